# Optimizing an MI355X kernel written in HIP

```python
import math
import jax, jax.numpy as jnp
from jax import lax
import numpy as np

D_MODEL = 1024
BATCH = 8
SEQ = 2048
DEPTH = 1
DEC_BATCH = 128
DEC_SEQ = 1
PAST_LEN = 16384
PAGE_SIZE = 128

GM_CHUNK = 128
GM_GROUPS = 4
GM_GROUP_DIM = 128
GM_WIDTH = GM_GROUPS * GM_GROUP_DIM
SSD_HEADS = 16
SSD_HEAD_DIM = 64
SSD_INNER = SSD_HEADS * SSD_HEAD_DIM
SSD_GROUPS = 2
SSD_STATE = 128
SSD_CONV = 4
SSD_CHUNK = 128
SSD_CONV_DIM = SSD_INNER + 2 * SSD_GROUPS * SSD_STATE
MEM_LEN = 256
XA_HEADS = 4
XA_HEAD_DIM = 128
XA_WIDTH = XA_HEADS * XA_HEAD_DIM
N_BRANCH = 3
D_FF = 4 * D_MODEL
EPS = 1e-6
IN_PROJ_DIM = 2 * GM_WIDTH + SSD_INNER + SSD_CONV_DIM + SSD_HEADS + XA_WIDTH + N_BRANCH * D_MODEL

kernel_name = "hybrid_gmlp_ssd_memxattn_decode_step"


def rmsnorm(x, w):
    xf = x.astype(jnp.float32)
    y = xf * lax.rsqrt(jnp.mean(xf * xf, axis=-1, keepdims=True) + EPS)
    return (y * w.astype(jnp.float32)).astype(x.dtype)


def layernorm(x, w, b):
    xf = x.astype(jnp.float32)
    mu = jnp.mean(xf, axis=-1, keepdims=True)
    xc = xf - mu
    y = xc * lax.rsqrt(jnp.mean(xc * xc, axis=-1, keepdims=True) + EPS)
    return (y * w.astype(jnp.float32) + b.astype(jnp.float32)).astype(x.dtype)


def pad_seq(t, mult):
    n_pad = (-t.shape[1]) % mult
    return jnp.pad(t, [(0, 0), (0, n_pad)] + [(0, 0)] * (t.ndim - 2))


def split_points():
    sizes = (2 * GM_WIDTH, SSD_INNER, SSD_CONV_DIM, SSD_HEADS, XA_WIDTH, N_BRANCH * D_MODEL)
    pts, acc = [], 0
    for s in sizes[:-1]:
        acc += s
        pts.append(acc)
    return pts


def gmlp_mix(uv, ln_w, ln_b, w_s, b_s):
    u, v = jnp.split(uv, 2, axis=-1)
    v = layernorm(v, ln_w, ln_b)
    b, L, _ = v.shape
    vc = pad_seq(v, GM_CHUNK)
    n_c = vc.shape[1] // GM_CHUNK
    vc = vc.reshape(b, n_c, GM_CHUNK, GM_GROUPS, GM_GROUP_DIM)
    causal = jnp.tril(jnp.ones((GM_CHUNK, GM_CHUNK), dtype=bool))
    ws = jnp.where(causal[None], w_s, 0).astype(v.dtype)
    mixed = jnp.einsum('gts,bcsgd->bctgd', ws, vc) + b_s.T.astype(v.dtype)[None, None, :, :, None]
    mixed = mixed.reshape(b, n_c * GM_CHUNK, GM_WIDTH)[:, :L]
    return u * mixed, v


def causal_conv(prev, u, w, bias):
    full = jnp.concatenate([prev.astype(u.dtype), u], axis=1)
    L = u.shape[1]
    out = full[:, 0:L] * w[0]
    for k in range(1, SSD_CONV):
        out = out + full[:, k:k + L] * w[k]
    return out + bias, full[:, L:]


def ssd_chunked(x, dt, A, bm, cm, h0):
    b, L = x.shape[:2]
    E = SSD_HEADS // SSD_GROUPS
    Q = SSD_CHUNK
    x, dt, bm, cm = (pad_seq(t, Q) for t in (x, dt, bm, cm))
    n_c = x.shape[1] // Q
    x = x.reshape(b, n_c, Q, SSD_GROUPS, E, SSD_HEAD_DIM)
    dt = dt.reshape(b, n_c, Q, SSD_GROUPS, E)
    bm = bm.reshape(b, n_c, Q, SSD_GROUPS, SSD_STATE)
    cm = cm.reshape(b, n_c, Q, SSD_GROUPS, SSD_STATE)
    acum = jnp.cumsum(dt * A.reshape(SSD_GROUPS, E), axis=2)
    xdt = x * dt[..., None]
    seg = acum[:, :, :, None] - acum[:, :, None, :]
    causal = jnp.tril(jnp.ones((Q, Q), dtype=bool))[:, :, None, None]
    decay = jnp.exp(jnp.where(causal, seg, -jnp.inf))
    cb = jnp.einsum('bcign,bcjgn->bcijg', cm, bm)
    y_diag = jnp.einsum('bcijg,bcijge,bcjgep->bcigep', cb, decay, xdt)
    decay_end = jnp.exp(acum[:, :, -1:] - acum)
    states = jnp.einsum('bcjgn,bcjge,bcjgep->bcgepn', bm, decay_end, xdt)
    chunk_decay = jnp.exp(acum[:, :, -1])

    def step(h, inp):
        s, d = inp
        return h * d[..., None, None] + s, h

    h_init = h0.reshape(b, SSD_GROUPS, E, SSD_HEAD_DIM, SSD_STATE)
    h_final, h_prev = lax.scan(step, h_init, (jnp.moveaxis(states, 1, 0), jnp.moveaxis(chunk_decay, 1, 0)))
    h_prev = jnp.moveaxis(h_prev, 0, 1)
    y_off = jnp.einsum('bcign,bcgepn,bcige->bcigep', cm, h_prev, jnp.exp(acum))
    y = (y_diag + y_off).reshape(b, n_c * Q, SSD_HEADS, SSD_HEAD_DIM)[:, :L]
    return y, h_final.reshape(b, SSD_HEADS, SSD_HEAD_DIM, SSD_STATE)


def mem_kv(mem, mem_norm_w, w_k, w_v):
    b = mem.shape[0]
    mn = rmsnorm(mem, mem_norm_w)
    k = (mn @ w_k).reshape(b, MEM_LEN, XA_HEADS, XA_HEAD_DIM)
    v = (mn @ w_v).reshape(b, MEM_LEN, XA_HEADS, XA_HEAD_DIM)
    return k, v


def mem_attend(q, k, v):
    s = jnp.einsum('blhd,bmhd->bhlm', q, k).astype(jnp.float32) * (XA_HEAD_DIM ** -0.5)
    p = jax.nn.softmax(s, axis=-1).astype(v.dtype)
    o = jnp.einsum('bhlm,bmhd->blhd', p, v)
    return o.reshape(q.shape[0], q.shape[1], XA_WIDTH)


def decoder_block(h, conv_prev, ssm_prev, mem_k, mem_v,
                  norm_mix_w, w_in, gm_ln_w, gm_ln_b, gm_ws, gm_bs,
                  conv_w, conv_b, dt_bias, a_log, d_skip, ssd_norm_w,
                  w_br_gm, w_br_ssd, w_br_xa, w_out, norm_ffn_w, w_up, w_down):
    b, L, _ = h.shape
    f32 = jnp.float32
    xn = rmsnorm(h, norm_mix_w)
    proj = xn @ w_in
    gm_uv, z, xbc, dt_raw, q, gate_raw = jnp.split(proj, split_points(), axis=-1)
    gm_out, gm_v = gmlp_mix(jax.nn.gelu(gm_uv, approximate=False), gm_ln_w, gm_ln_b, gm_ws, gm_bs)
    xbc, conv_new = causal_conv(conv_prev, xbc, conv_w, conv_b)
    xbc = jax.nn.silu(xbc)
    xs, bm, cm = jnp.split(xbc, [SSD_INNER, SSD_INNER + SSD_GROUPS * SSD_STATE], axis=-1)
    xs_h = xs.reshape(b, L, SSD_HEADS, SSD_HEAD_DIM).astype(f32)
    dt = jax.nn.softplus(dt_raw.astype(f32) + dt_bias.astype(f32))
    A = -jnp.exp(a_log.astype(f32))
    y, ssm_new = ssd_chunked(xs_h, dt, A,
                             bm.reshape(b, L, SSD_GROUPS, SSD_STATE).astype(f32),
                             cm.reshape(b, L, SSD_GROUPS, SSD_STATE).astype(f32),
                             ssm_prev.astype(f32))
    y = y + xs_h * d_skip.astype(f32)[:, None]
    y = y.reshape(b, L, SSD_INNER).astype(h.dtype) * jax.nn.silu(z)
    y = rmsnorm(y.reshape(b, L, SSD_GROUPS, SSD_INNER // SSD_GROUPS),
                ssd_norm_w.reshape(SSD_GROUPS, SSD_INNER // SSD_GROUPS)).reshape(b, L, SSD_INNER)
    xa = mem_attend(q.reshape(b, L, XA_HEADS, XA_HEAD_DIM), mem_k, mem_v)
    gates = jax.nn.sigmoid(gate_raw.astype(f32)).astype(h.dtype).reshape(b, L, N_BRANCH, D_MODEL)
    merged = (gates[:, :, 0] * (gm_out @ w_br_gm)
              + gates[:, :, 1] * (y @ w_br_ssd)
              + gates[:, :, 2] * (xa @ w_br_xa))
    h = h + merged @ w_out
    hn = rmsnorm(h, norm_ffn_w)
    h = h + jnp.square(jax.nn.relu(hn @ w_up)) @ w_down
    return h, conv_new, ssm_new, gm_v


def setup_inputs(seed: int = 0) -> dict:
    key = jax.random.key(seed)
    ks = jax.random.split(key, 40)
    f32 = jnp.float32

    def nrm(k, shape, scale):
        return jax.random.normal(k, shape, f32) * scale

    Ld = DEPTH
    dt0 = jnp.exp(jax.random.uniform(ks[12], (Ld, SSD_HEADS), f32, math.log(1e-3), math.log(1e-1)))
    return {
        "x_prompt": nrm(ks[0], (BATCH, SEQ, D_MODEL), 1.0),
        "x_sample": nrm(ks[1], (DEC_BATCH, DEC_SEQ, D_MODEL), 1.0),
        "mem_prompt": nrm(ks[2], (BATCH, MEM_LEN, D_MODEL), 1.0),
        "cache_mem_k": nrm(ks[3], (Ld, DEC_BATCH, MEM_LEN, XA_HEADS, XA_HEAD_DIM), 1.0),
        "cache_mem_v": nrm(ks[4], (Ld, DEC_BATCH, MEM_LEN, XA_HEADS, XA_HEAD_DIM), 1.0),
        "state_conv": nrm(ks[5], (Ld, DEC_BATCH, SSD_CONV - 1, SSD_CONV_DIM), 1.0),
        "state_ssm": nrm(ks[6], (Ld, DEC_BATCH, SSD_HEADS, SSD_HEAD_DIM, SSD_STATE), 0.1),
        "norm_mix_w": 1.0 + nrm(ks[7], (Ld, D_MODEL), 0.02),
        "w_in": nrm(ks[8], (Ld, D_MODEL, IN_PROJ_DIM), D_MODEL ** -0.5),
        "gm_ln_w": 1.0 + nrm(ks[9], (Ld, GM_WIDTH), 0.02),
        "gm_ln_b": nrm(ks[10], (Ld, GM_WIDTH), 0.02),
        "gm_ws": nrm(ks[11], (Ld, GM_GROUPS, GM_CHUNK, GM_CHUNK), 0.5 * GM_CHUNK ** -0.5),
        "gm_bs": 1.0 + nrm(ks[13], (Ld, GM_GROUPS, GM_CHUNK), 0.02),
        "conv_w": nrm(ks[14], (Ld, SSD_CONV, SSD_CONV_DIM), SSD_CONV ** -0.5),
        "conv_b": nrm(ks[15], (Ld, SSD_CONV_DIM), 0.02),
        "dt_bias": dt0 + jnp.log(-jnp.expm1(-dt0)),
        "a_log": jnp.log(jax.random.uniform(ks[16], (Ld, SSD_HEADS), f32, 1.0, 16.0)),
        "d_skip": 1.0 + nrm(ks[17], (Ld, SSD_HEADS), 0.02),
        "ssd_norm_w": 1.0 + nrm(ks[18], (Ld, SSD_INNER), 0.02),
        "mem_norm_w": 1.0 + nrm(ks[19], (Ld, D_MODEL), 0.02),
        "w_mem_k": nrm(ks[20], (Ld, D_MODEL, XA_WIDTH), D_MODEL ** -0.5),
        "w_mem_v": nrm(ks[21], (Ld, D_MODEL, XA_WIDTH), D_MODEL ** -0.5),
        "w_br_gm": nrm(ks[22], (Ld, GM_WIDTH, D_MODEL), GM_WIDTH ** -0.5),
        "w_br_ssd": nrm(ks[23], (Ld, SSD_INNER, D_MODEL), SSD_INNER ** -0.5),
        "w_br_xa": nrm(ks[24], (Ld, XA_WIDTH, D_MODEL), XA_WIDTH ** -0.5),
        "w_out": nrm(ks[25], (Ld, D_MODEL, D_MODEL), D_MODEL ** -0.5),
        "norm_ffn_w": 1.0 + nrm(ks[26], (Ld, D_MODEL), 0.02),
        "w_up": nrm(ks[27], (Ld, D_MODEL, D_FF), D_MODEL ** -0.5),
        "w_down": nrm(ks[28], (Ld, D_FF, D_MODEL), D_FF ** -0.5),
        "norm_final_w": 1.0 + nrm(ks[29], (D_MODEL,), 0.02),
    }


def reference(x_prompt, x_sample, mem_prompt, cache_mem_k, cache_mem_v, state_conv, state_ssm,
              norm_mix_w, w_in, gm_ln_w, gm_ln_b, gm_ws, gm_bs, conv_w, conv_b, dt_bias, a_log,
              d_skip, ssd_norm_w, mem_norm_w, w_mem_k, w_mem_v, w_br_gm, w_br_ssd, w_br_xa, w_out,
              norm_ffn_w, w_up, w_down, norm_final_w):
    hp, hs = x_prompt, x_sample
    mk_p, mv_p, cv_p, ss_p, cv_s, ss_s, gv_s = [], [], [], [], [], [], []
    for l in range(DEPTH):
        layer_w = (norm_mix_w[l], w_in[l], gm_ln_w[l], gm_ln_b[l], gm_ws[l], gm_bs[l],
                   conv_w[l], conv_b[l], dt_bias[l], a_log[l], d_skip[l], ssd_norm_w[l],
                   w_br_gm[l], w_br_ssd[l], w_br_xa[l], w_out[l], norm_ffn_w[l], w_up[l], w_down[l])
        mk, mv = mem_kv(mem_prompt, mem_norm_w[l], w_mem_k[l], w_mem_v[l])
        conv0 = jnp.zeros((hp.shape[0], SSD_CONV - 1, SSD_CONV_DIM), hp.dtype)
        ssm0 = jnp.zeros((hp.shape[0], SSD_HEADS, SSD_HEAD_DIM, SSD_STATE), jnp.float32)
        hp, cvp, ssp, _ = decoder_block(hp, conv0, ssm0, mk, mv, *layer_w)
        hs, cvs, sss, gvs = decoder_block(hs, state_conv[l], state_ssm[l],
                                          cache_mem_k[l], cache_mem_v[l], *layer_w)
        mk_p.append(mk); mv_p.append(mv); cv_p.append(cvp); ss_p.append(ssp)
        cv_s.append(cvs); ss_s.append(sss); gv_s.append(gvs)
    y_prompt = rmsnorm(hp, norm_final_w)
    y_sample = rmsnorm(hs, norm_final_w)
    mem_k_prompt = jnp.stack(mk_p)
    mem_v_prompt = jnp.stack(mv_p)
    conv_prompt = jnp.stack(cv_p)
    ssm_prompt = jnp.stack(ss_p)
    conv_sample = jnp.stack(cv_s)
    ssm_sample = jnp.stack(ss_s)
    gmlp_v_sample = jnp.stack(gv_s)
    return (y_prompt, y_sample, mem_k_prompt, mem_v_prompt, conv_prompt, ssm_prompt,
            conv_sample, ssm_sample, gmlp_v_sample)
```

```cpp
#include <hip/hip_runtime.h>
#include <hip/hip_cooperative_groups.h>
#include <cstdio>
namespace cg = cooperative_groups;

typedef unsigned short u16;
typedef short bf16x8 __attribute__((ext_vector_type(8)));
typedef float f32x4 __attribute__((ext_vector_type(4)));
typedef float f32x2 __attribute__((ext_vector_type(2)));
typedef unsigned u32x2 __attribute__((ext_vector_type(2)));
typedef unsigned u32x4 __attribute__((ext_vector_type(4)));

constexpr int TP = 16384, TS = 128, T = TP + TS;
constexpr float EPS = 1e-6f;
constexpr int NTHREADS = 512;
constexpr int DYN_LDS = 159744;

constexpr size_t OFF_WIN = 0;
constexpr size_t OFF_WKV = OFF_WIN + 14680064;
constexpr size_t OFF_WGM = OFF_WKV + 2097152;
constexpr size_t OFF_WSSD = OFF_WGM + 1048576;
constexpr size_t OFF_WXA = OFF_WSSD + 2097152;
constexpr size_t OFF_WOUT = OFF_WXA + 1048576;
constexpr size_t OFF_WUP = OFF_WOUT + 2097152;
constexpr size_t OFF_WDN = OFF_WUP + 8388608;
constexpr size_t OFF_WSB = OFF_WDN + 8388608;
constexpr size_t OFF_MN = OFF_WSB + 131072;
constexpr size_t OFF_KP = OFF_MN + 4194304;
constexpr size_t OFF_VT = OFF_KP + 2097152;
constexpr size_t OFF_DT = OFF_VT + 2097152;
constexpr size_t OFF_YPS = OFF_DT + 1056768;
constexpr size_t OFF_PS = OFF_YPS + 2113536;
constexpr size_t OFF_PSS = OFF_PS + 1048576;
constexpr size_t OFF_R1 = OFF_PSS + 32768;
constexpr size_t SZ_1024B = (size_t)T * 1024 * 2;
constexpr size_t OFF_UV = OFF_R1;
constexpr size_t OFF_ZS = OFF_R1 + SZ_1024B;
constexpr size_t OFF_XBC = OFF_R1 + 2 * SZ_1024B;
constexpr size_t OFF_MERGED = OFF_R1;
constexpr size_t OFF_ACT = OFF_R1;
constexpr size_t OFF_R2 = OFF_R1 + (size_t)T * 4096 * 2;
constexpr size_t OFF_GATE = OFF_R2;
constexpr size_t OFF_H2 = OFF_R2;
constexpr size_t OFF_H2B = OFF_R2 + (size_t)T * 1024 * 4;
constexpr size_t OFF_XA = OFF_R2 + (size_t)T * 3072 * 2;
constexpr size_t OFF_WDT = OFF_XA + (size_t)T * 512 * 2;
constexpr size_t OFF_BAR = OFF_WDT + 32768;
constexpr size_t BAR_BYTES = 32768;
constexpr size_t WS_TOTAL = OFF_BAR + BAR_BYTES;
constexpr size_t OOFF_XN = 0;
constexpr size_t OOFF_Q = SZ_1024B;
constexpr size_t OOFF_GM = SZ_1024B + (size_t)T * 512 * 2;
constexpr size_t O_Y = 0, O_MEMK = 16908288, O_MEMV = 17956864, O_CONVP = 19005440, O_SSMP = 19042304,
                 O_CONVS = 20090880, O_SSMS = 20680704, O_GMV = 37457920;

struct Params { const float* in[30]; float* out; char* ws; };

extern __shared__ __attribute__((aligned(16))) char g_shm[];

typedef __bf16 bf16x2_t __attribute__((ext_vector_type(2)));
__device__ __forceinline__ unsigned cvt_pk(float lo, float hi) { f32x2 v = {lo, hi}; bf16x2_t b = __builtin_convertvector(v, bf16x2_t); return __builtin_bit_cast(unsigned, b); }
__device__ __forceinline__ u32x2 pack4(f32x4 v) { u32x2 r; r.x = cvt_pk(v[0], v[1]); r.y = cvt_pk(v[2], v[3]); return r; }
__device__ __forceinline__ u16 f2bf(float f) { return (u16)(cvt_pk(f, 0.f) & 0xffffu); }
__device__ __forceinline__ float bf2f(u16 h) { return __uint_as_float(((unsigned)h) << 16); }
__device__ __forceinline__ float bflo(unsigned w) { return __uint_as_float(w << 16); }
__device__ __forceinline__ float bfhi(unsigned w) { return __uint_as_float(w & 0xffff0000u); }
__device__ __forceinline__ f32x4 unpack4(u32x2 w) { return (f32x4){bflo(w.x), bfhi(w.x), bflo(w.y), bfhi(w.y)}; }
__device__ __forceinline__ float silu_f(float x) { return x * __builtin_amdgcn_rcpf(1.f + __builtin_amdgcn_exp2f(-1.4426950409f * x)); }
__device__ __forceinline__ float sigm_f(float x) { return __builtin_amdgcn_rcpf(1.f + __builtin_amdgcn_exp2f(-1.4426950409f * x)); }
__device__ __forceinline__ float gelu_f(float v) {
  const float av = fabsf(v), t = __builtin_amdgcn_rcpf(av * 0.2316418882f + 1.0f);
  float q = t * 0.5307027145f + (-0.7265760135f); q = q * t + 0.7107068705f; q = q * t + (-0.142248368f); q = q * t + 0.127414796f; q = q * t;
  const float e = __builtin_amdgcn_exp2f((v * v) * (-0.72134752044f));
  const float m = v * (q * e), r = v - m;
  return v < 0.f ? m : r;
}
__device__ __forceinline__ float softplus_f(float x) { return fmaxf(x, 0.f) + log1pf(__expf(-fabsf(x))); }
__device__ __forceinline__ int lane_fresh() { int l; asm volatile("v_mbcnt_lo_u32_b32 %0, -1, 0\n\tv_mbcnt_hi_u32_b32 %0, -1, %0" : "=v"(l)); return l; }
__device__ __forceinline__ float shfl_xor_f(float v, int mask) { const int l = lane_fresh(); return __int_as_float(__builtin_amdgcn_ds_bpermute((l ^ mask) << 2, __float_as_int(v))); }
__device__ __forceinline__ float shfl_idx_f(float v, int src) { return __int_as_float(__builtin_amdgcn_ds_bpermute(src << 2, __float_as_int(v))); }
__device__ __forceinline__ float wave_sum(float v) {
#pragma unroll
  for (int o = 32; o >= 1; o >>= 1) v += shfl_xor_f(v, o);
  return v;
}
__device__ __forceinline__ float wave_max(float v) {
#pragma unroll
  for (int o = 32; o >= 1; o >>= 1) v = fmaxf(v, shfl_xor_f(v, o));
  return v;
}
__device__ __forceinline__ f32x4 ld_nt(const float* p) { return __builtin_nontemporal_load((const f32x4*)p); }
__device__ __forceinline__ void st_nt(float* p, f32x4 v) { __builtin_nontemporal_store(v, (f32x4*)p); }
#define MFMA16(a, b, c) __builtin_amdgcn_mfma_f32_16x16x32_bf16((a), (b), (c), 0, 0, 0)


#define XB_TMO      128
#define XB_XCNT(j)  (256  + 64 * (j))
#define XB_XSUB(j)  (1280 + 64 * (j))
#define XB_XGEN(j)  (2304 + 64 * (j))
#define XB_TOP      3328
#define XB_TOPGEN   3392
#define XB_SPIN_CAP (1u << 20)
#define LAS __attribute__((address_space(3)))
__device__ __forceinline__ unsigned xb_ld(unsigned* p) { return __hip_atomic_load(p, __ATOMIC_RELAXED, __HIP_MEMORY_SCOPE_AGENT); }
__device__ __forceinline__ unsigned xb_add(unsigned* p, unsigned v) { return __hip_atomic_fetch_add(p, v, __ATOMIC_RELAXED, __HIP_MEMORY_SCOPE_AGENT); }
__device__ __forceinline__ unsigned xb_xcc_id() { return (unsigned)__builtin_amdgcn_s_getreg((3 << 11) | 20) & 0xFu; }
#define XB_SPIN(cond, bar) do { unsigned _sp = 0; while (cond) { __builtin_amdgcn_s_sleep(1); \
    if ((++_sp & 255u) == 0u) { if (xb_ld(&(bar)[XB_TMO])) break; if (_sp > XB_SPIN_CAP) { atomicAdd(&(bar)[XB_TMO], 1u); break; } } } } while (0)
__shared__ uint4 xb_words;
__device__ __forceinline__ void xcd_barrier_complete(unsigned* bar, unsigned x, unsigned& nloc, unsigned& nx) {
  const unsigned G = gridDim.x;
  unsigned sum, cnt, mine, sp = 0u;
  for (;;) {
    sum = 0u; cnt = 0u; mine = 0u;
#pragma unroll
    for (unsigned j = 0; j < 16; ++j) { const unsigned c = xb_ld(&bar[XB_XCNT(j)]); sum += c; cnt += (c > 0u) ? 1u : 0u; mine = (j == x) ? c : mine; }
    if (sum == G) break;
    __builtin_amdgcn_s_sleep(1);
    if ((++sp & 255u) == 0u) { if (xb_ld(&bar[XB_TMO])) break; if (sp > XB_SPIN_CAP) { atomicAdd(&bar[XB_TMO], 1u); break; } }
  }
  nloc = mine > 0u ? mine : 1u; nx = cnt > 0u ? cnt : 1u;
}
__device__ __forceinline__ void xcd_barrier(unsigned* bar, const int wv) {
  asm volatile("s_waitcnt vmcnt(0)" ::: "memory");
  __syncthreads();
  if (wv == 0) {
    if (lane_fresh() == 0) {
      volatile LAS unsigned* st = (volatile LAS unsigned*)&xb_words;
      const unsigned x = xb_xcc_id();
      __builtin_amdgcn_s_waitcnt(0);
      unsigned nloc = st[0], nx = st[1];
      if (nloc == 0u) { xcd_barrier_complete(bar, x, nloc, nx); st[0] = nloc; st[1] = nx; }
      const unsigned old = xb_add(&bar[XB_XSUB(x)], 1u);
      const unsigned gen = old / nloc;
      if (old + 1u == (gen + 1u) * nloc) {
        __builtin_amdgcn_fence(__ATOMIC_RELEASE, "agent");
        asm volatile("s_waitcnt vmcnt(0)" ::: "memory");
        const unsigned og = xb_add(&bar[XB_TOP], 1u);
        const unsigned tg = og / nx;
        if (og + 1u == (tg + 1u) * nx) xb_add(&bar[XB_TOPGEN], 1u);
        else XB_SPIN(xb_ld(&bar[XB_TOPGEN]) == tg, bar);
        __builtin_amdgcn_fence(__ATOMIC_ACQUIRE, "agent");
        xb_add(&bar[XB_XGEN(x)], 1u);
        asm volatile("s_waitcnt vmcnt(0)" ::: "memory");
      } else {
        XB_SPIN(xb_ld(&bar[XB_XGEN(x)]) == gen, bar);
        __builtin_amdgcn_fence(__ATOMIC_ACQUIRE, "agent");
        asm volatile("s_waitcnt vmcnt(0)" ::: "memory");
      }
    }
  }
  __syncthreads();
}

constexpr int BM = 256, BK = 64, HALF = 128, HT = HALF * BK;
__device__ __forceinline__ int lds_byte(int r, int c) { int st = (r >> 4) * 2 + (c >> 5), rr = r & 15, cc = c & 31, ob = rr * 64 + cc * 2; return st * 1024 + (ob ^ (((ob >> 9) & 1) << 5)); }
__device__ __forceinline__ void stage_rc(int b, int& R, int& C) { int st = b / 1024, sb = b % 1024, swz = sb ^ (((sb >> 9) & 1) << 5); R = (st >> 1) * 16 + swz / 64; C = (st & 1) * 32 + (swz % 64) / 2; }

typedef f32x4 Acc[2][2][4][2];

template <int PART  , bool SYNC_FIRST = true>
__device__ __forceinline__ void kloop_t(const u16* __restrict__ A, int lda, const u16* __restrict__ Bt, int ldb, int K, Acc& acc, const int wv) {
  u16* shm = (u16*)g_shm;
#define SA(b, h) (shm + ((b) * 2 + (h)) * HT)
#define SB(b, h) (shm + (4 + (b) * 2 + (h)) * HT)
#define STAGE(P_, BASE, LD, br, kt) do { const u16* _gb = (BASE) + ((br) * (LD) + (kt) * BK); \
    unsigned _o0 = ((&(BASE) == &A) ? oA0 : oB0), _o1 = ((&(BASE) == &A) ? oA1 : oB1); asm volatile("" : "+v"(_o0), "+v"(_o1)); \
    __builtin_amdgcn_global_load_lds((const unsigned*)((const char*)_gb + _o0), (unsigned*)((char*)(P_) + ktid * 16), 16, 0, 0); \
    __builtin_amdgcn_global_load_lds((const unsigned*)((const char*)_gb + _o1), (unsigned*)((char*)(P_) + ktid * 16 + 8192), 16, 0, 0); } while (0)
#define LDA(dst, b, h) for (int m = 0; m < 4; ++m) for (int k = 0; k < 2; ++k) \
    dst[m][k] = *reinterpret_cast<const bf16x8*>((char*)SA(b, h) + lds_byte(wr * 64 + m * 16 + fr, k * 32 + fq * 8))
#define LDB(dst, b, h) for (int n = 0; n < 2; ++n) for (int k = 0; k < 2; ++k) \
    dst[n][k] = *reinterpret_cast<const bf16x8*>((char*)SB(b, h) + lds_byte(wc * 32 + n * 16 + fr, k * 32 + fq * 8))
#define MMA(ai, bj, At_, Bt_) do { __builtin_amdgcn_s_setprio(1); \
    for (int m = 0; m < 4; ++m) for (int n = 0; n < 2; ++n) for (int k = 0; k < 2; ++k) \
      acc[ai][bj][m][n] = MFMA16(Bt_[n][k], At_[m][k], acc[ai][bj][m][n]); \
    __builtin_amdgcn_s_setprio(0); } while (0)
#define WAIT_V(n) asm volatile("s_waitcnt vmcnt(" #n ")" ::: "memory")
#define WAIT_L(n) asm volatile("s_waitcnt lgkmcnt(" #n ")" ::: "memory")
#define BAR __builtin_amdgcn_s_barrier()
#define SCHED __builtin_amdgcn_sched_barrier(0)
  const int wid = wv, lane = lane_fresh(), ktid = wv * 64 + lane, wr = wid >> 2, wc = wid & 3, fr = lane & 15, fq = lane >> 4;
  bf16x8 At[4][2], B0[2][2], B1[2][2];
  const int nt = K / BK;
  unsigned oA0, oA1, oB0, oB1;
  { int r_, c_; stage_rc(ktid * 16, r_, c_); oA0 = (unsigned)(r_ * lda + c_) * 2u; oB0 = (unsigned)(r_ * ldb + c_) * 2u;
    stage_rc(ktid * 16 + 8192, r_, c_); oA1 = (unsigned)(r_ * lda + c_) * 2u; oB1 = (unsigned)(r_ * ldb + c_) * 2u; }
  if (PART != 2) {
    if (SYNC_FIRST) { WAIT_V(0); WAIT_L(0); __syncthreads(); }
    STAGE(SB(0, 0), Bt, ldb, 0, 0); STAGE(SA(0, 0), A, lda, 0, 0);
    STAGE(SB(0, 1), Bt, ldb, HALF, 0); STAGE(SA(0, 1), A, lda, HALF, 0);
  }
  if (PART == 1) return;
  if (wr == 1) BAR;
  WAIT_V(4); BAR;
  STAGE(SB(1, 0), Bt, ldb, 0, 1); STAGE(SA(1, 0), A, lda, 0, 1); STAGE(SB(1, 1), Bt, ldb, HALF, 1);
  WAIT_V(6); BAR;
#pragma unroll 1
  for (int t = 0; t < nt - 2; t += 2) {
    LDB(B0, 0, 0); SCHED; LDA(At, 0, 0); STAGE(SA(1, 1), A, lda, HALF, t + 1);
    WAIT_L(8); BAR; WAIT_L(0); MMA(0, 0, At, B0); BAR; SCHED;
    LDB(B1, 0, 1); STAGE(SB(0, 0), Bt, ldb, 0, t + 2);
    BAR; WAIT_L(0); MMA(0, 1, At, B1); BAR;
    LDA(At, 0, 1); STAGE(SA(0, 0), A, lda, 0, t + 2);
    BAR; WAIT_L(0); MMA(1, 0, At, B0); BAR; SCHED;
    STAGE(SB(0, 1), Bt, ldb, HALF, t + 2);
    WAIT_V(6); BAR; MMA(1, 1, At, B1); BAR;
    LDB(B0, 1, 0); SCHED; LDA(At, 1, 0); STAGE(SA(0, 1), A, lda, HALF, t + 2);
    WAIT_L(8); BAR; WAIT_L(0); MMA(0, 0, At, B0); BAR; SCHED;
    LDB(B1, 1, 1); STAGE(SB(1, 0), Bt, ldb, 0, t + 3);
    BAR; WAIT_L(0); MMA(0, 1, At, B1); BAR;
    LDA(At, 1, 1); STAGE(SA(1, 0), A, lda, 0, t + 3);
    BAR; WAIT_L(0); MMA(1, 0, At, B0); BAR; SCHED;
    STAGE(SB(1, 1), Bt, ldb, HALF, t + 3);
    WAIT_V(6); BAR; MMA(1, 1, At, B1); BAR;
  }
  { LDB(B0, 0, 0); LDA(At, 0, 0); STAGE(SA(1, 1), A, lda, HALF, nt - 1);
    BAR; WAIT_L(0); MMA(0, 0, At, B0); BAR;
    LDB(B1, 0, 1); BAR; WAIT_L(0); MMA(0, 1, At, B1); BAR;
    LDA(At, 0, 1); WAIT_V(4); BAR; WAIT_L(0); MMA(1, 0, At, B0); MMA(1, 1, At, B1); BAR; }
  { LDB(B0, 1, 0); LDA(At, 1, 0); WAIT_V(2); BAR; WAIT_L(0); MMA(0, 0, At, B0); BAR;
    LDB(B1, 1, 1); WAIT_V(0); BAR; WAIT_L(0); MMA(0, 1, At, B1); BAR;
    LDA(At, 1, 1); BAR; WAIT_L(0); MMA(1, 0, At, B0); MMA(1, 1, At, B1); BAR; }
  if (wr == 0) BAR;
  SCHED;
}

__device__ __forceinline__ void kloop(const u16* __restrict__ A, int lda, const u16* __restrict__ Bt, int ldb, int K, Acc& acc, const int wv) { kloop_t<0>(A, lda, Bt, ldb, K, acc, wv); }

#define ACC_ZERO(acc) do { _Pragma("unroll") for (int ai = 0; ai < 2; ++ai) _Pragma("unroll") for (int bj = 0; bj < 2; ++bj) \
  _Pragma("unroll") for (int m = 0; m < 4; ++m) _Pragma("unroll") for (int n = 0; n < 2; ++n) acc[ai][bj][m][n] = (f32x4){0.f, 0.f, 0.f, 0.f}; } while (0)
#define ACC_FOREACH(...) do { const int lane_e = lane_fresh(), fr = lane_e & 15, fq = lane_e >> 4; (void)fr; (void)fq; _Pragma("unroll") for (int ai = 0; ai < 2; ++ai) _Pragma("unroll") for (int m = 0; m < 4; ++m) { \
  const int rrow = ai * 128 + wr * 64 + m * 16 + fr; (void)rrow; \
  _Pragma("unroll") for (int bj = 0; bj < 2; ++bj) _Pragma("unroll") for (int n = 0; n < 2; ++n) { \
    const int rcol = bj * 128 + wc * 32 + n * 16 + fq * 4; (void)rcol; f32x4& v = acc[ai][bj][m][n]; __VA_ARGS__ } } } while (0)
#define ACC_FOREACH_SB(...) do { __builtin_amdgcn_sched_barrier(0); const int lane_e = lane_fresh(), fr = lane_e & 15, fq = lane_e >> 4; (void)fr; (void)fq; _Pragma("unroll") for (int ai = 0; ai < 2; ++ai) _Pragma("unroll") for (int m = 0; m < 4; ++m) { \
  const int rrow = ai * 128 + wr * 64 + m * 16 + fr; (void)rrow; \
  _Pragma("unroll") for (int bj = 0; bj < 2; ++bj) _Pragma("unroll") for (int n = 0; n < 2; ++n) { \
    const int rcol = bj * 128 + wc * 32 + n * 16 + fq * 4; (void)rcol; f32x4& v = acc[ai][bj][m][n]; __VA_ARGS__ } __builtin_amdgcn_sched_barrier(0); } } while (0)

__device__ __forceinline__ f32x4 wave_gemm16(const u16* __restrict__ A, int lda, const u16* __restrict__ Bt, int ldb, int K, f32x4 acc) {
  const int lane = lane_fresh(), fr = lane & 15, fq = lane >> 4;
  const u16* ap = A + (size_t)fr * lda + fq * 8;
  const u16* bp = Bt + (size_t)fr * ldb + fq * 8;
#pragma unroll 4
  for (int k = 0; k < K; k += 32) {
    bf16x8 a = *(const bf16x8*)(ap + k);
    bf16x8 b = *(const bf16x8*)(bp + k);
    acc = MFMA16(b, a, acc);
  }
  return acc;
}


template <int NT, class FA, class FB, class FL>
__device__ __forceinline__ void skgemm(FA aptr, FB bptr, FL ldf, const int KS, const int wv) {
  float* part = (float*)g_shm;
  const int lane = lane_fresh(), fr = lane & 15, fq = lane >> 4;
  __syncthreads();
#pragma unroll
  for (int i = 0; i < NT; ++i) {
    f32x4 acc = {0.f, 0.f, 0.f, 0.f};
    const int ld = ldf(i);
    const u16* ap = aptr(i) + (size_t)fr * ld + wv * KS + fq * 8;
    const u16* bp = bptr(i) + (size_t)fr * ld + wv * KS + fq * 8;
#pragma unroll 8
    for (int k = 0; k < KS; k += 32) acc = MFMA16(*(const bf16x8*)(bp + k), *(const bf16x8*)(ap + k), acc);
    *(f32x4*)(part + ((i * 8 + wv) * 64 + lane) * 4) = acc;
  }
  __syncthreads();
}
__device__ __forceinline__ f32x4 skreduce(int i) {
  const float* part = (const float*)g_shm;
  const int lane = lane_fresh();
  f32x4 s = {0.f, 0.f, 0.f, 0.f};
#pragma unroll
  for (int w = 0; w < 8; ++w) s += *(const f32x4*)(part + ((i * 8 + w) * 64 + lane) * 4);
  return s;
}

struct TJob { const float* src; const float* ks; u16* dst; int ldsrc, col0, k0, K, n0; };
__device__ __forceinline__ TJob tjob_decode(const Params& p, int i) {
  TJob j; char* ws = p.ws; j.ks = nullptr;
  if (i < 1792) { int kt = i & 15, ntl = i >> 4; j.src = p.in[8]; j.ldsrc = 7184; j.K = 1024; j.k0 = kt * 64; j.n0 = ntl * 64; j.col0 = j.n0 + (j.n0 >= 3584 ? 16 : 0); j.dst = (u16*)(ws + OFF_WIN); }
  else if ((i -= 1792) < 128) { int kt = i & 15, ntl = i >> 4; j.src = p.in[20]; j.ldsrc = 512; j.K = 1024; j.k0 = kt * 64; j.col0 = ntl * 64; j.n0 = (ntl >> 1) * 256 + (ntl & 1) * 64; j.dst = (u16*)(ws + OFF_WKV); }
  else if ((i -= 128) < 128) { int kt = i & 15, ntl = i >> 4; j.src = p.in[21]; j.ldsrc = 512; j.K = 1024; j.k0 = kt * 64; j.col0 = ntl * 64; j.n0 = (ntl >> 1) * 256 + 128 + (ntl & 1) * 64; j.dst = (u16*)(ws + OFF_WKV); }
  else if ((i -= 128) < 128) { int kt = i & 7, ntl = i >> 3; j.src = p.in[22]; j.ldsrc = 1024; j.K = 512; j.k0 = kt * 64; j.col0 = ntl * 64; j.n0 = j.col0; j.dst = (u16*)(ws + OFF_WGM); }
  else if ((i -= 128) < 256) { int kt = i & 15, ntl = i >> 4; j.src = p.in[23]; j.ldsrc = 1024; j.K = 1024; j.k0 = kt * 64; j.col0 = ntl * 64; j.n0 = j.col0; j.dst = (u16*)(ws + OFF_WSSD); j.ks = p.in[18]; }
  else if ((i -= 256) < 128) { int kt = i & 7, ntl = i >> 3; j.src = p.in[24]; j.ldsrc = 1024; j.K = 512; j.k0 = kt * 64; j.col0 = ntl * 64; j.n0 = j.col0; j.dst = (u16*)(ws + OFF_WXA); }
  else if ((i -= 128) < 256) { int kt = i & 15, ntl = i >> 4; j.src = p.in[25]; j.ldsrc = 1024; j.K = 1024; j.k0 = kt * 64; j.col0 = ntl * 64; j.n0 = j.col0; j.dst = (u16*)(ws + OFF_WOUT); }
  else if ((i -= 256) < 1024) { int kt = i & 15, ntl = i >> 4; j.src = p.in[27]; j.ldsrc = 4096; j.K = 1024; j.k0 = kt * 64; j.col0 = ntl * 64; j.n0 = j.col0; j.dst = (u16*)(ws + OFF_WUP); j.ks = p.in[26]; }
  else { i -= 1024; int kt = i & 63, ntl = i >> 6; j.src = p.in[28]; j.ldsrc = 1024; j.K = 4096; j.k0 = kt * 64; j.col0 = ntl * 64; j.n0 = j.col0; j.dst = (u16*)(ws + OFF_WDN); }
  return j;
}
__device__ __forceinline__ void ttile_load(const TJob& j, int tid, f32x4 (&v)[2]) {
#pragma unroll
  for (int i = 0; i < 2; ++i) {
    const int kk = (tid >> 4) + 32 * i, nn = (tid & 15) * 4;
    v[i] = ld_nt(j.src + (size_t)(j.k0 + kk) * j.ldsrc + j.col0 + nn);
    if (j.ks) v[i] = v[i] * j.ks[j.k0 + kk];
  }
}
__device__ __forceinline__ void ttile_store(const TJob& j, int tid, const f32x4 (&v)[2]) {
  float* tile = (float*)g_shm;
  __syncthreads();
#pragma unroll
  for (int i = 0; i < 2; ++i) {
    const int kk = (tid >> 4) + 32 * i, nn = (tid & 15) * 4;
    tile[kk * 65 + nn] = v[i][0]; tile[kk * 65 + nn + 1] = v[i][1]; tile[kk * 65 + nn + 2] = v[i][2]; tile[kk * 65 + nn + 3] = v[i][3];
  }
  __syncthreads();
  {
    const int nn = tid >> 3, k8 = (tid & 7) * 8;
    u32x4 w;
    w.x = cvt_pk(tile[(k8 + 0) * 65 + nn], tile[(k8 + 1) * 65 + nn]); w.y = cvt_pk(tile[(k8 + 2) * 65 + nn], tile[(k8 + 3) * 65 + nn]);
    w.z = cvt_pk(tile[(k8 + 4) * 65 + nn], tile[(k8 + 5) * 65 + nn]); w.w = cvt_pk(tile[(k8 + 6) * 65 + nn], tile[(k8 + 7) * 65 + nn]);
    *(u32x4*)(j.dst + (size_t)(j.n0 + nn) * j.K + j.k0 + k8) = w;
  }
}

__device__ __forceinline__ void phaseA(const Params& p, const int wv, const int rep) {
  const int lane = lane_fresh(), wid = wv, tid = wv * 64 + lane;
  char* ws = p.ws;
  {
    const int tend = 4864 * rep;
    int t_ = blockIdx.x;
    TJob job; f32x4 v[2];
    if (t_ < tend) { job = tjob_decode(p, t_ >= 4864 ? t_ - 4864 : t_); ttile_load(job, tid, v); }
    while (t_ < tend) {
      const int tn = t_ + gridDim.x;
      TJob jobn = job; f32x4 vn[2] = {v[0], v[1]};
      if (tn < tend) { jobn = tjob_decode(p, tn >= 4864 ? tn - 4864 : tn); ttile_load(jobn, tid, vn); }
      ttile_store(job, tid, v);
      job = jobn; v[0] = vn[0]; v[1] = vn[1]; t_ = tn;
    }
  }
  const int gw = blockIdx.x * 8 + wid, nw = gridDim.x * 8;
  u16* XN = (u16*)((char*)p.out + OOFF_XN);
  u16* MN = (u16*)(ws + OFF_MN);
  {
    const int rend = (T + 2048) * rep;
    auto rowsrc = [&](int r_) -> const float* {
      const int r = r_ >= T + 2048 ? r_ - (T + 2048) : r_;
      return r < TP ? p.in[0] + (size_t)r * 1024 : r < T ? p.in[1] + (size_t)(r - TP) * 1024 : p.in[2] + (size_t)(r - T) * 1024;
    };
    int r_ = gw;
    f32x4 v[4];
    if (r_ < rend) { const float* x = rowsrc(r_);
#pragma unroll
      for (int i = 0; i < 4; ++i) v[i] = *(const f32x4*)(x + (i * 64 + lane) * 4); }
    while (r_ < rend) {
      const int rn = r_ + nw;
      f32x4 vn[4] = {v[0], v[1], v[2], v[3]};
      if (rn < rend) { const float* x = rowsrc(rn);
#pragma unroll
        for (int i = 0; i < 4; ++i) vn[i] = *(const f32x4*)(x + (i * 64 + lane) * 4); }
      const int r = r_ >= T + 2048 ? r_ - (T + 2048) : r_;
      const float* w = r < T ? p.in[7] : p.in[19];
      u16* dst = r < T ? XN + (size_t)r * 1024 : MN + (size_t)(r - T) * 1024;
      float ss = 0.f;
#pragma unroll
      for (int i = 0; i < 4; ++i) ss += v[i][0] * v[i][0] + v[i][1] * v[i][1] + v[i][2] * v[i][2] + v[i][3] * v[i][3];
      ss = wave_sum(ss);
      const float rstd = rsqrtf(ss * (1.f / 1024.f) + EPS);
#pragma unroll
      for (int i = 0; i < 4; ++i) { f32x4 wv4 = *(const f32x4*)(w + (i * 64 + lane) * 4); *(u32x2*)(dst + (i * 64 + lane) * 4) = pack4(v[i] * rstd * wv4); }
#pragma unroll
      for (int i = 0; i < 4; ++i) v[i] = vn[i];
      r_ = rn;
    }
  }
  for (int i = blockIdx.x * NTHREADS + tid; i < 16384; i += gridDim.x * NTHREADS) {
    int k = i & 1023, hh = i >> 10;
    ((u16*)(ws + OFF_WDT))[i] = f2bf(p.in[8][(size_t)k * 7184 + 3584 + hh]);
  }
  u16* WSB = (u16*)(ws + OFF_WSB);
  for (int i = blockIdx.x * NTHREADS + tid; i < 65536; i += gridDim.x * NTHREADS) {
    int s = i & 127, tt = (i >> 7) & 127;
    WSB[i] = f2bf(s <= tt ? p.in[11][i] : 0.f);
  }
  for (int i = blockIdx.x * NTHREADS + tid; i < 128 * 3072; i += gridDim.x * NTHREADS) {
    int b = i / 3072, rem = i - b * 3072;
    p.out[O_CONVS + (size_t)b * 4608 + rem] = p.in[5][(size_t)b * 4608 + 1536 + rem];
  }
}

template <int SEC> __device__ __forceinline__ void epiB(const Params& p, int row, int col, f32x4 v) {
  char* ws = p.ws;
  if (SEC == 0) { f32x4 o = {gelu_f(v[0]), gelu_f(v[1]), gelu_f(v[2]), gelu_f(v[3])}; *(u32x2*)((u16*)(ws + OFF_UV) + (size_t)row * 1024 + col) = pack4(o); }
  else if (SEC == 1) { f32x4 o = {silu_f(v[0]), silu_f(v[1]), silu_f(v[2]), silu_f(v[3])}; *(u32x2*)((u16*)(ws + OFF_ZS) + (size_t)row * 1024 + (col - 1024)) = pack4(o); }
  else if (SEC == 2) {
    int c = col - 2048;
    *(u32x2*)((u16*)(ws + OFF_XBC) + (size_t)row * 1536 + c) = pack4(v);
    if (row >= TP) { *(f32x4*)(p.out + O_CONVS + (size_t)(row - TP) * 4608 + 3072 + c) = v; }
    else { int pos = row & 2047; if (pos >= 2045) *(f32x4*)(p.out + O_CONVP + (size_t)(row >> 11) * 4608 + (pos - 2045) * 1536 + c) = v; }
  }
  else if (SEC == 3) { *(u32x2*)((u16*)((char*)p.out + OOFF_Q) + (size_t)row * 512 + (col - 3584)) = pack4(v); }
  else if (SEC == 4) { f32x4 o = {sigm_f(v[0]), sigm_f(v[1]), sigm_f(v[2]), sigm_f(v[3])}; *(u32x2*)((u16*)(ws + OFF_GATE) + (size_t)row * 3072 + (col - 4096)) = pack4(o); }
  else {
    if (col < 512) {
      st_nt(p.out + O_MEMK + (size_t)row * 512 + col, v);
      *(u32x2*)((u16*)(ws + OFF_KP) + (size_t)row * 512 + col) = pack4(v);
    } else {
      int c = col - 512;
      st_nt(p.out + O_MEMV + (size_t)row * 512 + c, v);
      int b = row >> 8, mm = row & 255, hh = c >> 7, d = c & 127;
      int x = mm & 31, pos = (mm & ~31) + 8 * ((x >> 2) & 3) + 4 * (x >> 4) + (x & 3);
      u16* vt = (u16*)(ws + OFF_VT) + ((size_t)(b * 4 + hh) * 128 + d) * 256 + pos;
      vt[0] = f2bf(v[0]); vt[256] = f2bf(v[1]); vt[512] = f2bf(v[2]); vt[768] = f2bf(v[3]);
    }
  }
}
__device__ __forceinline__ int secB(int col) { return col < 1024 ? 0 : col < 2048 ? 1 : col < 3584 ? 2 : col < 4096 ? 3 : 4; }

__device__ __forceinline__ void phaseB(const Params& p, const int wv, const int rep) {
  const int wid = wv, wr = wid >> 2, wc = wid & 3;
  char* ws = p.ws;
  const u16* XN = (const u16*)((char*)p.out + OOFF_XN);
  {
    const u16* WIN = (const u16*)(ws + OFF_WIN);
    int t_ = blockIdx.x;
    const int tend = 1792 * rep;
    Acc acc;
    if (t_ < tend) {
      const int t = t_ >= 1792 ? t_ - 1792 : t_;
      kloop_t<1, true>(XN + (size_t)((t & 63) * 256) * 1024, 1024, WIN + (size_t)((t >> 6) * 256) * 1024, 1024, 1024, acc, wv);
    }
    while (t_ < tend) {
      const int t = t_ >= 1792 ? t_ - 1792 : t_;
      const int brow = (t & 63) * 256, bcol = (t >> 6) * 256, sec = secB(bcol);
      ACC_ZERO(acc);
      kloop_t<2>(XN + (size_t)brow * 1024, 1024, WIN + (size_t)bcol * 1024, 1024, 1024, acc, wv);
      t_ += gridDim.x;
      if (t_ < tend) {
        const int tn = t_ >= 1792 ? t_ - 1792 : t_;
        kloop_t<1, false>(XN + (size_t)((tn & 63) * 256) * 1024, 1024, WIN + (size_t)((tn >> 6) * 256) * 1024, 1024, 1024, acc, wv);
      }
      switch (sec) {
        case 0: ACC_FOREACH({ epiB<0>(p, brow + rrow, bcol + rcol, v); }); break;
        case 1: ACC_FOREACH({ epiB<1>(p, brow + rrow, bcol + rcol, v); }); break;
        case 2: ACC_FOREACH({ epiB<2>(p, brow + rrow, bcol + rcol, v); }); break;
        case 3: ACC_FOREACH({ epiB<3>(p, brow + rrow, bcol + rcol, v); }); break;
        default: ACC_FOREACH({ epiB<4>(p, brow + rrow, bcol + rcol, v); }); break;
      }
    }
  }
  for (int gb = blockIdx.x; gb < 256; gb += gridDim.x) {
    const int task0 = gb * 14, mt = task0 / 448, nt0 = task0 - mt * 448;
    const u16* Ab = XN + (size_t)(TP + mt * 16) * 1024;
    const u16* Bb = (const u16*)(ws + OFF_WIN) + (size_t)(nt0 * 16) * 1024;
    skgemm<14>([&](int) { return Ab; }, [&](int i) { return Bb + (size_t)i * 16 * 1024; }, [&](int) { return 1024; }, 128, wv);
    for (int i = wv; i < 14; i += 8) {
      const int lane_e = lane_fresh(), fr = lane_e & 15, fq = lane_e >> 4;
      f32x4 a = skreduce(i);
      int row = TP + mt * 16 + fr, col = (nt0 + i) * 16 + fq * 4;
      switch (secB(col)) {
        case 0: epiB<0>(p, row, col, a); break;
        case 1: epiB<1>(p, row, col, a); break;
        case 2: epiB<2>(p, row, col, a); break;
        case 3: epiB<3>(p, row, col, a); break;
        default: epiB<4>(p, row, col, a); break;
      }
    }
  }
  for (int gb = blockIdx.x; gb < 256; gb += gridDim.x) {
    const u16* Bd = (const u16*)(ws + OFF_WDT);
    skgemm<5>([&](int i) { int tk = gb + 256 * i; tk = tk < T / 16 ? tk : 0; return XN + (size_t)(tk * 16) * 1024; }, [&](int) { return Bd; }, [&](int) { return 1024; }, 128, wv);
    for (int i = wv; i < 5; i += 8) {
      const int tk = gb + 256 * i;
      if (tk < T / 16) {
        const int lane_d = lane_fresh(), frd = lane_d & 15, fqd = lane_d >> 4;
        f32x4 a = skreduce(i);
        f32x4 bb = *(const f32x4*)(p.in[15] + fqd * 4);
        f32x4 o = {softplus_f(a[0] + bb[0]), softplus_f(a[1] + bb[1]), softplus_f(a[2] + bb[2]), softplus_f(a[3] + bb[3])};
        *(f32x4*)((float*)(ws + OFF_DT) + (size_t)(tk * 16 + frd) * 16 + fqd * 4) = o;
      }
    }
  }
}

__device__ __forceinline__ void ssd_prompt_item(const Params& p, int item, const int wv) {
  const int lane = lane_fresh(), wid = wv, tid = wv * 64 + lane, fr = lane & 15, fq = lane >> 4;
  const int h = item & 15, b = item >> 4, g = h >> 3;
  char* ws = p.ws;
  u16* C_l = (u16*)g_shm;
  u16* B_l = C_l + 128 * 136;
  u16* G_l = B_l;
  u16* BT_l = B_l + 128 * 136;
  u16* xT_l = BT_l + 128 * 136;
  u16* xw_l = xT_l + 64 * 136;
  u16* h_l = xw_l + 64 * 136;
  float* acum_l = (float*)(h_l + 64 * 136);
  float* dt_l = acum_l + 128;
  const u16* XBC = (const u16*)(ws + OFF_XBC);
  const u16* ZS = (const u16*)(ws + OFF_ZS);
  const float* DT = (const float*)(ws + OFF_DT);
  u16* Y = (u16*)((char*)p.out + OOFF_XN);
  float* YPS = (float*)(ws + OFF_YPS);
  const float Ah = -__expf(p.in[16][h]);
  const float Dh = p.in[17][h];
  const float* convw = p.in[13];
  const float* convb = p.in[14];
  const int cc = tid & 31, rg = tid >> 5;
  const int colbc = (cc < 16) ? (1024 + g * 128 + cc * 8) : (1280 + g * 128 + (cc - 16) * 8);
  const int xc = tid & 7, xr = tid >> 3;
  const int colx = h * 64 + xc * 8;
  const int j0 = rg * 8;
  f32x4 hacc[4];
#pragma unroll
  for (int pb = 0; pb < 4; ++pb) hacc[pb] = (f32x4){0.f, 0.f, 0.f, 0.f};
  u32x4 u[11], ux[5];
  float a0 = 0.f, a1 = 0.f;
#define SSD_PREFETCH(cn) do { const int t0n = b * 2048 + (cn) * 128; \
    _Pragma("unroll") for (int i_ = 0; i_ < 11; ++i_) { const int j_ = j0 - 3 + i_; const bool ok_ = ((cn) > 0) | (j_ >= 0); \
      u[i_] = *(const u32x4*)(XBC + (size_t)(t0n + (ok_ ? j_ : 0)) * 1536 + colbc); const unsigned m_ = ok_ ? 0xffffffffu : 0u; \
      u[i_].x &= m_; u[i_].y &= m_; u[i_].z &= m_; u[i_].w &= m_; } \
    _Pragma("unroll") for (int k_ = 0; k_ < 5; ++k_) { const int j_ = 2 * xr - 3 + k_; const bool ok_ = ((cn) > 0) | (j_ >= 0); \
      ux[k_] = *(const u32x4*)(XBC + (size_t)(t0n + (ok_ ? j_ : 0)) * 1536 + colx); const unsigned m_ = ok_ ? 0xffffffffu : 0u; \
      ux[k_].x &= m_; ux[k_].y &= m_; ux[k_].z &= m_; ux[k_].w &= m_; } \
    if (wid == 0) { a0 = DT[(size_t)(t0n + 2 * lane) * 16 + h]; a1 = DT[(size_t)(t0n + 2 * lane + 1) * 16 + h]; } } while (0)
  SSD_PREFETCH(0);
#pragma unroll 1
  for (int c = 0; c < 16; ++c) {
    const int t0 = b * 2048 + c * 128;
    __syncthreads();
#pragma unroll
    for (int pb = 0; pb < 4; ++pb) *(u32x2*)(h_l + (pb * 16 + fr) * 136 + wid * 16 + fq * 4) = pack4(hacc[pb]);
    if (wid == 0) {
      dt_l[2 * lane] = a0; dt_l[2 * lane + 1] = a1;
      float s = (a0 + a1) * Ah;
#pragma unroll
      for (int o = 1; o < 64; o <<= 1) { float v = shfl_idx_f(s, (lane - o) & 63); if (lane >= o) s += v; }
      acum_l[2 * lane + 1] = s; acum_l[2 * lane] = s - a1 * Ah;
    }
    {
      float w[4][8], bias[8];
#pragma unroll
      for (int k = 0; k < 4; ++k) { f32x4 w0 = *(const f32x4*)(convw + k * 1536 + colbc), w1 = *(const f32x4*)(convw + k * 1536 + colbc + 4);
        w[k][0] = w0[0]; w[k][1] = w0[1]; w[k][2] = w0[2]; w[k][3] = w0[3]; w[k][4] = w1[0]; w[k][5] = w1[1]; w[k][6] = w1[2]; w[k][7] = w1[3]; }
      { f32x4 b0 = *(const f32x4*)(convb + colbc), b1 = *(const f32x4*)(convb + colbc + 4);
        bias[0] = b0[0]; bias[1] = b0[1]; bias[2] = b0[2]; bias[3] = b0[3]; bias[4] = b1[0]; bias[5] = b1[1]; bias[6] = b1[2]; bias[7] = b1[3]; }
      unsigned outp[8][4];
#pragma unroll
      for (int jj = 0; jj < 8; ++jj) {
        float o[8];
#pragma unroll
        for (int e = 0; e < 8; ++e) o[e] = bias[e];
#pragma unroll
        for (int k = 0; k < 4; ++k) {
          u32x4 uu = u[jj + k];
          o[0] += w[k][0] * bflo(uu.x); o[1] += w[k][1] * bfhi(uu.x); o[2] += w[k][2] * bflo(uu.y); o[3] += w[k][3] * bfhi(uu.y);
          o[4] += w[k][4] * bflo(uu.z); o[5] += w[k][5] * bfhi(uu.z); o[6] += w[k][6] * bflo(uu.w); o[7] += w[k][7] * bfhi(uu.w);
        }
#pragma unroll
        for (int e = 0; e < 8; ++e) o[e] = silu_f(o[e]);
#pragma unroll
        for (int e2 = 0; e2 < 4; ++e2) outp[jj][e2] = cvt_pk(o[2 * e2], o[2 * e2 + 1]);
      }
      if (cc < 16) {
#pragma unroll
        for (int jj = 0; jj < 8; ++jj) *(u32x4*)(B_l + (j0 + jj) * 136 + cc * 8) = (u32x4){outp[jj][0], outp[jj][1], outp[jj][2], outp[jj][3]};
#pragma unroll
        for (int e2 = 0; e2 < 4; ++e2) {
          u32x4 lo, hi;
          lo.x = (outp[0][e2] & 0xffffu) | (outp[1][e2] << 16); lo.y = (outp[2][e2] & 0xffffu) | (outp[3][e2] << 16);
          lo.z = (outp[4][e2] & 0xffffu) | (outp[5][e2] << 16); lo.w = (outp[6][e2] & 0xffffu) | (outp[7][e2] << 16);
          hi.x = (outp[0][e2] >> 16) | (outp[1][e2] & 0xffff0000u); hi.y = (outp[2][e2] >> 16) | (outp[3][e2] & 0xffff0000u);
          hi.z = (outp[4][e2] >> 16) | (outp[5][e2] & 0xffff0000u); hi.w = (outp[6][e2] >> 16) | (outp[7][e2] & 0xffff0000u);
          *(u32x4*)(BT_l + (cc * 8 + 2 * e2) * 136 + j0) = lo;
          *(u32x4*)(BT_l + (cc * 8 + 2 * e2 + 1) * 136 + j0) = hi;
        }
      } else {
#pragma unroll
        for (int jj = 0; jj < 8; ++jj) *(u32x4*)(C_l + (j0 + jj) * 136 + (cc - 16) * 8) = (u32x4){outp[jj][0], outp[jj][1], outp[jj][2], outp[jj][3]};
      }
    }
    {
      f32x4 b0 = *(const f32x4*)(convb + colx), b1 = *(const f32x4*)(convb + colx + 4);
      f32x4 w0[4], w1[4];
#pragma unroll
      for (int k = 0; k < 4; ++k) { w0[k] = *(const f32x4*)(convw + k * 1536 + colx); w1[k] = *(const f32x4*)(convw + k * 1536 + colx + 4); }
      float xo[2][8];
#pragma unroll
      for (int r2 = 0; r2 < 2; ++r2) {
        float o[8] = {b0[0], b0[1], b0[2], b0[3], b1[0], b1[1], b1[2], b1[3]};
#pragma unroll
        for (int k = 0; k < 4; ++k) {
          u32x4 uu = ux[r2 + k];
          o[0] += w0[k][0] * bflo(uu.x); o[1] += w0[k][1] * bfhi(uu.x); o[2] += w0[k][2] * bflo(uu.y); o[3] += w0[k][3] * bfhi(uu.y);
          o[4] += w1[k][0] * bflo(uu.z); o[5] += w1[k][1] * bfhi(uu.z); o[6] += w1[k][2] * bflo(uu.w); o[7] += w1[k][3] * bfhi(uu.w);
        }
#pragma unroll
        for (int e = 0; e < 8; ++e) xo[r2][e] = silu_f(o[e]);
      }
#pragma unroll
      for (int e = 0; e < 8; ++e) *(unsigned*)(xT_l + (xc * 8 + e) * 136 + 2 * xr) = cvt_pk(xo[0][e], xo[1][e]);
    }
    __syncthreads();
    if (c < 15) SSD_PREFETCH(c + 1);
    u32x2 zsr[4];
#pragma unroll
    for (int pb = 0; pb < 4; ++pb) zsr[pb] = *(const u32x2*)(ZS + (size_t)(t0 + wid * 16 + fr) * 1024 + h * 64 + pb * 16 + fq * 4);
    bf16x8 cf[4];
#pragma unroll
    for (int ks = 0; ks < 4; ++ks) cf[ks] = *(const bf16x8*)(C_l + (wid * 16 + fr) * 136 + ks * 32 + fq * 8);
    f32x4 cb[8];
#pragma unroll
    for (int jb = 0; jb < 8; ++jb) {
      cb[jb] = (f32x4){0.f, 0.f, 0.f, 0.f};
      if (jb <= wid) {
#pragma unroll
        for (int ks = 0; ks < 4; ++ks) { bf16x8 bf = *(const bf16x8*)(B_l + (jb * 16 + fr) * 136 + ks * 32 + fq * 8); cb[jb] = MFMA16(bf, cf[ks], cb[jb]); }
      }
    }
    const float alast = acum_l[127];
#pragma unroll
    for (int r2 = 0; r2 < 2; ++r2) {
      int pp = (tid >> 4) + 32 * r2, jc = tid & 15;
      u32x4 xv = *(const u32x4*)(xT_l + pp * 136 + jc * 8);
      float wj[8];
#pragma unroll
      for (int e = 0; e < 8; ++e) wj[e] = dt_l[jc * 8 + e] * __expf(alast - acum_l[jc * 8 + e]);
      u32x4 ov;
      ov.x = cvt_pk(bflo(xv.x) * wj[0], bfhi(xv.x) * wj[1]); ov.y = cvt_pk(bflo(xv.y) * wj[2], bfhi(xv.y) * wj[3]);
      ov.z = cvt_pk(bflo(xv.z) * wj[4], bfhi(xv.z) * wj[5]); ov.w = cvt_pk(bflo(xv.w) * wj[6], bfhi(xv.w) * wj[7]);
      *(u32x4*)(xw_l + pp * 136 + jc * 8) = ov;
    }
    __syncthreads();
    {
      const int i = wid * 16 + fr;
      const float ai = acum_l[i];
#pragma unroll
      for (int jb = 0; jb < 8; ++jb) {
        f32x4 gv = {0.f, 0.f, 0.f, 0.f};
        if (jb <= wid) {
          f32x4 aj = *(const f32x4*)(acum_l + jb * 16 + fq * 4);
          f32x4 dj = *(const f32x4*)(dt_l + jb * 16 + fq * 4);
#pragma unroll
          for (int e = 0; e < 4; ++e) { int j = jb * 16 + fq * 4 + e; gv[e] = (j <= i) ? cb[jb][e] * __expf(ai - aj[e]) * dj[e] : 0.f; }
        }
        *(u32x2*)(G_l + i * 136 + jb * 16 + fq * 4) = pack4(gv);
      }
    }
    __syncthreads();
    {
      const int i = wid * 16 + fr, tok = t0 + i;
      const float ea = __expf(acum_l[i]);
      float ss = 0.f;
      bf16x8 gf[4];
#pragma unroll
      for (int ks = 0; ks < 4; ++ks) gf[ks] = *(const bf16x8*)(G_l + (wid * 16 + fr) * 136 + ks * 32 + fq * 8);
#pragma unroll
      for (int pb = 0; pb < 4; ++pb) {
        f32x4 y = {0.f, 0.f, 0.f, 0.f};
#pragma unroll
        for (int ks = 0; ks < 4; ++ks) { bf16x8 hf = *(const bf16x8*)(h_l + (pb * 16 + fr) * 136 + ks * 32 + fq * 8); y = MFMA16(hf, cf[ks], y); }
        y = y * ea;
#pragma unroll
        for (int ks = 0; ks < 4; ++ks) {
          if (ks <= (wid >> 1)) {
            bf16x8 xf = *(const bf16x8*)(xT_l + (pb * 16 + fr) * 136 + ks * 32 + fq * 8);
            y = MFMA16(xf, gf[ks], y);
          }
        }
        const int pc = pb * 16 + fq * 4;
        f32x4 zs = unpack4(zsr[pb]);
#pragma unroll
        for (int e = 0; e < 4; ++e) { float xv = bf2f(xT_l[(pc + e) * 136 + i]); y[e] = (y[e] + xv * Dh) * zs[e]; ss += y[e] * y[e]; }
        *(u32x2*)(Y + (size_t)tok * 1024 + h * 64 + pc) = pack4(y);
      }
      ss += shfl_xor_f(ss, 16); ss += shfl_xor_f(ss, 32);
      if (fq == 0) { YPS[(size_t)tok * 32 + g * 16 + (h & 7) * 2] = ss; YPS[(size_t)tok * 32 + g * 16 + (h & 7) * 2 + 1] = 0.f; }
    }
    {
      const float dl = __expf(alast);
      bf16x8 btf[4];
#pragma unroll
      for (int ks = 0; ks < 4; ++ks) btf[ks] = *(const bf16x8*)(BT_l + (wid * 16 + fr) * 136 + ks * 32 + fq * 8);
#pragma unroll
      for (int pb = 0; pb < 4; ++pb) {
        hacc[pb] = hacc[pb] * dl;
#pragma unroll
        for (int ks = 0; ks < 4; ++ks) {
          bf16x8 xwf = *(const bf16x8*)(xw_l + (pb * 16 + fr) * 136 + ks * 32 + fq * 8);
          hacc[pb] = MFMA16(btf[ks], xwf, hacc[pb]);
        }
      }
    }
  }
#undef SSD_PREFETCH
#pragma unroll
  for (int pb = 0; pb < 4; ++pb)
    st_nt(p.out + O_SSMP + ((size_t)(b * 16 + h) * 64 + pb * 16 + fr) * 128 + wid * 16 + fq * 4, hacc[pb]);
}

__device__ __forceinline__ void memkv_tile(const Params& p, int item, const int wv, unsigned* bar) {
  const int wid = wv, wr = wid >> 2, wc = wid & 3;
  const int h = item & 3, b = item >> 2;
  char* ws = p.ws;
  Acc acc; ACC_ZERO(acc);
  kloop((const u16*)(ws + OFF_MN) + (size_t)(b * 256) * 1024, 1024, (const u16*)(ws + OFF_WKV) + (size_t)(h * 256) * 1024, 1024, 1024, acc, wv);
  ACC_FOREACH({
    const int row = b * 256 + rrow;
    const int col = (rcol < 128) ? (h * 128 + rcol) : (512 + h * 128 + rcol - 128);
    epiB<5>(p, row, col, v);
  });
  asm volatile("s_waitcnt vmcnt(0)" ::: "memory");
  __syncthreads();
  if (wv == 0) { if (lane_fresh() == 0) { __builtin_amdgcn_fence(__ATOMIC_RELEASE, "agent"); asm volatile("s_waitcnt vmcnt(0)" ::: "memory"); (void)xb_add(&bar[6144 + item * 16], 1u); } }
}

__device__ __forceinline__ void attn_prompt_item(const Params& p, int item, const int wv, unsigned* bar) {
  const int lane = lane_fresh(), wid = wv, tid = wv * 64 + lane, fr = lane & 15, fq = lane >> 4;
  const int qt = item & 7, h = (item >> 3) & 3, b = item >> 5;
  char* ws = p.ws;
  u16* K_l = (u16*)g_shm;
  u16* VT_l = K_l + 256 * 136;
  const u16* KP = (const u16*)(ws + OFF_KP);
  const u16* VT = (const u16*)(ws + OFF_VT);
  u16* Q = (u16*)((char*)p.out + OOFF_Q);
  if (wv == 0) { if (lane == 0) { XB_SPIN(xb_ld(&bar[6144 + (b * 4 + h) * 16]) == 0u, bar); } }
  __syncthreads();
  __builtin_amdgcn_fence(__ATOMIC_ACQUIRE, "agent");
#pragma unroll
  for (int i = 0; i < 8; ++i) {
    int idx = i * 512 + tid, mm = idx >> 4, ch = idx & 15;
    *(u32x4*)(K_l + mm * 136 + ch * 8) = *(const u32x4*)(KP + (size_t)(b * 256 + mm) * 512 + h * 128 + ch * 8);
  }
#pragma unroll
  for (int i = 0; i < 8; ++i) {
    int idx = i * 512 + tid, d = idx >> 5, ch = idx & 31;
    *(u32x4*)(VT_l + d * 264 + ch * 8) = *(const u32x4*)(VT + ((size_t)(b * 4 + h) * 128 + d) * 256 + ch * 8);
  }
  const int q0 = b * 2048 + qt * 256 + wid * 32;
  bf16x8 qf[2][4];
#pragma unroll
  for (int qb = 0; qb < 2; ++qb)
#pragma unroll
    for (int ks = 0; ks < 4; ++ks) qf[qb][ks] = *(const bf16x8*)(Q + (size_t)(q0 + qb * 16 + fr) * 512 + h * 128 + ks * 32 + fq * 8);
  __syncthreads();
  f32x4 s[16][2];
#pragma unroll
  for (int mb = 0; mb < 16; ++mb) {
    s[mb][0] = (f32x4){0.f, 0.f, 0.f, 0.f}; s[mb][1] = (f32x4){0.f, 0.f, 0.f, 0.f};
#pragma unroll
    for (int ks = 0; ks < 4; ++ks) {
      bf16x8 kf = *(const bf16x8*)(K_l + (mb * 16 + fr) * 136 + ks * 32 + fq * 8);
      s[mb][0] = MFMA16(kf, qf[0][ks], s[mb][0]);
      s[mb][1] = MFMA16(kf, qf[1][ks], s[mb][1]);
    }
  }
  const float cexp = 0.08838834764831845f * 1.4426950408889634f;
  float inv[2];
  bf16x8 pf[2][8];
#pragma unroll
  for (int qb = 0; qb < 2; ++qb) {
    float mx = -1e30f;
#pragma unroll
    for (int mb = 0; mb < 16; ++mb) mx = fmaxf(mx, fmaxf(fmaxf(s[mb][qb][0], s[mb][qb][1]), fmaxf(s[mb][qb][2], s[mb][qb][3])));
    mx = fmaxf(mx, shfl_xor_f(mx, 16)); mx = fmaxf(mx, shfl_xor_f(mx, 32));
    float sum = 0.f;
#pragma unroll
    for (int mb = 0; mb < 16; ++mb)
#pragma unroll
      for (int e = 0; e < 4; ++e) { float pv = exp2f((s[mb][qb][e] - mx) * cexp); s[mb][qb][e] = pv; sum += pv; }
    sum += shfl_xor_f(sum, 16); sum += shfl_xor_f(sum, 32);
    inv[qb] = 1.f / sum;
#pragma unroll
    for (int st = 0; st < 8; ++st) {
      u32x2 lo = pack4(s[2 * st][qb]), hi = pack4(s[2 * st + 1][qb]);
      u32x4 w = {lo.x, lo.y, hi.x, hi.y};
      pf[qb][st] = __builtin_bit_cast(bf16x8, w);
    }
  }
  f32x4 o[8][2];
#pragma unroll
  for (int db = 0; db < 8; ++db) { o[db][0] = (f32x4){0.f, 0.f, 0.f, 0.f}; o[db][1] = (f32x4){0.f, 0.f, 0.f, 0.f}; }
#pragma unroll
  for (int st = 0; st < 8; ++st)
#pragma unroll
    for (int db = 0; db < 8; ++db) {
      bf16x8 vf = *(const bf16x8*)(VT_l + (db * 16 + fr) * 264 + st * 32 + fq * 8);
      o[db][0] = MFMA16(vf, pf[0][st], o[db][0]);
      o[db][1] = MFMA16(vf, pf[1][st], o[db][1]);
    }
#pragma unroll
  for (int qb = 0; qb < 2; ++qb)
#pragma unroll
    for (int db = 0; db < 8; ++db)
      *(u32x2*)((u16*)(ws + OFF_XA) + (size_t)(q0 + qb * 16 + fr) * 512 + h * 128 + db * 16 + fq * 4) = pack4(o[db][qb] * inv[qb]);
}

__device__ __forceinline__ void gmlp_prompt_item(const Params& p, int item, const int wv) {
  const int lane = lane_fresh(), wid = wv, tid = wv * 64 + lane, fr = lane & 15, fq = lane >> 4;
  const int gp = item & 1, c = (item >> 1) & 15, b = item >> 5;
  const int t0 = b * 2048 + c * 128;
  char* ws = p.ws;
  u16* VnT = (u16*)g_shm;
  const u16* UV = (const u16*)(ws + OFF_UV);
  const u16* WSB = (const u16*)(ws + OFF_WSB);
  u16* GM = (u16*)((char*)p.out + OOFF_GM);
  __syncthreads();
  {
    const int row = tid >> 2, qq = tid & 3;
    const u16* vrow = UV + (size_t)(t0 + row) * 1024 + 512;
    float sm = 0.f, sq = 0.f;
#pragma unroll
    for (int i = 0; i < 16; ++i) {
      u32x4 w = *(const u32x4*)(vrow + qq * 128 + i * 8);
      float f[8] = {bflo(w.x), bfhi(w.x), bflo(w.y), bfhi(w.y), bflo(w.z), bfhi(w.z), bflo(w.w), bfhi(w.w)};
#pragma unroll
      for (int e = 0; e < 8; ++e) { sm += f[e]; sq += f[e] * f[e]; }
    }
    sm += shfl_xor_f(sm, 1); sm += shfl_xor_f(sm, 2); sq += shfl_xor_f(sq, 1); sq += shfl_xor_f(sq, 2);
    const float mean = sm * (1.f / 512.f), var = fmaxf(sq * (1.f / 512.f) - mean * mean, 0.f), rstd = rsqrtf(var + EPS);
#pragma unroll
    for (int i = 0; i < 8; ++i) {
      const int cl = qq * 64 + i * 8, col = gp * 256 + cl;
      u32x4 w = *(const u32x4*)(vrow + col);
      float f[8] = {bflo(w.x), bfhi(w.x), bflo(w.y), bfhi(w.y), bflo(w.z), bfhi(w.z), bflo(w.w), bfhi(w.w)};
#pragma unroll
      for (int e = 0; e < 8; ++e) {
        float vn = (f[e] - mean) * rstd * p.in[9][col + e] + p.in[10][col + e];
        VnT[(cl + e) * 136 + row] = f2bf(vn);
      }
    }
  }
  __syncthreads();
  f32x4 acc[16];
#pragma unroll
  for (int db = 0; db < 16; ++db) acc[db] = (f32x4){0.f, 0.f, 0.f, 0.f};
#pragma unroll
  for (int ks = 0; ks < 4; ++ks) {
    if (ks <= (wid >> 1)) {
      bf16x8 w0 = *(const bf16x8*)(WSB + ((size_t)(gp * 2) * 128 + wid * 16 + fr) * 128 + ks * 32 + fq * 8);
      bf16x8 w1 = *(const bf16x8*)(WSB + ((size_t)(gp * 2 + 1) * 128 + wid * 16 + fr) * 128 + ks * 32 + fq * 8);
#pragma unroll
      for (int db = 0; db < 16; ++db) {
        bf16x8 vf = *(const bf16x8*)(VnT + (db * 16 + fr) * 136 + ks * 32 + fq * 8);
        acc[db] = MFMA16(vf, db < 8 ? w0 : w1, acc[db]);
      }
    }
  }
  const int tt = wid * 16 + fr, tok = t0 + tt;
#pragma unroll
  for (int db = 0; db < 16; ++db) {
    const int gs = gp * 2 + (db >> 3), col = gs * 128 + (db & 7) * 16 + fq * 4;
    const float bsv = p.in[12][gs * 128 + tt];
    f32x4 u = unpack4(*(const u32x2*)(UV + (size_t)tok * 1024 + col));
    f32x4 o = u * (acc[db] + bsv);
    *(u32x2*)(GM + (size_t)tok * 512 + col) = pack4(o);
  }
}

__device__ __forceinline__ void gmlp_sample_row(const Params& p, int bidx, const int wv) {
  const int lane = lane_fresh();
  char* ws = p.ws;
  const u16* UV = (const u16*)(ws + OFF_UV);
  u16* GM = (u16*)((char*)p.out + OOFF_GM);
  const int tok = TP + bidx;
  u32x4 w = *(const u32x4*)(UV + (size_t)tok * 1024 + 512 + lane * 8);
  float f[8] = {bflo(w.x), bfhi(w.x), bflo(w.y), bfhi(w.y), bflo(w.z), bfhi(w.z), bflo(w.w), bfhi(w.w)};
  float sm = 0.f, sq = 0.f;
#pragma unroll
  for (int e = 0; e < 8; ++e) { sm += f[e]; sq += f[e] * f[e]; }
  sm = wave_sum(sm); sq = wave_sum(sq);
  const float mean = sm * (1.f / 512.f), var = fmaxf(sq * (1.f / 512.f) - mean * mean, 0.f), rstd = rsqrtf(var + EPS);
  const int col = lane * 8, gs = col >> 7;
  const float w00 = p.in[11][gs * 16384], bs0 = p.in[12][gs * 128];
  u32x4 uw = *(const u32x4*)(UV + (size_t)tok * 1024 + col);
  float u[8] = {bflo(uw.x), bfhi(uw.x), bflo(uw.y), bfhi(uw.y), bflo(uw.z), bfhi(uw.z), bflo(uw.w), bfhi(uw.w)};
  float vn[8], o[8];
#pragma unroll
  for (int e = 0; e < 8; ++e) { vn[e] = (f[e] - mean) * rstd * p.in[9][col + e] + p.in[10][col + e]; o[e] = u[e] * (w00 * vn[e] + bs0); }
  *(f32x4*)(p.out + O_GMV + (size_t)bidx * 512 + col) = (f32x4){vn[0], vn[1], vn[2], vn[3]};
  *(f32x4*)(p.out + O_GMV + (size_t)bidx * 512 + col + 4) = (f32x4){vn[4], vn[5], vn[6], vn[7]};
  u32x4 ow = {cvt_pk(o[0], o[1]), cvt_pk(o[2], o[3]), cvt_pk(o[4], o[5]), cvt_pk(o[6], o[7])};
  *(u32x4*)(GM + (size_t)tok * 512 + col) = ow;
}

__device__ __forceinline__ void ssd_sample_item(const Params& p, int item, const int wv) {
  const int lane = lane_fresh();
  const int h = item & 15, b = item >> 4, g = h >> 3, tok = TP + b;
  char* ws = p.ws;
  const u16* XBC = (const u16*)(ws + OFF_XBC);
  const u16* ZS = (const u16*)(ws + OFF_ZS);
  const float* DT = (const float*)(ws + OFF_DT);
  u16* Y = (u16*)((char*)p.out + OOFF_XN);
  float* YPS = (float*)(ws + OFF_YPS);
  const float* sc = p.in[5] + (size_t)b * 4608;
  const float* convw = p.in[13];
  const float* convb = p.in[14];
  auto conv1 = [&](int col) -> float {
    float o = convb[col] + convw[col] * sc[col] + convw[1536 + col] * sc[1536 + col] + convw[3072 + col] * sc[3072 + col]
            + convw[4608 + col] * bf2f(XBC[(size_t)tok * 1536 + col]);
    return silu_f(o);
  };
  const float x = conv1(h * 64 + lane);
  const int n4 = (lane & 31) * 4, hf = lane >> 5;
  float Bv[4], Cv[4];
#pragma unroll
  for (int e = 0; e < 4; ++e) { Bv[e] = conv1(1024 + g * 128 + n4 + e); Cv[e] = conv1(1280 + g * 128 + n4 + e); }
  const float dt = DT[(size_t)tok * 16 + h];
  const float dA = __expf(-dt * __expf(p.in[16][h]));
  const float* st = p.in[6] + ((size_t)(b * 16 + h) * 64) * 128;
  float* so = p.out + O_SSMS + ((size_t)(b * 16 + h) * 64) * 128;
  float ymine = 0.f;
#pragma unroll 8
  for (int r = 0; r < 32; ++r) {
    const int pp = 2 * r + hf;
    f32x4 hv = ld_nt(st + (size_t)pp * 128 + n4);
    const float xp = shfl_idx_f(x, pp) * dt;
    f32x4 hn;
    float yp = 0.f;
#pragma unroll
    for (int e = 0; e < 4; ++e) { hn[e] = dA * hv[e] + xp * Bv[e]; yp += hn[e] * Cv[e]; }
    st_nt(so + (size_t)pp * 128 + n4, hn);
#pragma unroll
    for (int o = 16; o >= 1; o >>= 1) yp += shfl_xor_f(yp, o);
    if ((lane & 31) == r) ymine = yp;
  }
  const int pm = 2 * (lane & 31) + hf;
  const float xm = shfl_idx_f(x, pm);
  const float zs = bf2f(ZS[(size_t)tok * 1024 + h * 64 + pm]);
  const float yg = (ymine + xm * p.in[17][h]) * zs;
  float ss = wave_sum(yg * yg);
  Y[(size_t)tok * 1024 + h * 64 + pm] = f2bf(yg);
  if (lane == 0) { YPS[(size_t)tok * 32 + g * 16 + (h & 7) * 2] = ss; YPS[(size_t)tok * 32 + g * 16 + (h & 7) * 2 + 1] = 0.f; }
}

__device__ __forceinline__ void attn_sample_item(const Params& p, int item, const int wv) {
  const int lane = lane_fresh(), wid = wv, tid = wv * 64 + lane;
  const int h = item & 3, b = item >> 2, tok = TP + b;
  float* sc_l = (float*)g_shm;
  float* red_l = sc_l + 256;
  u16* Q = (u16*)((char*)p.out + OOFF_Q);
  const float* Kc = p.in[3] + ((size_t)b * 256 * 4 + h) * 128;
  const float* Vc = p.in[4] + ((size_t)b * 256 * 4 + h) * 128;
  const int vdch = tid & 31, vmg = tid >> 5;
  f32x4 vreg[16];
#pragma unroll
  for (int i = 0; i < 16; ++i) vreg[i] = ld_nt(Vc + (size_t)(vmg * 16 + i) * 512 + vdch * 4);
  __syncthreads();
  {
    const int dch = lane & 15, ksub = lane >> 4;
    u32x4 qw = *(const u32x4*)(Q + (size_t)tok * 512 + h * 128 + dch * 8);
    float q[8] = {bflo(qw.x), bfhi(qw.x), bflo(qw.y), bfhi(qw.y), bflo(qw.z), bfhi(qw.z), bflo(qw.w), bfhi(qw.w)};
#pragma unroll
    for (int it = 0; it < 8; ++it) {
      const int mm = wid * 32 + it * 4 + ksub;
      f32x4 k0 = ld_nt(Kc + (size_t)mm * 512 + dch * 8), k1 = ld_nt(Kc + (size_t)mm * 512 + dch * 8 + 4);
      float d = q[0] * k0[0] + q[1] * k0[1] + q[2] * k0[2] + q[3] * k0[3] + q[4] * k1[0] + q[5] * k1[1] + q[6] * k1[2] + q[7] * k1[3];
      d += shfl_xor_f(d, 1); d += shfl_xor_f(d, 2); d += shfl_xor_f(d, 4); d += shfl_xor_f(d, 8);
      if (dch == 0) sc_l[mm] = d * 0.08838834764831845f;
    }
  }
  __syncthreads();
  float pv[4];
  {
    float mx = -1e30f;
#pragma unroll
    for (int i = 0; i < 4; ++i) { pv[i] = sc_l[lane + 64 * i]; mx = fmaxf(mx, pv[i]); }
    mx = wave_max(mx);
    float sum = 0.f;
#pragma unroll
    for (int i = 0; i < 4; ++i) { pv[i] = __expf(pv[i] - mx); sum += pv[i]; }
    sum = wave_sum(sum);
    const float inv = 1.f / sum;
#pragma unroll
    for (int i = 0; i < 4; ++i) pv[i] *= inv;
  }
  __syncthreads();
  if (wid == 0) {
#pragma unroll
    for (int i = 0; i < 4; ++i) sc_l[lane + 64 * i] = pv[i];
  }
  __syncthreads();
  {
    f32x4 acc = {0.f, 0.f, 0.f, 0.f};
#pragma unroll
    for (int i = 0; i < 16; ++i) acc += vreg[i] * sc_l[vmg * 16 + i];
    *(f32x4*)(red_l + vmg * 128 + vdch * 4) = acc;
  }
  __syncthreads();
  if (tid < 128) {
    float o = 0.f;
#pragma unroll
    for (int mg = 0; mg < 16; ++mg) o += red_l[mg * 128 + tid];
    ((u16*)(p.ws + OFF_XA))[(size_t)tok * 512 + h * 128 + tid] = f2bf(o);
  }
}

__device__ __forceinline__ void phaseC(const Params& p, const int wv, const int r0, const int r1, const int r2, const int r3, const int r4, unsigned* bar) {
  const int wid = wv;
  const int nS = gridDim.x >> 1;
  if ((int)blockIdx.x < nS) {
    for (int it = blockIdx.x; it < 128 * r0; it += nS) ssd_prompt_item(p, it & 127, wv);
  } else {
    const int ob = blockIdx.x - nS, nO = gridDim.x - nS;
    const int gw = ob * 8 + wid, nw = nO * 8;
    for (int it = ob; it < 32; it += nO) memkv_tile(p, it, wv, bar);
    for (int it = gw; it < 2048 * r1; it += nw) ssd_sample_item(p, it & 2047, wv);
    if (nO >= 64) {
      if (ob < 32) attn_sample_item(p, ob, wv);
      else for (int it = 32 + (ob - 32); it < 512; it += nO - 32) attn_sample_item(p, it, wv);
    } else {
      for (int it = ob; it < 512; it += nO) attn_sample_item(p, it, wv);
    }
    for (int it = ob; it < 256 * r2; it += nO) attn_prompt_item(p, it & 255, wv, bar);
    for (int it = ob; it < 256 * r3; it += nO) gmlp_prompt_item(p, it & 255, wv);
    for (int it = gw; it < 128; it += nw) gmlp_sample_row(p, it, wv);
  }
}

__device__ __forceinline__ void phaseD(const Params& p, const int wv, const int rep) {
  const int wid = wv, wr = wid >> 2, wc = wid & 3;
  char* ws = p.ws;
  const u16* GM = (const u16*)((char*)p.out + OOFF_GM);
  const u16* Y = (const u16*)((char*)p.out + OOFF_XN);
  const u16* XA = (const u16*)(ws + OFF_XA);
  const u16* GATE = (const u16*)(ws + OFF_GATE);
  const float* YPS = (const float*)(ws + OFF_YPS);
  u16* MERGED = (u16*)(ws + OFF_MERGED);
  const u16* WGM = (const u16*)(ws + OFF_WGM);
  const u16* WSSD = (const u16*)(ws + OFF_WSSD);
  const u16* WXA = (const u16*)(ws + OFF_WXA);
  float* rs_l = (float*)(g_shm + 131072);
  for (int t_ = blockIdx.x; t_ < 256 * rep; t_ += gridDim.x) {
    const int t = t_ & 255;
    const int pm = t & 63, pn = t >> 6, brow = pm * 256, bcol = pn * 256;
    __syncthreads();
    {
      const int tid = wv * 64 + lane_fresh();
      const int r = tid >> 1, gg = tid & 1;
      const float* ps = YPS + (size_t)(brow + r) * 32 + gg * 16;
      f32x4 a = *(const f32x4*)ps + *(const f32x4*)(ps + 4) + *(const f32x4*)(ps + 8) + *(const f32x4*)(ps + 12);
      rs_l[r * 2 + gg] = rsqrtf((a[0] + a[1] + a[2] + a[3]) * (1.f / 512.f) + EPS);
    }
    auto opnd = [&](int br, const u16*& Ap, const u16*& Bp, int& ld) {
      if (br == 0) { Ap = GM + (size_t)brow * 512; Bp = WGM + (size_t)bcol * 512; ld = 512; }
      else if (br == 1) { Ap = Y + (size_t)brow * 1024; Bp = WSSD + (size_t)bcol * 1024; ld = 1024; }
      else if (br == 2) { Ap = Y + (size_t)brow * 1024 + 512; Bp = WSSD + (size_t)bcol * 1024 + 512; ld = 1024; }
      else { Ap = XA + (size_t)brow * 512; Bp = WXA + (size_t)bcol * 512; ld = 512; }
    };
    Acc acc; ACC_ZERO(acc);
    { const u16 *Ap, *Bp; int ld; opnd(0, Ap, Bp, ld); kloop_t<1, true>(Ap, ld, Bp, ld, 512, acc, wv); }
#pragma unroll 1
    for (int br = 0; br < 4; ++br) {
      const u16 *Ap, *Bp; int ld; opnd(br, Ap, Bp, ld);
      kloop_t<2>(Ap, ld, Bp, ld, 512, acc, wv);
      const int gnum = (br == 0) ? 0 : (br == 2) ? 1024 : 2048, gden = (br == 0) ? 1024 : 2048;
      const int lane_e = lane_fresh(), fr = lane_e & 15, fq = lane_e >> 4;
      const int r0 = brow + wr * 64 + fr, c0 = bcol + wc * 32 + fq * 4;
      u32x2 gq[2][4], dq[2][4];
#define D_LOAD(g, buf) do { const int row_ = r0 + ((g) >> 2) * 128 + ((g) & 3) * 16; \
        _Pragma("unroll") for (int q = 0; q < 4; ++q) { const int col_ = c0 + (q >> 1) * 128 + (q & 1) * 16; \
          gq[buf][q] = (u32x2){0x3f803f80u, 0x3f803f80u}; dq[buf][q] = (u32x2){0x3f803f80u, 0x3f803f80u}; \
          if (br != 1) gq[buf][q] = *(const u32x2*)(GATE + (size_t)row_ * 3072 + gnum + col_); \
          if (br == 0 || br == 2) dq[buf][q] = *(const u32x2*)(GATE + (size_t)row_ * 3072 + gden + col_); } } while (0)
      D_LOAD(0, 0);
      if (br < 3) { const u16 *An, *Bn; int ldn; opnd(br + 1, An, Bn, ldn); kloop_t<1, false>(An, ldn, Bn, ldn, 512, acc, wv); }
#pragma unroll
      for (int g = 0; g < 8; ++g) {
        if (g < 7) D_LOAD(g + 1, (g + 1) & 1);
        __builtin_amdgcn_sched_barrier(0);
        const int ai = g >> 2, m = g & 3, rrow = ai * 128 + wr * 64 + m * 16 + fr, row_ = brow + rrow;
        const float rs0 = rs_l[rrow * 2], rs1 = rs_l[rrow * 2 + 1];
        const float rsc = (br == 0) ? __builtin_amdgcn_rcpf(rs0) : (br == 1) ? rs0 * __builtin_amdgcn_rcpf(rs1) : (br == 2) ? rs1 : 1.f;
#pragma unroll
        for (int q = 0; q < 4; ++q) {
          const int col_ = c0 + (q >> 1) * 128 + (q & 1) * 16;
          const f32x4 gn = unpack4(gq[g & 1][q]), gd = unpack4(dq[g & 1][q]);
          f32x4 sc;
#pragma unroll
          for (int e = 0; e < 4; ++e) sc[e] = gn[e] * rsc * __builtin_amdgcn_rcpf(fmaxf(gd[e], 1e-30f));
          f32x4 o = acc[ai][q >> 1][m][q & 1] * sc;
          acc[ai][q >> 1][m][q & 1] = o;
          if (br == 3) *(u32x2*)(MERGED + (size_t)row_ * 1024 + col_) = pack4(o);
        }
        __builtin_amdgcn_sched_barrier(0);
      }
#undef D_LOAD
    }
  }
  for (int gb = blockIdx.x; gb < 256; gb += gridDim.x) {
    const int task0 = gb * 2, mt = task0 >> 6, nt0 = task0 & 63, r0 = TP + mt * 16;
    skgemm<8>([&](int i) { const int br = i & 3; return br == 0 ? GM + (size_t)r0 * 512 : br == 1 ? Y + (size_t)r0 * 1024 : br == 2 ? Y + (size_t)r0 * 1024 + 512 : XA + (size_t)r0 * 512; },
              [&](int i) { const int br = i & 3, c0 = (nt0 + (i >> 2)) * 16; return br == 0 ? WGM + (size_t)c0 * 512 : br == 1 ? WSSD + (size_t)c0 * 1024 : br == 2 ? WSSD + (size_t)c0 * 1024 + 512 : WXA + (size_t)c0 * 512; },
              [&](int i) { const int br = i & 3; return (br == 1 || br == 2) ? 1024 : 512; }, 64, wv);
    if (wv < 2) {
      const int lane_e = lane_fresh(), fr = lane_e & 15, fq = lane_e >> 4;
      const int row = r0 + fr, col = (nt0 + wv) * 16 + fq * 4;
      const u16* gp_ = GATE + (size_t)row * 3072 + col;
      f32x4 g0 = unpack4(*(const u32x2*)gp_), g1 = unpack4(*(const u32x2*)(gp_ + 1024)), g2 = unpack4(*(const u32x2*)(gp_ + 2048));
      float rs[2];
#pragma unroll
      for (int gg = 0; gg < 2; ++gg) {
        const float* ps = YPS + (size_t)row * 32 + gg * 16;
        f32x4 a = *(const f32x4*)ps + *(const f32x4*)(ps + 4) + *(const f32x4*)(ps + 8) + *(const f32x4*)(ps + 12);
        rs[gg] = rsqrtf((a[0] + a[1] + a[2] + a[3]) * (1.f / 512.f) + EPS);
      }
      f32x4 a0 = skreduce(wv * 4 + 0), a1 = skreduce(wv * 4 + 1), a2 = skreduce(wv * 4 + 2), a3 = skreduce(wv * 4 + 3);
      f32x4 o = g0 * a0 + g1 * (a1 * rs[0] + a2 * rs[1]) + g2 * a3;
      *(u32x2*)(MERGED + (size_t)row * 1024 + col) = pack4(o);
    }
  }
}

__device__ __forceinline__ void phaseE(const Params& p, const int wv, const int rep) {
  const int wid = wv, wr = wid >> 2, wc = wid & 3;
  char* ws = p.ws;
  const u16* MERGED = (const u16*)(ws + OFF_MERGED);
  const u16* WOUT = (const u16*)(ws + OFF_WOUT);
  u16* H2B = (u16*)(ws + OFF_H2B);
  float* PS = (float*)(ws + OFF_PS);
  float* PSS = (float*)(ws + OFF_PSS);
  for (int t_ = blockIdx.x; t_ < 256 * rep; t_ += gridDim.x) {
    const int t = t_ & 255;
    const int pm = t & 63, pn = t >> 6, brow = pm * 256, bcol = pn * 256;
    Acc acc; ACC_ZERO(acc);
    kloop(MERGED + (size_t)brow * 1024, 1024, WOUT + (size_t)bcol * 1024, 1024, 1024, acc, wv);
    const int lane_e = lane_fresh(), fr = lane_e & 15, fq = lane_e >> 4; (void)fr; (void)fq;
#pragma unroll
    for (int ai = 0; ai < 2; ++ai)
#pragma unroll
      for (int m = 0; m < 4; ++m) {
        const int row = brow + ai * 128 + wr * 64 + m * 16 + fr;
        float ss = 0.f;
#pragma unroll
        for (int bj = 0; bj < 2; ++bj)
#pragma unroll
          for (int n = 0; n < 2; ++n) {
            const int col = bcol + bj * 128 + wc * 32 + n * 16 + fq * 4;
            f32x4 v = acc[ai][bj][m][n] + *(const f32x4*)(p.in[0] + (size_t)row * 1024 + col);
            *(u32x2*)(H2B + (size_t)row * 1024 + col) = pack4(v);
            ss += v[0] * v[0] + v[1] * v[1] + v[2] * v[2] + v[3] * v[3];
          }
        ss += shfl_xor_f(ss, 16); ss += shfl_xor_f(ss, 32);
        if (fq == 0) PS[(size_t)row * 16 + pn * 4 + wc] = ss;
      }
  }
  for (int gb = blockIdx.x; gb < 256; gb += gridDim.x) {
    const int task0 = gb * 2, mt = task0 >> 6, nt0 = task0 & 63;
    const u16* Ab = MERGED + (size_t)(TP + mt * 16) * 1024;
    skgemm<2>([&](int) { return Ab; }, [&](int i) { return WOUT + (size_t)((nt0 + i) * 16) * 1024; }, [&](int) { return 1024; }, 128, wv);
    if (wv < 2) {
      const int lane_e = lane_fresh(), fr = lane_e & 15, fq = lane_e >> 4;
      const int ntl = nt0 + wv, row = TP + mt * 16 + fr, col = ntl * 16 + fq * 4;
      f32x4 v = skreduce(wv) + *(const f32x4*)(p.in[1] + (size_t)(row - TP) * 1024 + col);
      *(u32x2*)(H2B + (size_t)row * 1024 + col) = pack4(v);
      float ss = v[0] * v[0] + v[1] * v[1] + v[2] * v[2] + v[3] * v[3];
      ss += shfl_xor_f(ss, 16); ss += shfl_xor_f(ss, 32);
      if (fq == 0) PSS[(size_t)(row - TP) * 64 + ntl] = ss;
    }
  }
}

__device__ __forceinline__ void phaseF(const Params& p, const int wv, const int rep) {
  const int wid = wv, wr = wid >> 2, wc = wid & 3;
  char* ws = p.ws;
  const u16* H2B = (const u16*)(ws + OFF_H2B);
  const u16* WUP = (const u16*)(ws + OFF_WUP);
  u16* ACT = (u16*)(ws + OFF_ACT);
  const float* PS = (const float*)(ws + OFF_PS);
  const float* PSS = (const float*)(ws + OFF_PSS);
  {
    float* rs_l = (float*)(g_shm + 131072);
    auto fill_rs = [&](int t, int buf) {
      const int tid = wv * 64 + lane_fresh();
      if (tid < 256) {
        const float* ps = PS + (size_t)((t & 63) * 256 + tid) * 16;
        f32x4 a = *(const f32x4*)ps + *(const f32x4*)(ps + 4) + *(const f32x4*)(ps + 8) + *(const f32x4*)(ps + 12);
        rs_l[buf * 256 + tid] = rsqrtf((a[0] + a[1] + a[2] + a[3]) * (1.f / 1024.f) + EPS);
      }
    };
    int t_ = blockIdx.x, it = 0;
    const int tend = 1024 * rep;
    Acc acc;
    if (t_ < tend) {
      const int t = t_ & 1023;
      fill_rs(t, 0);
      kloop_t<1, true>(H2B + (size_t)((t & 63) * 256) * 1024, 1024, WUP + (size_t)((t >> 6) * 256) * 1024, 1024, 1024, acc, wv);
    }
    while (t_ < tend) {
      const int t = t_ & 1023;
      const int pm = t & 63, pn = t >> 6, brow = pm * 256, bcol = pn * 256;
      ACC_ZERO(acc);
      kloop_t<2>(H2B + (size_t)brow * 1024, 1024, WUP + (size_t)bcol * 1024, 1024, 1024, acc, wv);
      t_ += gridDim.x;
      if (t_ < tend) {
        const int tn = t_ & 1023;
        fill_rs(tn, (it + 1) & 1);
        kloop_t<1, false>(H2B + (size_t)((tn & 63) * 256) * 1024, 1024, WUP + (size_t)((tn >> 6) * 256) * 1024, 1024, 1024, acc, wv);
      }
      const float* rs_c = rs_l + (it & 1) * 256;
      ACC_FOREACH({
        const float rstd = rs_c[rrow];
        f32x4 o = v * rstd;
        o[0] = fmaxf(o[0], 0.f); o[1] = fmaxf(o[1], 0.f); o[2] = fmaxf(o[2], 0.f); o[3] = fmaxf(o[3], 0.f);
        o = o * o;
        *(u32x2*)(ACT + (size_t)(brow + rrow) * 4096 + bcol + rcol) = pack4(o);
      });
      ++it;
    }
  }
  for (int gb = blockIdx.x; gb < 256; gb += gridDim.x) {
    const int task0 = gb * 8, mt = task0 >> 8, nt0 = task0 & 255;
    const u16* Ab = H2B + (size_t)(TP + mt * 16) * 1024;
    skgemm<8>([&](int) { return Ab; }, [&](int i) { return WUP + (size_t)((nt0 + i) * 16) * 1024; }, [&](int) { return 1024; }, 128, wv);
    {
      const int lane_e = lane_fresh(), fr = lane_e & 15, fq = lane_e >> 4;
      const int ntl = nt0 + wv, row = TP + mt * 16 + fr, col = ntl * 16 + fq * 4;
      const float* ps = PSS + (size_t)(row - TP) * 64 + fq * 16;
      f32x4 a4 = *(const f32x4*)ps + *(const f32x4*)(ps + 4) + *(const f32x4*)(ps + 8) + *(const f32x4*)(ps + 12);
      float sq = a4[0] + a4[1] + a4[2] + a4[3];
      sq += shfl_xor_f(sq, 16); sq += shfl_xor_f(sq, 32);
      const float rstd = rsqrtf(sq * (1.f / 1024.f) + EPS);
      f32x4 v = skreduce(wv) * rstd;
#pragma unroll
      for (int e = 0; e < 4; ++e) { float r = fmaxf(v[e], 0.f); v[e] = r * r; }
      *(u32x2*)(ACT + (size_t)row * 4096 + col) = pack4(v);
    }
  }
}

__device__ __forceinline__ void phaseG(const Params& p, const int wv, const int rep, unsigned* bar, const bool fused) {
  const int wid = wv, wr = wid >> 2, wc = wid & 3;
  char* ws = p.ws;
  const u16* ACT = (const u16*)(ws + OFF_ACT);
  const u16* WDN = (const u16*)(ws + OFF_WDN);
  const u16* H2 = (const u16*)(ws + OFF_H2B);
  unsigned* CNT = bar + 4096;
  unsigned* CNTS = bar + 4096 + 1024;
  float* XS = (float*)(ws + OFF_PS);
  float* XSS = (float*)(ws + OFF_PSS);
  const float* wfin = p.in[29];
  for (int t_ = blockIdx.x; t_ < 256 * rep; t_ += gridDim.x) {
    const int t = t_ & 255;
    const int pm = t & 63, pn = t >> 6, brow = pm * 256, bcol = pn * 256;
    Acc acc; ACC_ZERO(acc);
    kloop(ACT + (size_t)brow * 4096, 4096, WDN + (size_t)bcol * 4096, 4096, 4096, acc, wv);
    if (!fused) {
      ACC_FOREACH({
        const size_t o = (size_t)(brow + rrow) * 1024 + bcol + rcol;
        *(f32x4*)(p.out + O_Y + o) = v + unpack4(*(const u32x2*)(H2 + o));
      });
    } else {
      float* red = (float*)g_shm;
      float* rstd_l = red + 1024;
      {
        const int lane_e = lane_fresh(), fr = lane_e & 15, fq = lane_e >> 4;
#pragma unroll
        for (int ai = 0; ai < 2; ++ai)
#pragma unroll
          for (int m = 0; m < 4; ++m) {
            const int rrow = ai * 128 + wr * 64 + m * 16 + fr;
            float ss = 0.f;
#pragma unroll
            for (int bj = 0; bj < 2; ++bj)
#pragma unroll
              for (int n = 0; n < 2; ++n) {
                const int rcol = bj * 128 + wc * 32 + n * 16 + fq * 4;
                f32x4 v = acc[ai][bj][m][n] + unpack4(*(const u32x2*)(H2 + (size_t)(brow + rrow) * 1024 + bcol + rcol));
                acc[ai][bj][m][n] = v;
                ss += v[0] * v[0] + v[1] * v[1] + v[2] * v[2] + v[3] * v[3];
              }
            ss += shfl_xor_f(ss, 16); ss += shfl_xor_f(ss, 32);
            if (fq == 0) red[rrow * 4 + wc] = ss;
          }
      }
      __syncthreads();
      {
        const int tid = wv * 64 + lane_fresh();
        if (tid < 256) {
          f32x4 r4 = *(const f32x4*)(red + tid * 4);
          __hip_atomic_store(XS + (size_t)(brow + tid) * 4 + pn, r4[0] + r4[1] + r4[2] + r4[3], __ATOMIC_RELAXED, __HIP_MEMORY_SCOPE_AGENT);
        }
        asm volatile("s_waitcnt vmcnt(0)" ::: "memory");
        __syncthreads();
        if (tid == 0) {
          (void)xb_add(&CNT[pm * 16], 1u);
          XB_SPIN(xb_ld(&CNT[pm * 16]) < 4u, bar);
        }
        __syncthreads();
        if (tid < 256) {
          float sq = 0.f;
#pragma unroll
          for (int q = 0; q < 4; ++q) sq += __hip_atomic_load(XS + (size_t)(brow + tid) * 4 + q, __ATOMIC_RELAXED, __HIP_MEMORY_SCOPE_AGENT);
          rstd_l[tid] = rsqrtf(sq * (1.f / 1024.f) + EPS);
        }
        __syncthreads();
      }
      ACC_FOREACH({
        const float rs = rstd_l[rrow];
        const f32x4 wv4 = *(const f32x4*)(wfin + bcol + rcol);
        st_nt(p.out + O_Y + (size_t)(brow + rrow) * 1024 + bcol + rcol, v * rs * wv4);
      });
    }
  }
  for (int gb = blockIdx.x; gb < 256; gb += gridDim.x) {
    const int task0 = gb * 2, mt = task0 >> 6, nt0 = task0 & 63;
    const u16* Ab = ACT + (size_t)(TP + mt * 16) * 4096;
    skgemm<2>([&](int) { return Ab; }, [&](int i) { return WDN + (size_t)((nt0 + i) * 16) * 4096; }, [&](int) { return 4096; }, 512, wv);
    if (!fused) {
      if (wv < 2) {
        const int lane_e = lane_fresh(), fr = lane_e & 15, fq = lane_e >> 4;
        const int row = TP + mt * 16 + fr, col = (nt0 + wv) * 16 + fq * 4;
        const size_t o = (size_t)row * 1024 + col;
        *(f32x4*)(p.out + O_Y + o) = skreduce(wv) + unpack4(*(const u32x2*)(H2 + o));
      }
    } else {
      unsigned* last_l = (unsigned*)g_shm + 8192;
      if (wv < 2) {
        const int lane_e = lane_fresh(), fr = lane_e & 15, fq = lane_e >> 4;
        const int row = TP + mt * 16 + fr, col = (nt0 + wv) * 16 + fq * 4;
        const size_t o = (size_t)row * 1024 + col;
        f32x4 v = skreduce(wv) + unpack4(*(const u32x2*)(H2 + o));
        float* yo = p.out + O_Y + o;
#pragma unroll
        for (int e = 0; e < 4; ++e) __hip_atomic_store(yo + e, v[e], __ATOMIC_RELAXED, __HIP_MEMORY_SCOPE_AGENT);
        float ss = v[0] * v[0] + v[1] * v[1] + v[2] * v[2] + v[3] * v[3];
        ss += shfl_xor_f(ss, 16); ss += shfl_xor_f(ss, 32);
        if (fq == 0) __hip_atomic_store(XSS + (size_t)(row - TP) * 64 + nt0 + wv, ss, __ATOMIC_RELAXED, __HIP_MEMORY_SCOPE_AGENT);
      }
      asm volatile("s_waitcnt vmcnt(0)" ::: "memory");
      __syncthreads();
      const int tid = wv * 64 + lane_fresh();
      if (tid == 0) last_l[0] = (xb_add(&CNTS[mt * 16], 1u) == 31u) ? 1u : 0u;
      __syncthreads();
      if (last_l[0]) {
        __builtin_amdgcn_fence(__ATOMIC_ACQUIRE, "agent");
        const int r = tid >> 5, c32 = tid & 31;
        float* yrow = p.out + O_Y + (size_t)(TP + mt * 16 + r) * 1024;
        float sq = __hip_atomic_load(XSS + (size_t)(mt * 16 + r) * 64 + c32 * 2, __ATOMIC_RELAXED, __HIP_MEMORY_SCOPE_AGENT)
                 + __hip_atomic_load(XSS + (size_t)(mt * 16 + r) * 64 + c32 * 2 + 1, __ATOMIC_RELAXED, __HIP_MEMORY_SCOPE_AGENT);
        sq += shfl_xor_f(sq, 16); sq += shfl_xor_f(sq, 8); sq += shfl_xor_f(sq, 4); sq += shfl_xor_f(sq, 2); sq += shfl_xor_f(sq, 1);
        const float rs = rsqrtf(sq * (1.f / 1024.f) + EPS);
#pragma unroll
        for (int i = 0; i < 8; ++i) {
          const int col = i * 128 + c32 * 4;
          f32x4 v = *(const f32x4*)(yrow + col);
          *(f32x4*)(yrow + col) = v * rs * *(const f32x4*)(wfin + col);
        }
      }
    }
  }
}

__device__ __forceinline__ void phaseH(const Params& p, const int wv, const int rep) {
  const int wid = wv, lane = lane_fresh();
  const int gw = blockIdx.x * 8 + wid, nw = gridDim.x * 8;
  const float* w = p.in[29];
  for (int r_ = gw; r_ < T * rep; r_ += nw) {
    const int r = r_ >= T ? r_ - T : r_;
    float* x = p.out + O_Y + (size_t)r * 1024;
    f32x4 v[4]; float ss = 0.f;
#pragma unroll
    for (int i = 0; i < 4; ++i) { v[i] = *(const f32x4*)(x + (i * 64 + lane) * 4); ss += v[i][0] * v[i][0] + v[i][1] * v[i][1] + v[i][2] * v[i][2] + v[i][3] * v[i][3]; }
    ss = wave_sum(ss);
    const float rstd = rsqrtf(ss * (1.f / 1024.f) + EPS);
#pragma unroll
    for (int i = 0; i < 4; ++i) { f32x4 wv = *(const f32x4*)(w + (i * 64 + lane) * 4); *(f32x4*)(x + (i * 64 + lane) * 4) = v[i] * rstd * wv; }
  }
}

__global__ void __launch_bounds__(NTHREADS) fwd_megakernel(Params p) {
  cg::grid_group grid = cg::this_grid();
  const int wv = __builtin_amdgcn_readfirstlane(threadIdx.x >> 6);
#ifndef REP
#define REP 0
#endif
#define RB(bit) ({ int n_ = (REP & (1 << bit)) ? 2 : 1; asm volatile("" : "+s"(n_)); n_; })
  unsigned* bar = (unsigned*)(p.ws + OFF_BAR);
  if (wv == 0) { if (lane_fresh() == 0) { xb_words = make_uint4(0u, 0u, 0u, 0u); (void)xb_add(&bar[XB_XCNT(xb_xcc_id())], 1u); } }
  __syncthreads();
  phaseA(p, wv, RB(0));
  if (p.ws == nullptr) grid.sync();
  xcd_barrier(bar, wv);
  phaseB(p, wv, RB(1));
  xcd_barrier(bar, wv);
  phaseC(p, wv, RB(8), RB(9), RB(10), RB(11), RB(12), bar);
  xcd_barrier(bar, wv);
  phaseD(p, wv, RB(2));
  xcd_barrier(bar, wv);
  phaseE(p, wv, RB(3));
  xcd_barrier(bar, wv);
  phaseF(p, wv, RB(4));
  xcd_barrier(bar, wv);
  const bool fused = (gridDim.x == 256) && !(REP & 32);
  phaseG(p, wv, RB(5), bar, fused);
  if (!fused) {
    xcd_barrier(bar, wv);
    phaseH(p, wv, 1);
  }
  { int ns = (REP & 8192) ? 8 : 0; asm volatile("" : "+s"(ns)); for (int i = 0; i < ns; ++i) xcd_barrier(bar, wv); }
}

extern "C" void kernel_launch(void* const* d_in, const int* in_sizes, int n_in, void* d_out, int out_size, void* d_ws, size_t ws_size, hipStream_t stream) {
  static int grid_blocks = 0;
  if (!grid_blocks) {
    int dev = 0, cus = 0, per_cu = 0;
    (void)hipGetDevice(&dev);
    (void)hipDeviceGetAttribute(&cus, hipDeviceAttributeMultiprocessorCount, dev);
    (void)hipFuncSetAttribute((const void*)fwd_megakernel, hipFuncAttributeMaxDynamicSharedMemorySize, DYN_LDS);
    (void)hipOccupancyMaxActiveBlocksPerMultiprocessor(&per_cu, fwd_megakernel, NTHREADS, DYN_LDS);
    if (per_cu > 1) per_cu = 1;
    grid_blocks = cus * per_cu;
    if (grid_blocks > 256) grid_blocks = 256;
  }
  if (ws_size < WS_TOTAL || n_in < 30 || grid_blocks <= 0) { fprintf(stderr, "kernel_launch: bad config ws=%zu need=%zu grid=%d\n", ws_size, (size_t)WS_TOTAL, grid_blocks); return; }
  Params p{};
  for (int i = 0; i < 30; ++i) p.in[i] = (const float*)d_in[i];
  p.out = (float*)d_out;
  p.ws = (char*)d_ws;
  (void)hipMemsetAsync((char*)d_ws + OFF_BAR, 0, BAR_BYTES, stream);
  void* args[] = {&p};
  hipError_t e = hipLaunchCooperativeKernel((void*)fwd_megakernel, dim3(grid_blocks), dim3(NTHREADS), args, DYN_LDS, stream);
  if (e != hipSuccess) fprintf(stderr, "cooperative launch failed: %s (grid %d)\n", hipGetErrorString(e), grid_blocks);
}
```

```cpp
#include <hip/hip_runtime.h>
#include <hip/hip_cooperative_groups.h>
#include <cstdio>
namespace cg = cooperative_groups;

typedef unsigned short u16;
typedef short bf16x8 __attribute__((ext_vector_type(8)));
typedef float f32x4 __attribute__((ext_vector_type(4)));
typedef float f32x2 __attribute__((ext_vector_type(2)));
typedef unsigned u32x2 __attribute__((ext_vector_type(2)));
typedef unsigned u32x4 __attribute__((ext_vector_type(4)));

constexpr int TP = 16384, TS = 128, T = TP + TS;
constexpr float EPS = 1e-6f;
constexpr int NTHREADS = 512;
constexpr int DYN_LDS = 159744;

constexpr size_t OFF_WIN = 0;
constexpr size_t OFF_WKV = OFF_WIN + 14680064;
constexpr size_t OFF_WGM = OFF_WKV + 2097152;
constexpr size_t OFF_WSSD = OFF_WGM + 1048576;
constexpr size_t OFF_WXA = OFF_WSSD + 2097152;
constexpr size_t OFF_WOUT = OFF_WXA + 1048576;
constexpr size_t OFF_WUP = OFF_WOUT + 2097152;
constexpr size_t OFF_WDN = OFF_WUP + 8388608;
constexpr size_t OFF_WSB = OFF_WDN + 8388608;
constexpr size_t OFF_MN = OFF_WSB + 131072;
constexpr size_t OFF_KP = OFF_MN + 4194304;
constexpr size_t OFF_VT = OFF_KP + 2097152;
constexpr size_t OFF_DT = OFF_VT + 2097152;
constexpr size_t OFF_YPS = OFF_DT + 1056768;
constexpr size_t OFF_PS = OFF_YPS + 2113536;
constexpr size_t OFF_PSS = OFF_PS + 1048576;
constexpr size_t OFF_R1 = OFF_PSS + 32768;
constexpr size_t SZ_1024B = (size_t)T * 1024 * 2;
constexpr size_t OFF_UV = OFF_R1;
constexpr size_t OFF_ZS = OFF_R1 + SZ_1024B;
constexpr size_t OFF_XBC = OFF_R1 + 2 * SZ_1024B;
constexpr size_t OFF_MERGED = OFF_R1;
constexpr size_t OFF_ACT = OFF_R1;
constexpr size_t OFF_R2 = OFF_R1 + (size_t)T * 4096 * 2;
constexpr size_t OFF_GATE = OFF_R2;
constexpr size_t OFF_H2 = OFF_R2;
constexpr size_t OFF_H2B = OFF_R2 + (size_t)T * 1024 * 4;
constexpr size_t OFF_XA = OFF_R2 + (size_t)T * 3072 * 2;
constexpr size_t OFF_WDT = OFF_XA + (size_t)T * 512 * 2;
constexpr size_t OFF_BAR = OFF_WDT + 32768;
constexpr size_t BAR_BYTES = 32768;
constexpr size_t WS_TOTAL = OFF_BAR + BAR_BYTES;
constexpr size_t OOFF_XN = 0;
constexpr size_t OOFF_Q = SZ_1024B;
constexpr size_t OOFF_GM = SZ_1024B + (size_t)T * 512 * 2;
constexpr size_t O_Y = 0, O_MEMK = 16908288, O_MEMV = 17956864, O_CONVP = 19005440, O_SSMP = 19042304,
                 O_CONVS = 20090880, O_SSMS = 20680704, O_GMV = 37457920;

struct Params { const float* in[30]; float* out; char* ws; };

extern __shared__ __attribute__((aligned(16))) char g_shm[];

typedef __bf16 bf16x2_t __attribute__((ext_vector_type(2)));
__device__ __forceinline__ unsigned cvt_pk(float lo, float hi) { f32x2 v = {lo, hi}; bf16x2_t b = __builtin_convertvector(v, bf16x2_t); return __builtin_bit_cast(unsigned, b); }
__device__ __forceinline__ u32x2 pack4(f32x4 v) { u32x2 r; r.x = cvt_pk(v[0], v[1]); r.y = cvt_pk(v[2], v[3]); return r; }
__device__ __forceinline__ u16 f2bf(float f) { return (u16)(cvt_pk(f, 0.f) & 0xffffu); }
__device__ __forceinline__ float bf2f(u16 h) { return __uint_as_float(((unsigned)h) << 16); }
__device__ __forceinline__ float bflo(unsigned w) { return __uint_as_float(w << 16); }
__device__ __forceinline__ float bfhi(unsigned w) { return __uint_as_float(w & 0xffff0000u); }
__device__ __forceinline__ f32x4 unpack4(u32x2 w) { return (f32x4){bflo(w.x), bfhi(w.x), bflo(w.y), bfhi(w.y)}; }
__device__ __forceinline__ float silu_f(float x) { return x * __builtin_amdgcn_rcpf(1.f + __builtin_amdgcn_exp2f(-1.4426950409f * x)); }
__device__ __forceinline__ float sigm_f(float x) { return __builtin_amdgcn_rcpf(1.f + __builtin_amdgcn_exp2f(-1.4426950409f * x)); }
__device__ __forceinline__ float gelu_f(float v) {
  const float av = fabsf(v), t = __builtin_amdgcn_rcpf(av * 0.2316418882f + 1.0f);
  float q = t * 0.5307027145f + (-0.7265760135f); q = q * t + 0.7107068705f; q = q * t + (-0.142248368f); q = q * t + 0.127414796f; q = q * t;
  const float e = __builtin_amdgcn_exp2f((v * v) * (-0.72134752044f));
  const float m = v * (q * e), r = v - m;
  return v < 0.f ? m : r;
}
__device__ __forceinline__ float softplus_f(float x) { return fmaxf(x, 0.f) + log1pf(__expf(-fabsf(x))); }
__device__ __forceinline__ int lane_fresh() { int l; asm volatile("v_mbcnt_lo_u32_b32 %0, -1, 0\n\tv_mbcnt_hi_u32_b32 %0, -1, %0" : "=v"(l)); return l; }
__device__ __forceinline__ float shfl_xor_f(float v, int mask) { const int l = lane_fresh(); return __int_as_float(__builtin_amdgcn_ds_bpermute((l ^ mask) << 2, __float_as_int(v))); }
__device__ __forceinline__ float shfl_idx_f(float v, int src) { return __int_as_float(__builtin_amdgcn_ds_bpermute(src << 2, __float_as_int(v))); }
__device__ __forceinline__ float wave_sum(float v) {
#pragma unroll
  for (int o = 32; o >= 1; o >>= 1) v += shfl_xor_f(v, o);
  return v;
}
__device__ __forceinline__ float wave_max(float v) {
#pragma unroll
  for (int o = 32; o >= 1; o >>= 1) v = fmaxf(v, shfl_xor_f(v, o));
  return v;
}
#define MFMA16(a, b, c) __builtin_amdgcn_mfma_f32_16x16x32_bf16((a), (b), (c), 0, 0, 0)


#define XB_TMO      128
#define XB_XCNT(j)  (256  + 64 * (j))
#define XB_XSUB(j)  (1280 + 64 * (j))
#define XB_XGEN(j)  (2304 + 64 * (j))
#define XB_TOP      3328
#define XB_TOPGEN   3392
#define XB_SPIN_CAP (1u << 20)
#define LAS __attribute__((address_space(3)))
__device__ __forceinline__ unsigned xb_ld(unsigned* p) { return __hip_atomic_load(p, __ATOMIC_RELAXED, __HIP_MEMORY_SCOPE_AGENT); }
__device__ __forceinline__ unsigned xb_add(unsigned* p, unsigned v) { return __hip_atomic_fetch_add(p, v, __ATOMIC_RELAXED, __HIP_MEMORY_SCOPE_AGENT); }
__device__ __forceinline__ unsigned xb_xcc_id() { return (unsigned)__builtin_amdgcn_s_getreg((3 << 11) | 20) & 0xFu; }
#define XB_SPIN(cond, bar) do { unsigned _sp = 0; while (cond) { __builtin_amdgcn_s_sleep(1); \
    if ((++_sp & 255u) == 0u) { if (xb_ld(&(bar)[XB_TMO])) break; if (_sp > XB_SPIN_CAP) { atomicAdd(&(bar)[XB_TMO], 1u); break; } } } } while (0)
__shared__ uint4 xb_words;
__device__ __forceinline__ void xcd_barrier_complete(unsigned* bar, unsigned x, unsigned& nloc, unsigned& nx) {
  const unsigned G = gridDim.x;
  unsigned sum, cnt, mine, sp = 0u;
  for (;;) {
    sum = 0u; cnt = 0u; mine = 0u;
#pragma unroll
    for (unsigned j = 0; j < 16; ++j) { const unsigned c = xb_ld(&bar[XB_XCNT(j)]); sum += c; cnt += (c > 0u) ? 1u : 0u; mine = (j == x) ? c : mine; }
    if (sum == G) break;
    __builtin_amdgcn_s_sleep(1);
    if ((++sp & 255u) == 0u) { if (xb_ld(&bar[XB_TMO])) break; if (sp > XB_SPIN_CAP) { atomicAdd(&bar[XB_TMO], 1u); break; } }
  }
  nloc = mine > 0u ? mine : 1u; nx = cnt > 0u ? cnt : 1u;
}
__device__ __forceinline__ void xcd_barrier(unsigned* bar, const int wv) {
  asm volatile("s_waitcnt vmcnt(0)" ::: "memory");
  __syncthreads();
  if (wv == 0) {
    if (lane_fresh() == 0) {
      volatile LAS unsigned* st = (volatile LAS unsigned*)&xb_words;
      const unsigned x = xb_xcc_id();
      __builtin_amdgcn_s_waitcnt(0);
      unsigned nloc = st[0], nx = st[1];
      if (nloc == 0u) { xcd_barrier_complete(bar, x, nloc, nx); st[0] = nloc; st[1] = nx; }
      const unsigned old = xb_add(&bar[XB_XSUB(x)], 1u);
      const unsigned gen = old / nloc;
      if (old + 1u == (gen + 1u) * nloc) {
        __builtin_amdgcn_fence(__ATOMIC_RELEASE, "agent");
        asm volatile("s_waitcnt vmcnt(0)" ::: "memory");
        const unsigned og = xb_add(&bar[XB_TOP], 1u);
        const unsigned tg = og / nx;
        if (og + 1u == (tg + 1u) * nx) xb_add(&bar[XB_TOPGEN], 1u);
        else XB_SPIN(xb_ld(&bar[XB_TOPGEN]) == tg, bar);
        __builtin_amdgcn_fence(__ATOMIC_ACQUIRE, "agent");
        xb_add(&bar[XB_XGEN(x)], 1u);
        asm volatile("s_waitcnt vmcnt(0)" ::: "memory");
      } else {
        XB_SPIN(xb_ld(&bar[XB_XGEN(x)]) == gen, bar);
        __builtin_amdgcn_fence(__ATOMIC_ACQUIRE, "agent");
        asm volatile("s_waitcnt vmcnt(0)" ::: "memory");
      }
    }
  }
  __syncthreads();
}

constexpr int BM = 256, BK = 64, HALF = 128, HT = HALF * BK;
__device__ __forceinline__ int lds_byte(int r, int c) { int st = (r >> 4) * 2 + (c >> 5), rr = r & 15, cc = c & 31, ob = rr * 64 + cc * 2; return st * 1024 + (ob ^ (((ob >> 9) & 1) << 5)); }
__device__ __forceinline__ void stage_rc(int b, int& R, int& C) { int st = b / 1024, sb = b % 1024, swz = sb ^ (((sb >> 9) & 1) << 5); R = (st >> 1) * 16 + swz / 64; C = (st & 1) * 32 + (swz % 64) / 2; }

typedef f32x4 Acc[2][2][4][2];

template <int PART  , bool SYNC_FIRST = true>
__device__ __forceinline__ void kloop_t(const u16* __restrict__ A, int lda, const u16* __restrict__ Bt, int ldb, int K, Acc& acc, const int wv) {
  u16* shm = (u16*)g_shm;
#define SA(b, h) (shm + ((b) * 2 + (h)) * HT)
#define SB(b, h) (shm + (4 + (b) * 2 + (h)) * HT)
#define STAGE(P_, BASE, LD, br, kt) do { const u16* _gb = (BASE) + ((br) * (LD) + (kt) * BK); \
    unsigned _o0 = ((&(BASE) == &A) ? oA0 : oB0), _o1 = ((&(BASE) == &A) ? oA1 : oB1); asm volatile("" : "+v"(_o0), "+v"(_o1)); \
    __builtin_amdgcn_global_load_lds((const unsigned*)((const char*)_gb + _o0), (unsigned*)((char*)(P_) + ktid * 16), 16, 0, 0); \
    __builtin_amdgcn_global_load_lds((const unsigned*)((const char*)_gb + _o1), (unsigned*)((char*)(P_) + ktid * 16 + 8192), 16, 0, 0); } while (0)
#define LDA(dst, b, h) for (int m = 0; m < 4; ++m) for (int k = 0; k < 2; ++k) \
    dst[m][k] = *reinterpret_cast<const bf16x8*>((char*)SA(b, h) + lds_byte(wr * 64 + m * 16 + fr, k * 32 + fq * 8))
#define LDB(dst, b, h) for (int n = 0; n < 2; ++n) for (int k = 0; k < 2; ++k) \
    dst[n][k] = *reinterpret_cast<const bf16x8*>((char*)SB(b, h) + lds_byte(wc * 32 + n * 16 + fr, k * 32 + fq * 8))
#define MMA(ai, bj, At_, Bt_) do { __builtin_amdgcn_s_setprio(1); \
    for (int m = 0; m < 4; ++m) for (int n = 0; n < 2; ++n) for (int k = 0; k < 2; ++k) \
      acc[ai][bj][m][n] = MFMA16(Bt_[n][k], At_[m][k], acc[ai][bj][m][n]); \
    __builtin_amdgcn_s_setprio(0); } while (0)
#define WAIT_V(n) asm volatile("s_waitcnt vmcnt(" #n ")" ::: "memory")
#define WAIT_L(n) asm volatile("s_waitcnt lgkmcnt(" #n ")" ::: "memory")
#define BAR __builtin_amdgcn_s_barrier()
#define SCHED __builtin_amdgcn_sched_barrier(0)
  const int wid = wv, lane = lane_fresh(), ktid = wv * 64 + lane, wr = wid >> 2, wc = wid & 3, fr = lane & 15, fq = lane >> 4;
  bf16x8 At[4][2], B0[2][2], B1[2][2];
  const int nt = K / BK;
  unsigned oA0, oA1, oB0, oB1;
  { int r_, c_; stage_rc(ktid * 16, r_, c_); oA0 = (unsigned)(r_ * lda + c_) * 2u; oB0 = (unsigned)(r_ * ldb + c_) * 2u;
    stage_rc(ktid * 16 + 8192, r_, c_); oA1 = (unsigned)(r_ * lda + c_) * 2u; oB1 = (unsigned)(r_ * ldb + c_) * 2u; }
  if (PART != 2) {
    if (SYNC_FIRST) { WAIT_V(0); WAIT_L(0); __syncthreads(); }
    STAGE(SB(0, 0), Bt, ldb, 0, 0); STAGE(SA(0, 0), A, lda, 0, 0);
    STAGE(SB(0, 1), Bt, ldb, HALF, 0); STAGE(SA(0, 1), A, lda, HALF, 0);
  }
  if (PART == 1) return;
  if (wr == 1) BAR;
  WAIT_V(4); BAR;
  STAGE(SB(1, 0), Bt, ldb, 0, 1); STAGE(SA(1, 0), A, lda, 0, 1); STAGE(SB(1, 1), Bt, ldb, HALF, 1);
  WAIT_V(6); BAR;
#pragma unroll 1
  for (int t = 0; t < nt - 2; t += 2) {
    LDB(B0, 0, 0); SCHED; LDA(At, 0, 0); STAGE(SA(1, 1), A, lda, HALF, t + 1);
    WAIT_L(8); BAR; WAIT_L(0); MMA(0, 0, At, B0); BAR; SCHED;
    LDB(B1, 0, 1); STAGE(SB(0, 0), Bt, ldb, 0, t + 2);
    BAR; WAIT_L(0); MMA(0, 1, At, B1); BAR;
    LDA(At, 0, 1); STAGE(SA(0, 0), A, lda, 0, t + 2);
    BAR; WAIT_L(0); MMA(1, 0, At, B0); BAR; SCHED;
    STAGE(SB(0, 1), Bt, ldb, HALF, t + 2);
    WAIT_V(6); BAR; MMA(1, 1, At, B1); BAR;
    LDB(B0, 1, 0); SCHED; LDA(At, 1, 0); STAGE(SA(0, 1), A, lda, HALF, t + 2);
    WAIT_L(8); BAR; WAIT_L(0); MMA(0, 0, At, B0); BAR; SCHED;
    LDB(B1, 1, 1); STAGE(SB(1, 0), Bt, ldb, 0, t + 3);
    BAR; WAIT_L(0); MMA(0, 1, At, B1); BAR;
    LDA(At, 1, 1); STAGE(SA(1, 0), A, lda, 0, t + 3);
    BAR; WAIT_L(0); MMA(1, 0, At, B0); BAR; SCHED;
    STAGE(SB(1, 1), Bt, ldb, HALF, t + 3);
    WAIT_V(6); BAR; MMA(1, 1, At, B1); BAR;
  }
  { LDB(B0, 0, 0); LDA(At, 0, 0); STAGE(SA(1, 1), A, lda, HALF, nt - 1);
    BAR; WAIT_L(0); MMA(0, 0, At, B0); BAR;
    LDB(B1, 0, 1); BAR; WAIT_L(0); MMA(0, 1, At, B1); BAR;
    LDA(At, 0, 1); WAIT_V(4); BAR; WAIT_L(0); MMA(1, 0, At, B0); MMA(1, 1, At, B1); BAR; }
  { LDB(B0, 1, 0); LDA(At, 1, 0); WAIT_V(2); BAR; WAIT_L(0); MMA(0, 0, At, B0); BAR;
    LDB(B1, 1, 1); WAIT_V(0); BAR; WAIT_L(0); MMA(0, 1, At, B1); BAR;
    LDA(At, 1, 1); BAR; WAIT_L(0); MMA(1, 0, At, B0); MMA(1, 1, At, B1); BAR; }
  if (wr == 0) BAR;
  SCHED;
}

__device__ __forceinline__ void kloop(const u16* __restrict__ A, int lda, const u16* __restrict__ Bt, int ldb, int K, Acc& acc, const int wv) { kloop_t<0>(A, lda, Bt, ldb, K, acc, wv); }

#define ACC_ZERO(acc) do { _Pragma("unroll") for (int ai = 0; ai < 2; ++ai) _Pragma("unroll") for (int bj = 0; bj < 2; ++bj) \
  _Pragma("unroll") for (int m = 0; m < 4; ++m) _Pragma("unroll") for (int n = 0; n < 2; ++n) acc[ai][bj][m][n] = (f32x4){0.f, 0.f, 0.f, 0.f}; } while (0)
#define ACC_FOREACH(...) do { const int lane_e = lane_fresh(), fr = lane_e & 15, fq = lane_e >> 4; (void)fr; (void)fq; _Pragma("unroll") for (int ai = 0; ai < 2; ++ai) _Pragma("unroll") for (int m = 0; m < 4; ++m) { \
  const int rrow = ai * 128 + wr * 64 + m * 16 + fr; (void)rrow; \
  _Pragma("unroll") for (int bj = 0; bj < 2; ++bj) _Pragma("unroll") for (int n = 0; n < 2; ++n) { \
    const int rcol = bj * 128 + wc * 32 + n * 16 + fq * 4; (void)rcol; f32x4& v = acc[ai][bj][m][n]; __VA_ARGS__ } } } while (0)
#define ACC_FOREACH_SB(...) do { __builtin_amdgcn_sched_barrier(0); const int lane_e = lane_fresh(), fr = lane_e & 15, fq = lane_e >> 4; (void)fr; (void)fq; _Pragma("unroll") for (int ai = 0; ai < 2; ++ai) _Pragma("unroll") for (int m = 0; m < 4; ++m) { \
  const int rrow = ai * 128 + wr * 64 + m * 16 + fr; (void)rrow; \
  _Pragma("unroll") for (int bj = 0; bj < 2; ++bj) _Pragma("unroll") for (int n = 0; n < 2; ++n) { \
    const int rcol = bj * 128 + wc * 32 + n * 16 + fq * 4; (void)rcol; f32x4& v = acc[ai][bj][m][n]; __VA_ARGS__ } __builtin_amdgcn_sched_barrier(0); } } while (0)

__device__ __forceinline__ f32x4 wave_gemm16(const u16* __restrict__ A, int lda, const u16* __restrict__ Bt, int ldb, int K, f32x4 acc) {
  const int lane = lane_fresh(), fr = lane & 15, fq = lane >> 4;
  const u16* ap = A + (size_t)fr * lda + fq * 8;
  const u16* bp = Bt + (size_t)fr * ldb + fq * 8;
#pragma unroll 4
  for (int k = 0; k < K; k += 32) {
    bf16x8 a = *(const bf16x8*)(ap + k);
    bf16x8 b = *(const bf16x8*)(bp + k);
    acc = MFMA16(b, a, acc);
  }
  return acc;
}


template <int NT, class FA, class FB, class FL>
__device__ __forceinline__ void skgemm(FA aptr, FB bptr, FL ldf, const int KS, const int wv) {
  float* part = (float*)g_shm;
  const int lane = lane_fresh(), fr = lane & 15, fq = lane >> 4;
  __syncthreads();
#pragma unroll
  for (int i = 0; i < NT; ++i) {
    f32x4 acc = {0.f, 0.f, 0.f, 0.f};
    const int ld = ldf(i);
    const u16* ap = aptr(i) + (size_t)fr * ld + wv * KS + fq * 8;
    const u16* bp = bptr(i) + (size_t)fr * ld + wv * KS + fq * 8;
#pragma unroll 8
    for (int k = 0; k < KS; k += 32) acc = MFMA16(*(const bf16x8*)(bp + k), *(const bf16x8*)(ap + k), acc);
    *(f32x4*)(part + ((i * 8 + wv) * 64 + lane) * 4) = acc;
  }
  __syncthreads();
}
__device__ __forceinline__ f32x4 skreduce(int i) {
  const float* part = (const float*)g_shm;
  const int lane = lane_fresh();
  f32x4 s = {0.f, 0.f, 0.f, 0.f};
#pragma unroll
  for (int w = 0; w < 8; ++w) s += *(const f32x4*)(part + ((i * 8 + w) * 64 + lane) * 4);
  return s;
}

struct TJob { const float* src; const float* ks; u16* dst; int ldsrc, col0, k0, K, n0; };
__device__ __forceinline__ TJob tjob_decode(const Params& p, int i) {
  TJob j; char* ws = p.ws; j.ks = nullptr;
  if (i < 1792) { int kt = i & 15, ntl = i >> 4; j.src = p.in[8]; j.ldsrc = 7184; j.K = 1024; j.k0 = kt * 64; j.n0 = ntl * 64; j.col0 = j.n0 + (j.n0 >= 3584 ? 16 : 0); j.dst = (u16*)(ws + OFF_WIN); }
  else if ((i -= 1792) < 128) { int kt = i & 15, ntl = i >> 4; j.src = p.in[20]; j.ldsrc = 512; j.K = 1024; j.k0 = kt * 64; j.col0 = ntl * 64; j.n0 = (ntl >> 1) * 256 + (ntl & 1) * 64; j.dst = (u16*)(ws + OFF_WKV); }
  else if ((i -= 128) < 128) { int kt = i & 15, ntl = i >> 4; j.src = p.in[21]; j.ldsrc = 512; j.K = 1024; j.k0 = kt * 64; j.col0 = ntl * 64; j.n0 = (ntl >> 1) * 256 + 128 + (ntl & 1) * 64; j.dst = (u16*)(ws + OFF_WKV); }
  else if ((i -= 128) < 128) { int kt = i & 7, ntl = i >> 3; j.src = p.in[22]; j.ldsrc = 1024; j.K = 512; j.k0 = kt * 64; j.col0 = ntl * 64; j.n0 = j.col0; j.dst = (u16*)(ws + OFF_WGM); }
  else if ((i -= 128) < 256) { int kt = i & 15, ntl = i >> 4; j.src = p.in[23]; j.ldsrc = 1024; j.K = 1024; j.k0 = kt * 64; j.col0 = ntl * 64; j.n0 = j.col0; j.dst = (u16*)(ws + OFF_WSSD); j.ks = p.in[18]; }
  else if ((i -= 256) < 128) { int kt = i & 7, ntl = i >> 3; j.src = p.in[24]; j.ldsrc = 1024; j.K = 512; j.k0 = kt * 64; j.col0 = ntl * 64; j.n0 = j.col0; j.dst = (u16*)(ws + OFF_WXA); }
  else if ((i -= 128) < 256) { int kt = i & 15, ntl = i >> 4; j.src = p.in[25]; j.ldsrc = 1024; j.K = 1024; j.k0 = kt * 64; j.col0 = ntl * 64; j.n0 = j.col0; j.dst = (u16*)(ws + OFF_WOUT); }
  else if ((i -= 256) < 1024) { int kt = i & 15, ntl = i >> 4; j.src = p.in[27]; j.ldsrc = 4096; j.K = 1024; j.k0 = kt * 64; j.col0 = ntl * 64; j.n0 = j.col0; j.dst = (u16*)(ws + OFF_WUP); j.ks = p.in[26]; }
  else { i -= 1024; int kt = i & 63, ntl = i >> 6; j.src = p.in[28]; j.ldsrc = 1024; j.K = 4096; j.k0 = kt * 64; j.col0 = ntl * 64; j.n0 = j.col0; j.dst = (u16*)(ws + OFF_WDN); }
  return j;
}
__device__ __forceinline__ void ttile_load(const TJob& j, int tid, f32x4 (&v)[2]) {
#pragma unroll
  for (int i = 0; i < 2; ++i) {
    const int kk = (tid >> 4) + 32 * i, nn = (tid & 15) * 4;
    v[i] = *(const f32x4*)(j.src + (size_t)(j.k0 + kk) * j.ldsrc + j.col0 + nn);
    if (j.ks) v[i] = v[i] * j.ks[j.k0 + kk];
  }
}
__device__ __forceinline__ void ttile_store(const TJob& j, int tid, const f32x4 (&v)[2]) {
  float* tile = (float*)g_shm;
  __syncthreads();
#pragma unroll
  for (int i = 0; i < 2; ++i) {
    const int kk = (tid >> 4) + 32 * i, nn = (tid & 15) * 4;
    tile[kk * 65 + nn] = v[i][0]; tile[kk * 65 + nn + 1] = v[i][1]; tile[kk * 65 + nn + 2] = v[i][2]; tile[kk * 65 + nn + 3] = v[i][3];
  }
  __syncthreads();
  {
    const int nn = tid >> 3, k8 = (tid & 7) * 8;
    u32x4 w;
    w.x = cvt_pk(tile[(k8 + 0) * 65 + nn], tile[(k8 + 1) * 65 + nn]); w.y = cvt_pk(tile[(k8 + 2) * 65 + nn], tile[(k8 + 3) * 65 + nn]);
    w.z = cvt_pk(tile[(k8 + 4) * 65 + nn], tile[(k8 + 5) * 65 + nn]); w.w = cvt_pk(tile[(k8 + 6) * 65 + nn], tile[(k8 + 7) * 65 + nn]);
    *(u32x4*)(j.dst + (size_t)(j.n0 + nn) * j.K + j.k0 + k8) = w;
  }
}

__device__ __forceinline__ void phaseA(const Params& p, const int wv, const int rep) {
  const int lane = lane_fresh(), wid = wv, tid = wv * 64 + lane;
  char* ws = p.ws;
  {
    const int tend = 4864 * rep;
    int t_ = blockIdx.x;
    TJob job; f32x4 v[2];
    if (t_ < tend) { job = tjob_decode(p, t_ >= 4864 ? t_ - 4864 : t_); ttile_load(job, tid, v); }
    while (t_ < tend) {
      const int tn = t_ + gridDim.x;
      TJob jobn = job; f32x4 vn[2] = {v[0], v[1]};
      if (tn < tend) { jobn = tjob_decode(p, tn >= 4864 ? tn - 4864 : tn); ttile_load(jobn, tid, vn); }
      ttile_store(job, tid, v);
      job = jobn; v[0] = vn[0]; v[1] = vn[1]; t_ = tn;
    }
  }
  const int gw = blockIdx.x * 8 + wid, nw = gridDim.x * 8;
  u16* XN = (u16*)((char*)p.out + OOFF_XN);
  u16* MN = (u16*)(ws + OFF_MN);
  {
    const int rend = (T + 2048) * rep;
    auto rowsrc = [&](int r_) -> const float* {
      const int r = r_ >= T + 2048 ? r_ - (T + 2048) : r_;
      return r < TP ? p.in[0] + (size_t)r * 1024 : r < T ? p.in[1] + (size_t)(r - TP) * 1024 : p.in[2] + (size_t)(r - T) * 1024;
    };
    int r_ = gw;
    f32x4 v[4];
    if (r_ < rend) { const float* x = rowsrc(r_);
#pragma unroll
      for (int i = 0; i < 4; ++i) v[i] = *(const f32x4*)(x + (i * 64 + lane) * 4); }
    while (r_ < rend) {
      const int rn = r_ + nw;
      f32x4 vn[4] = {v[0], v[1], v[2], v[3]};
      if (rn < rend) { const float* x = rowsrc(rn);
#pragma unroll
        for (int i = 0; i < 4; ++i) vn[i] = *(const f32x4*)(x + (i * 64 + lane) * 4); }
      const int r = r_ >= T + 2048 ? r_ - (T + 2048) : r_;
      const float* w = r < T ? p.in[7] : p.in[19];
      u16* dst = r < T ? XN + (size_t)r * 1024 : MN + (size_t)(r - T) * 1024;
      float ss = 0.f;
#pragma unroll
      for (int i = 0; i < 4; ++i) ss += v[i][0] * v[i][0] + v[i][1] * v[i][1] + v[i][2] * v[i][2] + v[i][3] * v[i][3];
      ss = wave_sum(ss);
      const float rstd = rsqrtf(ss * (1.f / 1024.f) + EPS);
#pragma unroll
      for (int i = 0; i < 4; ++i) { f32x4 wv4 = *(const f32x4*)(w + (i * 64 + lane) * 4); *(u32x2*)(dst + (i * 64 + lane) * 4) = pack4(v[i] * rstd * wv4); }
#pragma unroll
      for (int i = 0; i < 4; ++i) v[i] = vn[i];
      r_ = rn;
    }
  }
  for (int i = blockIdx.x * NTHREADS + tid; i < 16384; i += gridDim.x * NTHREADS) {
    int k = i & 1023, hh = i >> 10;
    ((u16*)(ws + OFF_WDT))[i] = f2bf(p.in[8][(size_t)k * 7184 + 3584 + hh]);
  }
  u16* WSB = (u16*)(ws + OFF_WSB);
  for (int i = blockIdx.x * NTHREADS + tid; i < 65536; i += gridDim.x * NTHREADS) {
    int s = i & 127, tt = (i >> 7) & 127;
    WSB[i] = f2bf(s <= tt ? p.in[11][i] : 0.f);
  }
  for (int i = blockIdx.x * NTHREADS + tid; i < 128 * 3072; i += gridDim.x * NTHREADS) {
    int b = i / 3072, rem = i - b * 3072;
    p.out[O_CONVS + (size_t)b * 4608 + rem] = p.in[5][(size_t)b * 4608 + 1536 + rem];
  }
}

template <int SEC> __device__ __forceinline__ void epiB(const Params& p, int row, int col, f32x4 v) {
  char* ws = p.ws;
  if (SEC == 0) { f32x4 o = {gelu_f(v[0]), gelu_f(v[1]), gelu_f(v[2]), gelu_f(v[3])}; *(u32x2*)((u16*)(ws + OFF_UV) + (size_t)row * 1024 + col) = pack4(o); }
  else if (SEC == 1) { f32x4 o = {silu_f(v[0]), silu_f(v[1]), silu_f(v[2]), silu_f(v[3])}; *(u32x2*)((u16*)(ws + OFF_ZS) + (size_t)row * 1024 + (col - 1024)) = pack4(o); }
  else if (SEC == 2) {
    int c = col - 2048;
    *(u32x2*)((u16*)(ws + OFF_XBC) + (size_t)row * 1536 + c) = pack4(v);
    if (row >= TP) { *(f32x4*)(p.out + O_CONVS + (size_t)(row - TP) * 4608 + 3072 + c) = v; }
    else { int pos = row & 2047; if (pos >= 2045) *(f32x4*)(p.out + O_CONVP + (size_t)(row >> 11) * 4608 + (pos - 2045) * 1536 + c) = v; }
  }
  else if (SEC == 3) { *(u32x2*)((u16*)((char*)p.out + OOFF_Q) + (size_t)row * 512 + (col - 3584)) = pack4(v); }
  else if (SEC == 4) { f32x4 o;
#pragma unroll
    for (int e = 0; e < 4; ++e) o[e] = 1.f + __builtin_amdgcn_exp2f(fminf(-1.4426950409f * v[e], 100.f)); *(u32x2*)((u16*)(ws + OFF_GATE) + (size_t)row * 3072 + (col - 4096)) = pack4(o); }
  else {
    if (col < 512) {
      *(f32x4*)(p.out + O_MEMK + (size_t)row * 512 + col) = v;
      *(u32x2*)((u16*)(ws + OFF_KP) + (size_t)row * 512 + col) = pack4(v);
    } else {
      int c = col - 512;
      *(f32x4*)(p.out + O_MEMV + (size_t)row * 512 + c) = v;
      int b = row >> 8, mm = row & 255, hh = c >> 7, d = c & 127;
      int x = mm & 31, pos = (mm & ~31) + 8 * ((x >> 2) & 3) + 4 * (x >> 4) + (x & 3);
      u16* vt = (u16*)(ws + OFF_VT) + ((size_t)(b * 4 + hh) * 128 + d) * 256 + pos;
      vt[0] = f2bf(v[0]); vt[256] = f2bf(v[1]); vt[512] = f2bf(v[2]); vt[768] = f2bf(v[3]);
    }
  }
}
__device__ __forceinline__ int secB(int col) { return col < 1024 ? 0 : col < 2048 ? 1 : col < 3584 ? 2 : col < 4096 ? 3 : 4; }

__device__ __forceinline__ void phaseB(const Params& p, const int wv, const int rep) {
  const int wid = wv, wr = wid >> 2, wc = wid & 3;
  char* ws = p.ws;
  const u16* XN = (const u16*)((char*)p.out + OOFF_XN);
  {
    const u16* WIN = (const u16*)(ws + OFF_WIN);
    int t_ = blockIdx.x;
    const int tend = 1792 * rep;
    Acc acc;
    if (t_ < tend) {
      const int t = t_ >= 1792 ? t_ - 1792 : t_;
      kloop_t<1, true>(XN + (size_t)((t & 63) * 256) * 1024, 1024, WIN + (size_t)((t >> 6) * 256) * 1024, 1024, 1024, acc, wv);
    }
    while (t_ < tend) {
      const int t = t_ >= 1792 ? t_ - 1792 : t_;
      const int brow = (t & 63) * 256, bcol = (t >> 6) * 256, sec = secB(bcol);
      ACC_ZERO(acc);
      kloop_t<2>(XN + (size_t)brow * 1024, 1024, WIN + (size_t)bcol * 1024, 1024, 1024, acc, wv);
      t_ += gridDim.x;
      if (t_ < tend) {
        const int tn = t_ >= 1792 ? t_ - 1792 : t_;
        kloop_t<1, false>(XN + (size_t)((tn & 63) * 256) * 1024, 1024, WIN + (size_t)((tn >> 6) * 256) * 1024, 1024, 1024, acc, wv);
      }
      switch (sec) {
        case 0: ACC_FOREACH({ epiB<0>(p, brow + rrow, bcol + rcol, v); }); break;
        case 1: ACC_FOREACH({ epiB<1>(p, brow + rrow, bcol + rcol, v); }); break;
        case 2: ACC_FOREACH({ epiB<2>(p, brow + rrow, bcol + rcol, v); }); break;
        case 3: ACC_FOREACH({ epiB<3>(p, brow + rrow, bcol + rcol, v); }); break;
        default: ACC_FOREACH({ epiB<4>(p, brow + rrow, bcol + rcol, v); }); break;
      }
    }
  }
  for (int gb = blockIdx.x; gb < 256; gb += gridDim.x) {
    const int task0 = gb * 14, mt = task0 / 448, nt0 = task0 - mt * 448;
    const u16* Ab = XN + (size_t)(TP + mt * 16) * 1024;
    const u16* Bb = (const u16*)(ws + OFF_WIN) + (size_t)(nt0 * 16) * 1024;
    skgemm<14>([&](int) { return Ab; }, [&](int i) { return Bb + (size_t)i * 16 * 1024; }, [&](int) { return 1024; }, 128, wv);
    for (int i = wv; i < 14; i += 8) {
      const int lane_e = lane_fresh(), fr = lane_e & 15, fq = lane_e >> 4;
      f32x4 a = skreduce(i);
      int row = TP + mt * 16 + fr, col = (nt0 + i) * 16 + fq * 4;
      switch (secB(col)) {
        case 0: epiB<0>(p, row, col, a); break;
        case 1: epiB<1>(p, row, col, a); break;
        case 2: epiB<2>(p, row, col, a); break;
        case 3: epiB<3>(p, row, col, a); break;
        default: epiB<4>(p, row, col, a); break;
      }
    }
  }
  for (int gb = blockIdx.x; gb < 256; gb += gridDim.x) {
    const u16* Bd = (const u16*)(ws + OFF_WDT);
    skgemm<5>([&](int i) { int tk = gb + 256 * i; tk = tk < T / 16 ? tk : 0; return XN + (size_t)(tk * 16) * 1024; }, [&](int) { return Bd; }, [&](int) { return 1024; }, 128, wv);
    for (int i = wv; i < 5; i += 8) {
      const int tk = gb + 256 * i;
      if (tk < T / 16) {
        const int lane_d = lane_fresh(), frd = lane_d & 15, fqd = lane_d >> 4;
        f32x4 a = skreduce(i);
        f32x4 bb = *(const f32x4*)(p.in[15] + fqd * 4);
        f32x4 o = {softplus_f(a[0] + bb[0]), softplus_f(a[1] + bb[1]), softplus_f(a[2] + bb[2]), softplus_f(a[3] + bb[3])};
        *(f32x4*)((float*)(ws + OFF_DT) + (size_t)(tk * 16 + frd) * 16 + fqd * 4) = o;
      }
    }
  }
}

__device__ __forceinline__ void ssd_prompt_item(const Params& p, int item, const int wv) {
  const int lane = lane_fresh(), wid = wv, tid = wv * 64 + lane, fr = lane & 15, fq = lane >> 4;
  const int h = item & 15, b = item >> 4, g = h >> 3;
  char* ws = p.ws;
  u16* C_l = (u16*)g_shm;
  u16* B_l = C_l + 128 * 136;
  u16* G_l = B_l;
  u16* BT_l = B_l + 128 * 136;
  u16* xT_l = BT_l + 128 * 136;
  u16* xw_l = xT_l + 64 * 136;
  u16* h_l = xw_l + 64 * 136;
  float* acum_l = (float*)(h_l + 64 * 136);
  float* dt_l = acum_l + 128;
  const u16* XBC = (const u16*)(ws + OFF_XBC);
  const u16* ZS = (const u16*)(ws + OFF_ZS);
  const float* DT = (const float*)(ws + OFF_DT);
  u16* Y = (u16*)((char*)p.out + OOFF_XN);
  float* YPS = (float*)(ws + OFF_YPS);
  const float Ah = -__expf(p.in[16][h]);
  const float Dh = p.in[17][h];
  const float* convw = p.in[13];
  const float* convb = p.in[14];
  const int cc = tid & 31, rg = tid >> 5;
  const int colbc = (cc < 16) ? (1024 + g * 128 + cc * 8) : (1280 + g * 128 + (cc - 16) * 8);
  const int xc = tid & 7, xr = tid >> 3;
  const int colx = h * 64 + xc * 8;
  const int j0 = rg * 8;
  f32x4 hacc[4];
#pragma unroll
  for (int pb = 0; pb < 4; ++pb) hacc[pb] = (f32x4){0.f, 0.f, 0.f, 0.f};
  u32x4 u[11], ux[5];
  float a0 = 0.f, a1 = 0.f;
#define SSD_PREFETCH(cn) do { const int t0n = b * 2048 + (cn) * 128; \
    if ((cn) > 0) { \
      _Pragma("unroll") for (int i_ = 0; i_ < 11; ++i_) u[i_] = *(const u32x4*)(XBC + (size_t)(t0n + j0 - 3 + i_) * 1536 + colbc); \
      _Pragma("unroll") for (int k_ = 0; k_ < 5; ++k_) ux[k_] = *(const u32x4*)(XBC + (size_t)(t0n + 2 * xr - 3 + k_) * 1536 + colx); \
    } else { \
      _Pragma("unroll") for (int i_ = 0; i_ < 11; ++i_) { const int j_ = j0 - 3 + i_; const bool ok_ = j_ >= 0; \
        u[i_] = *(const u32x4*)(XBC + (size_t)(t0n + (ok_ ? j_ : 0)) * 1536 + colbc); const unsigned m_ = ok_ ? 0xffffffffu : 0u; \
        u[i_].x &= m_; u[i_].y &= m_; u[i_].z &= m_; u[i_].w &= m_; } \
      _Pragma("unroll") for (int k_ = 0; k_ < 5; ++k_) { const int j_ = 2 * xr - 3 + k_; const bool ok_ = j_ >= 0; \
        ux[k_] = *(const u32x4*)(XBC + (size_t)(t0n + (ok_ ? j_ : 0)) * 1536 + colx); const unsigned m_ = ok_ ? 0xffffffffu : 0u; \
        ux[k_].x &= m_; ux[k_].y &= m_; ux[k_].z &= m_; ux[k_].w &= m_; } \
    } \
    if (wid == 0) { a0 = DT[(size_t)(t0n + 2 * lane) * 16 + h]; a1 = DT[(size_t)(t0n + 2 * lane + 1) * 16 + h]; } } while (0)
  SSD_PREFETCH(0);
#pragma unroll 1
  for (int c = 0; c < 16; ++c) {
    const int t0 = b * 2048 + c * 128;
    __syncthreads();
#pragma unroll
    for (int pb = 0; pb < 4; ++pb) *(u32x2*)(h_l + (pb * 16 + fr) * 136 + wid * 16 + fq * 4) = pack4(hacc[pb]);
    if (wid == 0) {
      dt_l[2 * lane] = a0; dt_l[2 * lane + 1] = a1;
      float s = (a0 + a1) * Ah;
#pragma unroll
      for (int o = 1; o < 64; o <<= 1) { float v = shfl_idx_f(s, (lane - o) & 63); if (lane >= o) s += v; }
      acum_l[2 * lane + 1] = s; acum_l[2 * lane] = s - a1 * Ah;
    }
    {
      float w[4][8], bias[8];
#pragma unroll
      for (int k = 0; k < 4; ++k) { f32x4 w0 = *(const f32x4*)(convw + k * 1536 + colbc), w1 = *(const f32x4*)(convw + k * 1536 + colbc + 4);
        w[k][0] = w0[0]; w[k][1] = w0[1]; w[k][2] = w0[2]; w[k][3] = w0[3]; w[k][4] = w1[0]; w[k][5] = w1[1]; w[k][6] = w1[2]; w[k][7] = w1[3]; }
      { f32x4 b0 = *(const f32x4*)(convb + colbc), b1 = *(const f32x4*)(convb + colbc + 4);
        bias[0] = b0[0]; bias[1] = b0[1]; bias[2] = b0[2]; bias[3] = b0[3]; bias[4] = b1[0]; bias[5] = b1[1]; bias[6] = b1[2]; bias[7] = b1[3]; }
      unsigned outp[8][4];
#pragma unroll
      for (int jj = 0; jj < 8; ++jj) {
        float o[8];
#pragma unroll
        for (int e = 0; e < 8; ++e) o[e] = bias[e];
#pragma unroll
        for (int k = 0; k < 4; ++k) {
          u32x4 uu = u[jj + k];
          o[0] += w[k][0] * bflo(uu.x); o[1] += w[k][1] * bfhi(uu.x); o[2] += w[k][2] * bflo(uu.y); o[3] += w[k][3] * bfhi(uu.y);
          o[4] += w[k][4] * bflo(uu.z); o[5] += w[k][5] * bfhi(uu.z); o[6] += w[k][6] * bflo(uu.w); o[7] += w[k][7] * bfhi(uu.w);
        }
#pragma unroll
        for (int e = 0; e < 8; ++e) o[e] = silu_f(o[e]);
#pragma unroll
        for (int e2 = 0; e2 < 4; ++e2) outp[jj][e2] = cvt_pk(o[2 * e2], o[2 * e2 + 1]);
      }
      if (cc < 16) {
#pragma unroll
        for (int jj = 0; jj < 8; ++jj) *(u32x4*)(B_l + (j0 + jj) * 136 + cc * 8) = (u32x4){outp[jj][0], outp[jj][1], outp[jj][2], outp[jj][3]};
#pragma unroll
        for (int e2 = 0; e2 < 4; ++e2) {
          u32x4 lo, hi;
          lo.x = (outp[0][e2] & 0xffffu) | (outp[1][e2] << 16); lo.y = (outp[2][e2] & 0xffffu) | (outp[3][e2] << 16);
          lo.z = (outp[4][e2] & 0xffffu) | (outp[5][e2] << 16); lo.w = (outp[6][e2] & 0xffffu) | (outp[7][e2] << 16);
          hi.x = (outp[0][e2] >> 16) | (outp[1][e2] & 0xffff0000u); hi.y = (outp[2][e2] >> 16) | (outp[3][e2] & 0xffff0000u);
          hi.z = (outp[4][e2] >> 16) | (outp[5][e2] & 0xffff0000u); hi.w = (outp[6][e2] >> 16) | (outp[7][e2] & 0xffff0000u);
          *(u32x4*)(BT_l + (cc * 8 + 2 * e2) * 136 + j0) = lo;
          *(u32x4*)(BT_l + (cc * 8 + 2 * e2 + 1) * 136 + j0) = hi;
        }
      } else {
#pragma unroll
        for (int jj = 0; jj < 8; ++jj) *(u32x4*)(C_l + (j0 + jj) * 136 + (cc - 16) * 8) = (u32x4){outp[jj][0], outp[jj][1], outp[jj][2], outp[jj][3]};
      }
    }
    {
      f32x4 b0 = *(const f32x4*)(convb + colx), b1 = *(const f32x4*)(convb + colx + 4);
      f32x4 w0[4], w1[4];
#pragma unroll
      for (int k = 0; k < 4; ++k) { w0[k] = *(const f32x4*)(convw + k * 1536 + colx); w1[k] = *(const f32x4*)(convw + k * 1536 + colx + 4); }
      float xo[2][8];
#pragma unroll
      for (int r2 = 0; r2 < 2; ++r2) {
        float o[8] = {b0[0], b0[1], b0[2], b0[3], b1[0], b1[1], b1[2], b1[3]};
#pragma unroll
        for (int k = 0; k < 4; ++k) {
          u32x4 uu = ux[r2 + k];
          o[0] += w0[k][0] * bflo(uu.x); o[1] += w0[k][1] * bfhi(uu.x); o[2] += w0[k][2] * bflo(uu.y); o[3] += w0[k][3] * bfhi(uu.y);
          o[4] += w1[k][0] * bflo(uu.z); o[5] += w1[k][1] * bfhi(uu.z); o[6] += w1[k][2] * bflo(uu.w); o[7] += w1[k][3] * bfhi(uu.w);
        }
#pragma unroll
        for (int e = 0; e < 8; ++e) xo[r2][e] = silu_f(o[e]);
      }
#pragma unroll
      for (int e = 0; e < 8; ++e) *(unsigned*)(xT_l + (xc * 8 + e) * 136 + 2 * xr) = cvt_pk(xo[0][e], xo[1][e]);
    }
    __syncthreads();
    if (c < 15) SSD_PREFETCH(c + 1);
    u32x2 zsr[4];
#pragma unroll
    for (int pb = 0; pb < 4; ++pb) zsr[pb] = *(const u32x2*)(ZS + (size_t)(t0 + wid * 16 + fr) * 1024 + h * 64 + pb * 16 + fq * 4);
    bf16x8 cf[4];
#pragma unroll
    for (int ks = 0; ks < 4; ++ks) cf[ks] = *(const bf16x8*)(C_l + (wid * 16 + fr) * 136 + ks * 32 + fq * 8);
    f32x4 cb[8];
#pragma unroll
    for (int jb = 0; jb < 8; ++jb) {
      cb[jb] = (f32x4){0.f, 0.f, 0.f, 0.f};
      if (jb <= wid) {
#pragma unroll
        for (int ks = 0; ks < 4; ++ks) { bf16x8 bf = *(const bf16x8*)(B_l + (jb * 16 + fr) * 136 + ks * 32 + fq * 8); cb[jb] = MFMA16(bf, cf[ks], cb[jb]); }
      }
    }
    const float alast = acum_l[127];
#pragma unroll
    for (int r2 = 0; r2 < 2; ++r2) {
      int pp = (tid >> 4) + 32 * r2, jc = tid & 15;
      u32x4 xv = *(const u32x4*)(xT_l + pp * 136 + jc * 8);
      float wj[8];
#pragma unroll
      for (int e = 0; e < 8; ++e) wj[e] = dt_l[jc * 8 + e] * __expf(alast - acum_l[jc * 8 + e]);
      u32x4 ov;
      ov.x = cvt_pk(bflo(xv.x) * wj[0], bfhi(xv.x) * wj[1]); ov.y = cvt_pk(bflo(xv.y) * wj[2], bfhi(xv.y) * wj[3]);
      ov.z = cvt_pk(bflo(xv.z) * wj[4], bfhi(xv.z) * wj[5]); ov.w = cvt_pk(bflo(xv.w) * wj[6], bfhi(xv.w) * wj[7]);
      *(u32x4*)(xw_l + pp * 136 + jc * 8) = ov;
    }
    __syncthreads();
    {
      const int i = wid * 16 + fr;
      const float ai = acum_l[i];
#pragma unroll
      for (int jb = 0; jb < 8; ++jb) {
        f32x4 gv = {0.f, 0.f, 0.f, 0.f};
        if (jb <= wid) {
          f32x4 aj = *(const f32x4*)(acum_l + jb * 16 + fq * 4);
          f32x4 dj = *(const f32x4*)(dt_l + jb * 16 + fq * 4);
#pragma unroll
          for (int e = 0; e < 4; ++e) gv[e] = cb[jb][e] * __expf(ai - aj[e]) * dj[e];
          if (jb == wid) {
#pragma unroll
            for (int e = 0; e < 4; ++e) gv[e] = (fq * 4 + e <= fr) ? gv[e] : 0.f;
          }
        }
        *(u32x2*)(G_l + i * 136 + jb * 16 + fq * 4) = pack4(gv);
      }
    }
    __syncthreads();
    {
      const int i = wid * 16 + fr, tok = t0 + i;
      const float ea = __expf(acum_l[i]);
      float ss = 0.f;
      bf16x8 gf[4];
#pragma unroll
      for (int ks = 0; ks < 4; ++ks) gf[ks] = *(const bf16x8*)(G_l + (wid * 16 + fr) * 136 + ks * 32 + fq * 8);
#pragma unroll
      for (int pb = 0; pb < 4; ++pb) {
        f32x4 y = {0.f, 0.f, 0.f, 0.f};
#pragma unroll
        for (int ks = 0; ks < 4; ++ks) { bf16x8 hf = *(const bf16x8*)(h_l + (pb * 16 + fr) * 136 + ks * 32 + fq * 8); y = MFMA16(hf, cf[ks], y); }
        y = y * ea;
#pragma unroll
        for (int ks = 0; ks < 4; ++ks) {
          if (ks <= (wid >> 1)) {
            bf16x8 xf = *(const bf16x8*)(xT_l + (pb * 16 + fr) * 136 + ks * 32 + fq * 8);
            y = MFMA16(xf, gf[ks], y);
          }
        }
        const int pc = pb * 16 + fq * 4;
        f32x4 zs = unpack4(zsr[pb]);
#pragma unroll
        for (int e = 0; e < 4; ++e) { float xv = bf2f(xT_l[(pc + e) * 136 + i]); y[e] = (y[e] + xv * Dh) * zs[e]; ss += y[e] * y[e]; }
        *(u32x2*)(Y + (size_t)tok * 1024 + h * 64 + pc) = pack4(y);
      }
      ss += shfl_xor_f(ss, 16); ss += shfl_xor_f(ss, 32);
      if (fq == 0) { YPS[(size_t)tok * 32 + g * 16 + (h & 7) * 2] = ss; YPS[(size_t)tok * 32 + g * 16 + (h & 7) * 2 + 1] = 0.f; }
    }
    {
      const float dl = __expf(alast);
      bf16x8 btf[4];
#pragma unroll
      for (int ks = 0; ks < 4; ++ks) btf[ks] = *(const bf16x8*)(BT_l + (wid * 16 + fr) * 136 + ks * 32 + fq * 8);
#pragma unroll
      for (int pb = 0; pb < 4; ++pb) {
        hacc[pb] = hacc[pb] * dl;
#pragma unroll
        for (int ks = 0; ks < 4; ++ks) {
          bf16x8 xwf = *(const bf16x8*)(xw_l + (pb * 16 + fr) * 136 + ks * 32 + fq * 8);
          hacc[pb] = MFMA16(btf[ks], xwf, hacc[pb]);
        }
      }
    }
  }
#undef SSD_PREFETCH
#pragma unroll
  for (int pb = 0; pb < 4; ++pb)
    *(f32x4*)(p.out + O_SSMP + ((size_t)(b * 16 + h) * 64 + pb * 16 + fr) * 128 + wid * 16 + fq * 4) = hacc[pb];
}

__device__ __forceinline__ void memkv_tile(const Params& p, int item, const int wv, unsigned* bar) {
  const int wid = wv, wr = wid >> 2, wc = wid & 3;
  const int h = item & 3, b = item >> 2;
  char* ws = p.ws;
  Acc acc; ACC_ZERO(acc);
  kloop((const u16*)(ws + OFF_MN) + (size_t)(b * 256) * 1024, 1024, (const u16*)(ws + OFF_WKV) + (size_t)(h * 256) * 1024, 1024, 1024, acc, wv);
  ACC_FOREACH({
    const int row = b * 256 + rrow;
    const int col = (rcol < 128) ? (h * 128 + rcol) : (512 + h * 128 + rcol - 128);
    epiB<5>(p, row, col, v);
  });
  asm volatile("s_waitcnt vmcnt(0)" ::: "memory");
  __syncthreads();
  if (wv == 0) { if (lane_fresh() == 0) { __builtin_amdgcn_fence(__ATOMIC_RELEASE, "agent"); asm volatile("s_waitcnt vmcnt(0)" ::: "memory"); (void)xb_add(&bar[6144 + item * 16], 1u); } }
}

__device__ __forceinline__ void attn_prompt_item(const Params& p, int item, const int wv, unsigned* bar) {
  const int lane = lane_fresh(), wid = wv, tid = wv * 64 + lane, fr = lane & 15, fq = lane >> 4;
  const int qt = item & 7, h = (item >> 3) & 3, b = item >> 5;
  char* ws = p.ws;
  u16* K_l = (u16*)g_shm;
  u16* VT_l = K_l + 256 * 136;
  const u16* KP = (const u16*)(ws + OFF_KP);
  const u16* VT = (const u16*)(ws + OFF_VT);
  u16* Q = (u16*)((char*)p.out + OOFF_Q);
  if (wv == 0) { if (lane == 0) { XB_SPIN(xb_ld(&bar[6144 + (b * 4 + h) * 16]) == 0u, bar); } }
  __syncthreads();
  __builtin_amdgcn_fence(__ATOMIC_ACQUIRE, "agent");
#pragma unroll
  for (int i = 0; i < 8; ++i) {
    int idx = i * 512 + tid, mm = idx >> 4, ch = idx & 15;
    *(u32x4*)(K_l + mm * 136 + ch * 8) = *(const u32x4*)(KP + (size_t)(b * 256 + mm) * 512 + h * 128 + ch * 8);
  }
#pragma unroll
  for (int i = 0; i < 8; ++i) {
    int idx = i * 512 + tid, d = idx >> 5, ch = idx & 31;
    *(u32x4*)(VT_l + d * 264 + ch * 8) = *(const u32x4*)(VT + ((size_t)(b * 4 + h) * 128 + d) * 256 + ch * 8);
  }
  const int q0 = b * 2048 + qt * 256 + wid * 32;
  bf16x8 qf[2][4];
#pragma unroll
  for (int qb = 0; qb < 2; ++qb)
#pragma unroll
    for (int ks = 0; ks < 4; ++ks) qf[qb][ks] = *(const bf16x8*)(Q + (size_t)(q0 + qb * 16 + fr) * 512 + h * 128 + ks * 32 + fq * 8);
  __syncthreads();
  f32x4 s[16][2];
#pragma unroll
  for (int mb = 0; mb < 16; ++mb) {
    s[mb][0] = (f32x4){0.f, 0.f, 0.f, 0.f}; s[mb][1] = (f32x4){0.f, 0.f, 0.f, 0.f};
#pragma unroll
    for (int ks = 0; ks < 4; ++ks) {
      bf16x8 kf = *(const bf16x8*)(K_l + (mb * 16 + fr) * 136 + ks * 32 + fq * 8);
      s[mb][0] = MFMA16(kf, qf[0][ks], s[mb][0]);
      s[mb][1] = MFMA16(kf, qf[1][ks], s[mb][1]);
    }
  }
  const float cexp = 0.08838834764831845f * 1.4426950408889634f;
  float inv[2];
  bf16x8 pf[2][8];
#pragma unroll
  for (int qb = 0; qb < 2; ++qb) {
    float mx = -1e30f;
#pragma unroll
    for (int mb = 0; mb < 16; ++mb) mx = fmaxf(mx, fmaxf(fmaxf(s[mb][qb][0], s[mb][qb][1]), fmaxf(s[mb][qb][2], s[mb][qb][3])));
    mx = fmaxf(mx, shfl_xor_f(mx, 16)); mx = fmaxf(mx, shfl_xor_f(mx, 32));
    float sum = 0.f;
#pragma unroll
    for (int mb = 0; mb < 16; ++mb)
#pragma unroll
      for (int e = 0; e < 4; ++e) { float pv = __builtin_amdgcn_exp2f((s[mb][qb][e] - mx) * cexp); s[mb][qb][e] = pv; sum += pv; }
    sum += shfl_xor_f(sum, 16); sum += shfl_xor_f(sum, 32);
    inv[qb] = 1.f / sum;
#pragma unroll
    for (int st = 0; st < 8; ++st) {
      u32x2 lo = pack4(s[2 * st][qb]), hi = pack4(s[2 * st + 1][qb]);
      u32x4 w = {lo.x, lo.y, hi.x, hi.y};
      pf[qb][st] = __builtin_bit_cast(bf16x8, w);
    }
  }
  f32x4 o[8][2];
#pragma unroll
  for (int db = 0; db < 8; ++db) { o[db][0] = (f32x4){0.f, 0.f, 0.f, 0.f}; o[db][1] = (f32x4){0.f, 0.f, 0.f, 0.f}; }
#pragma unroll
  for (int st = 0; st < 8; ++st)
#pragma unroll
    for (int db = 0; db < 8; ++db) {
      bf16x8 vf = *(const bf16x8*)(VT_l + (db * 16 + fr) * 264 + st * 32 + fq * 8);
      o[db][0] = MFMA16(vf, pf[0][st], o[db][0]);
      o[db][1] = MFMA16(vf, pf[1][st], o[db][1]);
    }
#pragma unroll
  for (int qb = 0; qb < 2; ++qb)
#pragma unroll
    for (int db = 0; db < 8; ++db)
      *(u32x2*)((u16*)(ws + OFF_XA) + (size_t)(q0 + qb * 16 + fr) * 512 + h * 128 + db * 16 + fq * 4) = pack4(o[db][qb] * inv[qb]);
}

__device__ __forceinline__ void gmlp_prompt_item(const Params& p, int item, const int wv) {
  const int lane = lane_fresh(), wid = wv, tid = wv * 64 + lane, fr = lane & 15, fq = lane >> 4;
  const int gp = item & 1, c = (item >> 1) & 15, b = item >> 5;
  const int t0 = b * 2048 + c * 128;
  char* ws = p.ws;
  u16* VnT = (u16*)g_shm;
  const u16* UV = (const u16*)(ws + OFF_UV);
  const u16* WSB = (const u16*)(ws + OFF_WSB);
  u16* GM = (u16*)((char*)p.out + OOFF_GM);
  __syncthreads();
  {
    const int row = tid >> 2, qq = tid & 3;
    const u16* vrow = UV + (size_t)(t0 + row) * 1024 + 512;
    float sm = 0.f, sq = 0.f;
#pragma unroll
    for (int i = 0; i < 16; ++i) {
      u32x4 w = *(const u32x4*)(vrow + qq * 128 + i * 8);
      float f[8] = {bflo(w.x), bfhi(w.x), bflo(w.y), bfhi(w.y), bflo(w.z), bfhi(w.z), bflo(w.w), bfhi(w.w)};
#pragma unroll
      for (int e = 0; e < 8; ++e) { sm += f[e]; sq += f[e] * f[e]; }
    }
    sm += shfl_xor_f(sm, 1); sm += shfl_xor_f(sm, 2); sq += shfl_xor_f(sq, 1); sq += shfl_xor_f(sq, 2);
    const float mean = sm * (1.f / 512.f), var = fmaxf(sq * (1.f / 512.f) - mean * mean, 0.f), rstd = rsqrtf(var + EPS);
#pragma unroll
    for (int i = 0; i < 8; ++i) {
      const int cl = qq * 64 + i * 8, col = gp * 256 + cl;
      u32x4 w = *(const u32x4*)(vrow + col);
      float f[8] = {bflo(w.x), bfhi(w.x), bflo(w.y), bfhi(w.y), bflo(w.z), bfhi(w.z), bflo(w.w), bfhi(w.w)};
#pragma unroll
      for (int e = 0; e < 8; ++e) {
        float vn = (f[e] - mean) * rstd * p.in[9][col + e] + p.in[10][col + e];
        VnT[(cl + e) * 136 + row] = f2bf(vn);
      }
    }
  }
  __syncthreads();
  f32x4 acc[16];
#pragma unroll
  for (int db = 0; db < 16; ++db) acc[db] = (f32x4){0.f, 0.f, 0.f, 0.f};
#pragma unroll
  for (int ks = 0; ks < 4; ++ks) {
    if (ks <= (wid >> 1)) {
      bf16x8 w0 = *(const bf16x8*)(WSB + ((size_t)(gp * 2) * 128 + wid * 16 + fr) * 128 + ks * 32 + fq * 8);
      bf16x8 w1 = *(const bf16x8*)(WSB + ((size_t)(gp * 2 + 1) * 128 + wid * 16 + fr) * 128 + ks * 32 + fq * 8);
#pragma unroll
      for (int db = 0; db < 16; ++db) {
        bf16x8 vf = *(const bf16x8*)(VnT + (db * 16 + fr) * 136 + ks * 32 + fq * 8);
        acc[db] = MFMA16(vf, db < 8 ? w0 : w1, acc[db]);
      }
    }
  }
  const int tt = wid * 16 + fr, tok = t0 + tt;
#pragma unroll
  for (int db = 0; db < 16; ++db) {
    const int gs = gp * 2 + (db >> 3), col = gs * 128 + (db & 7) * 16 + fq * 4;
    const float bsv = p.in[12][gs * 128 + tt];
    f32x4 u = unpack4(*(const u32x2*)(UV + (size_t)tok * 1024 + col));
    f32x4 o = u * (acc[db] + bsv);
    *(u32x2*)(GM + (size_t)tok * 512 + col) = pack4(o);
  }
}

__device__ __forceinline__ void gmlp_sample_row(const Params& p, int bidx, const int wv) {
  const int lane = lane_fresh();
  char* ws = p.ws;
  const u16* UV = (const u16*)(ws + OFF_UV);
  u16* GM = (u16*)((char*)p.out + OOFF_GM);
  const int tok = TP + bidx;
  u32x4 w = *(const u32x4*)(UV + (size_t)tok * 1024 + 512 + lane * 8);
  float f[8] = {bflo(w.x), bfhi(w.x), bflo(w.y), bfhi(w.y), bflo(w.z), bfhi(w.z), bflo(w.w), bfhi(w.w)};
  float sm = 0.f, sq = 0.f;
#pragma unroll
  for (int e = 0; e < 8; ++e) { sm += f[e]; sq += f[e] * f[e]; }
  sm = wave_sum(sm); sq = wave_sum(sq);
  const float mean = sm * (1.f / 512.f), var = fmaxf(sq * (1.f / 512.f) - mean * mean, 0.f), rstd = rsqrtf(var + EPS);
  const int col = lane * 8, gs = col >> 7;
  const float w00 = p.in[11][gs * 16384], bs0 = p.in[12][gs * 128];
  u32x4 uw = *(const u32x4*)(UV + (size_t)tok * 1024 + col);
  float u[8] = {bflo(uw.x), bfhi(uw.x), bflo(uw.y), bfhi(uw.y), bflo(uw.z), bfhi(uw.z), bflo(uw.w), bfhi(uw.w)};
  float vn[8], o[8];
#pragma unroll
  for (int e = 0; e < 8; ++e) { vn[e] = (f[e] - mean) * rstd * p.in[9][col + e] + p.in[10][col + e]; o[e] = u[e] * (w00 * vn[e] + bs0); }
  *(f32x4*)(p.out + O_GMV + (size_t)bidx * 512 + col) = (f32x4){vn[0], vn[1], vn[2], vn[3]};
  *(f32x4*)(p.out + O_GMV + (size_t)bidx * 512 + col + 4) = (f32x4){vn[4], vn[5], vn[6], vn[7]};
  u32x4 ow = {cvt_pk(o[0], o[1]), cvt_pk(o[2], o[3]), cvt_pk(o[4], o[5]), cvt_pk(o[6], o[7])};
  *(u32x4*)(GM + (size_t)tok * 512 + col) = ow;
}

__device__ __forceinline__ void ssd_sample_item(const Params& p, int item, const int wv) {
  const int lane = lane_fresh();
  const int h = item & 15, b = item >> 4, g = h >> 3, tok = TP + b;
  char* ws = p.ws;
  const u16* XBC = (const u16*)(ws + OFF_XBC);
  const u16* ZS = (const u16*)(ws + OFF_ZS);
  const float* DT = (const float*)(ws + OFF_DT);
  u16* Y = (u16*)((char*)p.out + OOFF_XN);
  float* YPS = (float*)(ws + OFF_YPS);
  const float* sc = p.in[5] + (size_t)b * 4608;
  const float* convw = p.in[13];
  const float* convb = p.in[14];
  auto conv1 = [&](int col) -> float {
    float o = convb[col] + convw[col] * sc[col] + convw[1536 + col] * sc[1536 + col] + convw[3072 + col] * sc[3072 + col]
            + convw[4608 + col] * bf2f(XBC[(size_t)tok * 1536 + col]);
    return silu_f(o);
  };
  const float x = conv1(h * 64 + lane);
  const int n4 = (lane & 31) * 4, hf = lane >> 5;
  float Bv[4], Cv[4];
#pragma unroll
  for (int e = 0; e < 4; ++e) { Bv[e] = conv1(1024 + g * 128 + n4 + e); Cv[e] = conv1(1280 + g * 128 + n4 + e); }
  const float dt = DT[(size_t)tok * 16 + h];
  const float dA = __expf(-dt * __expf(p.in[16][h]));
  const float* st = p.in[6] + ((size_t)(b * 16 + h) * 64) * 128;
  float* so = p.out + O_SSMS + ((size_t)(b * 16 + h) * 64) * 128;
  float ymine = 0.f;
#pragma unroll 8
  for (int r = 0; r < 32; ++r) {
    const int pp = 2 * r + hf;
    f32x4 hv = *(const f32x4*)(st + (size_t)pp * 128 + n4);
    const float xp = shfl_idx_f(x, pp) * dt;
    f32x4 hn;
    float yp = 0.f;
#pragma unroll
    for (int e = 0; e < 4; ++e) { hn[e] = dA * hv[e] + xp * Bv[e]; yp += hn[e] * Cv[e]; }
    *(f32x4*)(so + (size_t)pp * 128 + n4) = hn;
#pragma unroll
    for (int o = 16; o >= 1; o >>= 1) yp += shfl_xor_f(yp, o);
    if ((lane & 31) == r) ymine = yp;
  }
  const int pm = 2 * (lane & 31) + hf;
  const float xm = shfl_idx_f(x, pm);
  const float zs = bf2f(ZS[(size_t)tok * 1024 + h * 64 + pm]);
  const float yg = (ymine + xm * p.in[17][h]) * zs;
  float ss = wave_sum(yg * yg);
  Y[(size_t)tok * 1024 + h * 64 + pm] = f2bf(yg);
  if (lane == 0) { YPS[(size_t)tok * 32 + g * 16 + (h & 7) * 2] = ss; YPS[(size_t)tok * 32 + g * 16 + (h & 7) * 2 + 1] = 0.f; }
}

__device__ __forceinline__ void attn_sample_item(const Params& p, int item, const int wv) {
  const int lane = lane_fresh(), wid = wv, tid = wv * 64 + lane;
  const int h = item & 3, b = item >> 2, tok = TP + b;
  float* sc_l = (float*)g_shm;
  float* red_l = sc_l + 256;
  u16* Q = (u16*)((char*)p.out + OOFF_Q);
  const float* Kc = p.in[3] + ((size_t)b * 256 * 4 + h) * 128;
  const float* Vc = p.in[4] + ((size_t)b * 256 * 4 + h) * 128;
  const int vdch = tid & 31, vmg = tid >> 5;
  f32x4 vreg[16];
#pragma unroll
  for (int i = 0; i < 16; ++i) vreg[i] = *(const f32x4*)(Vc + (size_t)(vmg * 16 + i) * 512 + vdch * 4);
  __syncthreads();
  {
    const int dch = lane & 15, ksub = lane >> 4;
    u32x4 qw = *(const u32x4*)(Q + (size_t)tok * 512 + h * 128 + dch * 8);
    float q[8] = {bflo(qw.x), bfhi(qw.x), bflo(qw.y), bfhi(qw.y), bflo(qw.z), bfhi(qw.z), bflo(qw.w), bfhi(qw.w)};
#pragma unroll
    for (int it = 0; it < 8; ++it) {
      const int mm = wid * 32 + it * 4 + ksub;
      f32x4 k0 = *(const f32x4*)(Kc + (size_t)mm * 512 + dch * 8), k1 = *(const f32x4*)(Kc + (size_t)mm * 512 + dch * 8 + 4);
      float d = q[0] * k0[0] + q[1] * k0[1] + q[2] * k0[2] + q[3] * k0[3] + q[4] * k1[0] + q[5] * k1[1] + q[6] * k1[2] + q[7] * k1[3];
      d += shfl_xor_f(d, 1); d += shfl_xor_f(d, 2); d += shfl_xor_f(d, 4); d += shfl_xor_f(d, 8);
      if (dch == 0) sc_l[mm] = d * 0.08838834764831845f;
    }
  }
  __syncthreads();
  float pv[4];
  {
    float mx = -1e30f;
#pragma unroll
    for (int i = 0; i < 4; ++i) { pv[i] = sc_l[lane + 64 * i]; mx = fmaxf(mx, pv[i]); }
    mx = wave_max(mx);
    float sum = 0.f;
#pragma unroll
    for (int i = 0; i < 4; ++i) { pv[i] = __expf(pv[i] - mx); sum += pv[i]; }
    sum = wave_sum(sum);
    const float inv = 1.f / sum;
#pragma unroll
    for (int i = 0; i < 4; ++i) pv[i] *= inv;
  }
  __syncthreads();
  if (wid == 0) {
#pragma unroll
    for (int i = 0; i < 4; ++i) sc_l[lane + 64 * i] = pv[i];
  }
  __syncthreads();
  {
    f32x4 acc = {0.f, 0.f, 0.f, 0.f};
#pragma unroll
    for (int i = 0; i < 16; ++i) acc += vreg[i] * sc_l[vmg * 16 + i];
    *(f32x4*)(red_l + vmg * 128 + vdch * 4) = acc;
  }
  __syncthreads();
  if (tid < 128) {
    float o = 0.f;
#pragma unroll
    for (int mg = 0; mg < 16; ++mg) o += red_l[mg * 128 + tid];
    ((u16*)(p.ws + OFF_XA))[(size_t)tok * 512 + h * 128 + tid] = f2bf(o);
  }
}

__device__ __forceinline__ void phaseC(const Params& p, const int wv, const int r0, const int r1, const int r2, const int r3, const int r4, unsigned* bar) {
  const int wid = wv;
  const int nS = gridDim.x >> 1;
  if ((int)blockIdx.x < nS) {
    for (int it = blockIdx.x; it < 128 * r0; it += nS) ssd_prompt_item(p, it & 127, wv);
  } else {
    const int ob = blockIdx.x - nS, nO = gridDim.x - nS;
    const int gw = ob * 8 + wid, nw = nO * 8;
    for (int it = ob; it < 32; it += nO) memkv_tile(p, it, wv, bar);
    for (int it = gw; it < 2048 * r1; it += nw) ssd_sample_item(p, it & 2047, wv);
    if (nO >= 64) {
      if (ob < 32) attn_sample_item(p, ob, wv);
      else for (int it = 32 + (ob - 32); it < 512; it += nO - 32) attn_sample_item(p, it, wv);
    } else {
      for (int it = ob; it < 512; it += nO) attn_sample_item(p, it, wv);
    }
    for (int it = ob; it < 256 * r2; it += nO) attn_prompt_item(p, it & 255, wv, bar);
    for (int it = ob; it < 256 * r3; it += nO) gmlp_prompt_item(p, it & 255, wv);
    for (int it = gw; it < 128; it += nw) gmlp_sample_row(p, it, wv);
  }
}

__device__ __forceinline__ void phaseD(const Params& p, const int wv, const int rep) {
  const int wid = wv, wr = wid >> 2, wc = wid & 3;
  char* ws = p.ws;
  const u16* GM = (const u16*)((char*)p.out + OOFF_GM);
  const u16* Y = (const u16*)((char*)p.out + OOFF_XN);
  const u16* XA = (const u16*)(ws + OFF_XA);
  const u16* GATE = (const u16*)(ws + OFF_GATE);
  const float* YPS = (const float*)(ws + OFF_YPS);
  u16* MERGED = (u16*)(ws + OFF_MERGED);
  const u16* WGM = (const u16*)(ws + OFF_WGM);
  const u16* WSSD = (const u16*)(ws + OFF_WSSD);
  const u16* WXA = (const u16*)(ws + OFF_WXA);
  float* rs_l = (float*)(g_shm + 131072);
  for (int t_ = blockIdx.x; t_ < 256 * rep; t_ += gridDim.x) {
    const int t = t_ & 255;
    const int pm = t & 63, pn = t >> 6, brow = pm * 256, bcol = pn * 256;
    __syncthreads();
    {
      const int tid = wv * 64 + lane_fresh();
      const int r = tid >> 1, gg = tid & 1;
      const float* ps = YPS + (size_t)(brow + r) * 32 + gg * 16;
      f32x4 a = *(const f32x4*)ps + *(const f32x4*)(ps + 4) + *(const f32x4*)(ps + 8) + *(const f32x4*)(ps + 12);
      rs_l[r * 2 + gg] = rsqrtf((a[0] + a[1] + a[2] + a[3]) * (1.f / 512.f) + EPS);
    }
    auto opnd = [&](int br, const u16*& Ap, const u16*& Bp, int& ld) {
      if (br == 0) { Ap = GM + (size_t)brow * 512; Bp = WGM + (size_t)bcol * 512; ld = 512; }
      else if (br == 1) { Ap = Y + (size_t)brow * 1024; Bp = WSSD + (size_t)bcol * 1024; ld = 1024; }
      else if (br == 2) { Ap = Y + (size_t)brow * 1024 + 512; Bp = WSSD + (size_t)bcol * 1024 + 512; ld = 1024; }
      else { Ap = XA + (size_t)brow * 512; Bp = WXA + (size_t)bcol * 512; ld = 512; }
    };
    Acc acc; ACC_ZERO(acc);
    { const u16 *Ap, *Bp; int ld; opnd(0, Ap, Bp, ld); kloop_t<1, true>(Ap, ld, Bp, ld, 512, acc, wv); }
#pragma unroll 1
    for (int br = 0; br < 4; ++br) {
      const u16 *Ap, *Bp; int ld; opnd(br, Ap, Bp, ld);
      kloop_t<2>(Ap, ld, Bp, ld, 512, acc, wv);
      const int gnum = (br == 0) ? 0 : (br == 2) ? 1024 : 2048, gden = (br == 0) ? 1024 : 2048;
      const int lane_e = lane_fresh(), fr = lane_e & 15, fq = lane_e >> 4;
      const int r0 = brow + wr * 64 + fr, c0 = bcol + wc * 32 + fq * 4;
      u32x2 gq[2][4], dq[2][4];
#define D_LOAD(g, buf) do { const int row_ = r0 + ((g) >> 2) * 128 + ((g) & 3) * 16; \
        _Pragma("unroll") for (int q = 0; q < 4; ++q) { const int col_ = c0 + (q >> 1) * 128 + (q & 1) * 16; \
          gq[buf][q] = (u32x2){0x3f803f80u, 0x3f803f80u}; dq[buf][q] = (u32x2){0x3f803f80u, 0x3f803f80u}; \
          if (br != 1) gq[buf][q] = *(const u32x2*)(GATE + (size_t)row_ * 3072 + gnum + col_); \
          if (br == 0 || br == 2) dq[buf][q] = *(const u32x2*)(GATE + (size_t)row_ * 3072 + gden + col_); } } while (0)
      D_LOAD(0, 0);
      if (br < 3) { const u16 *An, *Bn; int ldn; opnd(br + 1, An, Bn, ldn); kloop_t<1, false>(An, ldn, Bn, ldn, 512, acc, wv); }
#pragma unroll
      for (int g = 0; g < 8; ++g) {
        if (g < 7) D_LOAD(g + 1, (g + 1) & 1);
        __builtin_amdgcn_sched_barrier(0);
        const int ai = g >> 2, m = g & 3, rrow = ai * 128 + wr * 64 + m * 16 + fr, row_ = brow + rrow;
        const float rs0 = rs_l[rrow * 2], rs1 = rs_l[rrow * 2 + 1];
        const float rsc = (br == 0) ? __builtin_amdgcn_rcpf(rs0) : (br == 1) ? rs0 * __builtin_amdgcn_rcpf(rs1) : (br == 2) ? rs1 : 1.f;
#pragma unroll
        for (int q = 0; q < 4; ++q) {
          const int col_ = c0 + (q >> 1) * 128 + (q & 1) * 16;
          const f32x4 gn = unpack4(gq[g & 1][q]), gd = unpack4(dq[g & 1][q]);
          f32x4 sc;
#pragma unroll
          for (int e = 0; e < 4; ++e) sc[e] = gd[e] * rsc * __builtin_amdgcn_rcpf(gn[e]);
          f32x4 o = acc[ai][q >> 1][m][q & 1] * sc;
          acc[ai][q >> 1][m][q & 1] = o;
          if (br == 3) *(u32x2*)(MERGED + (size_t)row_ * 1024 + col_) = pack4(o);
        }
        __builtin_amdgcn_sched_barrier(0);
      }
#undef D_LOAD
    }
  }
  for (int gb = blockIdx.x; gb < 256; gb += gridDim.x) {
    const int task0 = gb * 2, mt = task0 >> 6, nt0 = task0 & 63, r0 = TP + mt * 16;
    skgemm<8>([&](int i) { const int br = i & 3; return br == 0 ? GM + (size_t)r0 * 512 : br == 1 ? Y + (size_t)r0 * 1024 : br == 2 ? Y + (size_t)r0 * 1024 + 512 : XA + (size_t)r0 * 512; },
              [&](int i) { const int br = i & 3, c0 = (nt0 + (i >> 2)) * 16; return br == 0 ? WGM + (size_t)c0 * 512 : br == 1 ? WSSD + (size_t)c0 * 1024 : br == 2 ? WSSD + (size_t)c0 * 1024 + 512 : WXA + (size_t)c0 * 512; },
              [&](int i) { const int br = i & 3; return (br == 1 || br == 2) ? 1024 : 512; }, 64, wv);
    if (wv < 2) {
      const int lane_e = lane_fresh(), fr = lane_e & 15, fq = lane_e >> 4;
      const int row = r0 + fr, col = (nt0 + wv) * 16 + fq * 4;
      const u16* gp_ = GATE + (size_t)row * 3072 + col;
      f32x4 g0 = unpack4(*(const u32x2*)gp_), g1 = unpack4(*(const u32x2*)(gp_ + 1024)), g2 = unpack4(*(const u32x2*)(gp_ + 2048));
#pragma unroll
      for (int e = 0; e < 4; ++e) { g0[e] = __builtin_amdgcn_rcpf(g0[e]); g1[e] = __builtin_amdgcn_rcpf(g1[e]); g2[e] = __builtin_amdgcn_rcpf(g2[e]); }
      float rs[2];
#pragma unroll
      for (int gg = 0; gg < 2; ++gg) {
        const float* ps = YPS + (size_t)row * 32 + gg * 16;
        f32x4 a = *(const f32x4*)ps + *(const f32x4*)(ps + 4) + *(const f32x4*)(ps + 8) + *(const f32x4*)(ps + 12);
        rs[gg] = rsqrtf((a[0] + a[1] + a[2] + a[3]) * (1.f / 512.f) + EPS);
      }
      f32x4 a0 = skreduce(wv * 4 + 0), a1 = skreduce(wv * 4 + 1), a2 = skreduce(wv * 4 + 2), a3 = skreduce(wv * 4 + 3);
      f32x4 o = g0 * a0 + g1 * (a1 * rs[0] + a2 * rs[1]) + g2 * a3;
      *(u32x2*)(MERGED + (size_t)row * 1024 + col) = pack4(o);
    }
  }
}

__device__ __forceinline__ void phaseE(const Params& p, const int wv, const int rep) {
  const int wid = wv, wr = wid >> 2, wc = wid & 3;
  char* ws = p.ws;
  const u16* MERGED = (const u16*)(ws + OFF_MERGED);
  const u16* WOUT = (const u16*)(ws + OFF_WOUT);
  u16* H2B = (u16*)(ws + OFF_H2B);
  float* PS = (float*)(ws + OFF_PS);
  float* PSS = (float*)(ws + OFF_PSS);
  for (int t_ = blockIdx.x; t_ < 256 * rep; t_ += gridDim.x) {
    const int t = t_ & 255;
    const int pm = t & 63, pn = t >> 6, brow = pm * 256, bcol = pn * 256;
    Acc acc; ACC_ZERO(acc);
    kloop(MERGED + (size_t)brow * 1024, 1024, WOUT + (size_t)bcol * 1024, 1024, 1024, acc, wv);
    const int lane_e = lane_fresh(), fr = lane_e & 15, fq = lane_e >> 4; (void)fr; (void)fq;
#pragma unroll
    for (int ai = 0; ai < 2; ++ai)
#pragma unroll
      for (int m = 0; m < 4; ++m) {
        const int row = brow + ai * 128 + wr * 64 + m * 16 + fr;
        float ss = 0.f;
#pragma unroll
        for (int bj = 0; bj < 2; ++bj)
#pragma unroll
          for (int n = 0; n < 2; ++n) {
            const int col = bcol + bj * 128 + wc * 32 + n * 16 + fq * 4;
            f32x4 v = acc[ai][bj][m][n] + *(const f32x4*)(p.in[0] + (size_t)row * 1024 + col);
            *(u32x2*)(H2B + (size_t)row * 1024 + col) = pack4(v);
            ss += v[0] * v[0] + v[1] * v[1] + v[2] * v[2] + v[3] * v[3];
          }
        ss += shfl_xor_f(ss, 16); ss += shfl_xor_f(ss, 32);
        if (fq == 0) PS[(size_t)row * 16 + pn * 4 + wc] = ss;
      }
  }
  for (int gb = blockIdx.x; gb < 256; gb += gridDim.x) {
    const int task0 = gb * 2, mt = task0 >> 6, nt0 = task0 & 63;
    const u16* Ab = MERGED + (size_t)(TP + mt * 16) * 1024;
    skgemm<2>([&](int) { return Ab; }, [&](int i) { return WOUT + (size_t)((nt0 + i) * 16) * 1024; }, [&](int) { return 1024; }, 128, wv);
    if (wv < 2) {
      const int lane_e = lane_fresh(), fr = lane_e & 15, fq = lane_e >> 4;
      const int ntl = nt0 + wv, row = TP + mt * 16 + fr, col = ntl * 16 + fq * 4;
      f32x4 v = skreduce(wv) + *(const f32x4*)(p.in[1] + (size_t)(row - TP) * 1024 + col);
      *(u32x2*)(H2B + (size_t)row * 1024 + col) = pack4(v);
      float ss = v[0] * v[0] + v[1] * v[1] + v[2] * v[2] + v[3] * v[3];
      ss += shfl_xor_f(ss, 16); ss += shfl_xor_f(ss, 32);
      if (fq == 0) PSS[(size_t)(row - TP) * 64 + ntl] = ss;
    }
  }
}

__device__ __forceinline__ void phaseF(const Params& p, const int wv, const int rep) {
  const int wid = wv, wr = wid >> 2, wc = wid & 3;
  char* ws = p.ws;
  const u16* H2B = (const u16*)(ws + OFF_H2B);
  const u16* WUP = (const u16*)(ws + OFF_WUP);
  u16* ACT = (u16*)(ws + OFF_ACT);
  const float* PS = (const float*)(ws + OFF_PS);
  const float* PSS = (const float*)(ws + OFF_PSS);
  {
    float* rs_l = (float*)(g_shm + 131072);
    auto fill_rs = [&](int t, int buf) {
      const int tid = wv * 64 + lane_fresh();
      if (tid < 256) {
        const float* ps = PS + (size_t)((t & 63) * 256 + tid) * 16;
        f32x4 a = *(const f32x4*)ps + *(const f32x4*)(ps + 4) + *(const f32x4*)(ps + 8) + *(const f32x4*)(ps + 12);
        rs_l[buf * 256 + tid] = rsqrtf((a[0] + a[1] + a[2] + a[3]) * (1.f / 1024.f) + EPS);
      }
    };
    int t_ = blockIdx.x, it = 0;
    const int tend = 1024 * rep;
    Acc acc;
    if (t_ < tend) {
      const int t = t_ & 1023;
      fill_rs(t, 0);
      kloop_t<1, true>(H2B + (size_t)((t & 63) * 256) * 1024, 1024, WUP + (size_t)((t >> 6) * 256) * 1024, 1024, 1024, acc, wv);
    }
    while (t_ < tend) {
      const int t = t_ & 1023;
      const int pm = t & 63, pn = t >> 6, brow = pm * 256, bcol = pn * 256;
      ACC_ZERO(acc);
      kloop_t<2>(H2B + (size_t)brow * 1024, 1024, WUP + (size_t)bcol * 1024, 1024, 1024, acc, wv);
      t_ += gridDim.x;
      if (t_ < tend) {
        const int tn = t_ & 1023;
        fill_rs(tn, (it + 1) & 1);
        kloop_t<1, false>(H2B + (size_t)((tn & 63) * 256) * 1024, 1024, WUP + (size_t)((tn >> 6) * 256) * 1024, 1024, 1024, acc, wv);
      }
      const float* rs_c = rs_l + (it & 1) * 256;
      ACC_FOREACH({
        const float rstd = rs_c[rrow];
        f32x4 o = v * rstd;
        o[0] = fmaxf(o[0], 0.f); o[1] = fmaxf(o[1], 0.f); o[2] = fmaxf(o[2], 0.f); o[3] = fmaxf(o[3], 0.f);
        o = o * o;
        *(u32x2*)(ACT + (size_t)(brow + rrow) * 4096 + bcol + rcol) = pack4(o);
      });
      ++it;
    }
  }
  for (int gb = blockIdx.x; gb < 256; gb += gridDim.x) {
    const int task0 = gb * 8, mt = task0 >> 8, nt0 = task0 & 255;
    const u16* Ab = H2B + (size_t)(TP + mt * 16) * 1024;
    skgemm<8>([&](int) { return Ab; }, [&](int i) { return WUP + (size_t)((nt0 + i) * 16) * 1024; }, [&](int) { return 1024; }, 128, wv);
    {
      const int lane_e = lane_fresh(), fr = lane_e & 15, fq = lane_e >> 4;
      const int ntl = nt0 + wv, row = TP + mt * 16 + fr, col = ntl * 16 + fq * 4;
      const float* ps = PSS + (size_t)(row - TP) * 64 + fq * 16;
      f32x4 a4 = *(const f32x4*)ps + *(const f32x4*)(ps + 4) + *(const f32x4*)(ps + 8) + *(const f32x4*)(ps + 12);
      float sq = a4[0] + a4[1] + a4[2] + a4[3];
      sq += shfl_xor_f(sq, 16); sq += shfl_xor_f(sq, 32);
      const float rstd = rsqrtf(sq * (1.f / 1024.f) + EPS);
      f32x4 v = skreduce(wv) * rstd;
#pragma unroll
      for (int e = 0; e < 4; ++e) { float r = fmaxf(v[e], 0.f); v[e] = r * r; }
      *(u32x2*)(ACT + (size_t)row * 4096 + col) = pack4(v);
    }
  }
}

__device__ __forceinline__ void phaseG(const Params& p, const int wv, const int rep, unsigned* bar, const bool fused) {
  const int wid = wv, wr = wid >> 2, wc = wid & 3;
  char* ws = p.ws;
  const u16* ACT = (const u16*)(ws + OFF_ACT);
  const u16* WDN = (const u16*)(ws + OFF_WDN);
  const u16* H2 = (const u16*)(ws + OFF_H2B);
  unsigned* CNT = bar + 4096;
  unsigned* CNTS = bar + 4096 + 1024;
  float* XS = (float*)(ws + OFF_PS);
  float* XSS = (float*)(ws + OFF_PSS);
  const float* wfin = p.in[29];
  for (int t_ = blockIdx.x; t_ < 256 * rep; t_ += gridDim.x) {
    const int t = t_ & 255;
    const int pm = t & 63, pn = t >> 6, brow = pm * 256, bcol = pn * 256;
    Acc acc; ACC_ZERO(acc);
    kloop(ACT + (size_t)brow * 4096, 4096, WDN + (size_t)bcol * 4096, 4096, 4096, acc, wv);
    if (!fused) {
      ACC_FOREACH({
        const size_t o = (size_t)(brow + rrow) * 1024 + bcol + rcol;
        *(f32x4*)(p.out + O_Y + o) = v + unpack4(*(const u32x2*)(H2 + o));
      });
    } else {
      float* red = (float*)g_shm;
      float* rstd_l = red + 1024;
      {
        const int lane_e = lane_fresh(), fr = lane_e & 15, fq = lane_e >> 4;
#pragma unroll
        for (int ai = 0; ai < 2; ++ai)
#pragma unroll
          for (int m = 0; m < 4; ++m) {
            const int rrow = ai * 128 + wr * 64 + m * 16 + fr;
            float ss = 0.f;
#pragma unroll
            for (int bj = 0; bj < 2; ++bj)
#pragma unroll
              for (int n = 0; n < 2; ++n) {
                const int rcol = bj * 128 + wc * 32 + n * 16 + fq * 4;
                f32x4 v = acc[ai][bj][m][n] + unpack4(*(const u32x2*)(H2 + (size_t)(brow + rrow) * 1024 + bcol + rcol));
                acc[ai][bj][m][n] = v;
                ss += v[0] * v[0] + v[1] * v[1] + v[2] * v[2] + v[3] * v[3];
              }
            ss += shfl_xor_f(ss, 16); ss += shfl_xor_f(ss, 32);
            if (fq == 0) red[rrow * 4 + wc] = ss;
          }
      }
      __syncthreads();
      {
        const int tid = wv * 64 + lane_fresh();
        if (tid < 256) {
          f32x4 r4 = *(const f32x4*)(red + tid * 4);
          __hip_atomic_store(XS + (size_t)(brow + tid) * 4 + pn, r4[0] + r4[1] + r4[2] + r4[3], __ATOMIC_RELAXED, __HIP_MEMORY_SCOPE_AGENT);
        }
        asm volatile("s_waitcnt vmcnt(0)" ::: "memory");
        __syncthreads();
        if (tid == 0) {
          (void)xb_add(&CNT[pm * 16], 1u);
          XB_SPIN(xb_ld(&CNT[pm * 16]) < 4u, bar);
        }
        __syncthreads();
        if (tid < 256) {
          float sq = 0.f;
#pragma unroll
          for (int q = 0; q < 4; ++q) sq += __hip_atomic_load(XS + (size_t)(brow + tid) * 4 + q, __ATOMIC_RELAXED, __HIP_MEMORY_SCOPE_AGENT);
          rstd_l[tid] = rsqrtf(sq * (1.f / 1024.f) + EPS);
        }
        __syncthreads();
      }
      ACC_FOREACH({
        const float rs = rstd_l[rrow];
        const f32x4 wv4 = *(const f32x4*)(wfin + bcol + rcol);
        *(f32x4*)(p.out + O_Y + (size_t)(brow + rrow) * 1024 + bcol + rcol) = v * rs * wv4;
      });
    }
  }
  for (int gb = blockIdx.x; gb < 256; gb += gridDim.x) {
    const int task0 = gb * 2, mt = task0 >> 6, nt0 = task0 & 63;
    const u16* Ab = ACT + (size_t)(TP + mt * 16) * 4096;
    skgemm<2>([&](int) { return Ab; }, [&](int i) { return WDN + (size_t)((nt0 + i) * 16) * 4096; }, [&](int) { return 4096; }, 512, wv);
    if (!fused) {
      if (wv < 2) {
        const int lane_e = lane_fresh(), fr = lane_e & 15, fq = lane_e >> 4;
        const int row = TP + mt * 16 + fr, col = (nt0 + wv) * 16 + fq * 4;
        const size_t o = (size_t)row * 1024 + col;
        *(f32x4*)(p.out + O_Y + o) = skreduce(wv) + unpack4(*(const u32x2*)(H2 + o));
      }
    } else {
      unsigned* last_l = (unsigned*)g_shm + 8192;
      if (wv < 2) {
        const int lane_e = lane_fresh(), fr = lane_e & 15, fq = lane_e >> 4;
        const int row = TP + mt * 16 + fr, col = (nt0 + wv) * 16 + fq * 4;
        const size_t o = (size_t)row * 1024 + col;
        f32x4 v = skreduce(wv) + unpack4(*(const u32x2*)(H2 + o));
        float* yo = p.out + O_Y + o;
#pragma unroll
        for (int e = 0; e < 4; ++e) __hip_atomic_store(yo + e, v[e], __ATOMIC_RELAXED, __HIP_MEMORY_SCOPE_AGENT);
        float ss = v[0] * v[0] + v[1] * v[1] + v[2] * v[2] + v[3] * v[3];
        ss += shfl_xor_f(ss, 16); ss += shfl_xor_f(ss, 32);
        if (fq == 0) __hip_atomic_store(XSS + (size_t)(row - TP) * 64 + nt0 + wv, ss, __ATOMIC_RELAXED, __HIP_MEMORY_SCOPE_AGENT);
      }
      asm volatile("s_waitcnt vmcnt(0)" ::: "memory");
      __syncthreads();
      const int tid = wv * 64 + lane_fresh();
      if (tid == 0) last_l[0] = (xb_add(&CNTS[mt * 16], 1u) == 31u) ? 1u : 0u;
      __syncthreads();
      if (last_l[0]) {
        __builtin_amdgcn_fence(__ATOMIC_ACQUIRE, "agent");
        const int r = tid >> 5, c32 = tid & 31;
        float* yrow = p.out + O_Y + (size_t)(TP + mt * 16 + r) * 1024;
        float sq = __hip_atomic_load(XSS + (size_t)(mt * 16 + r) * 64 + c32 * 2, __ATOMIC_RELAXED, __HIP_MEMORY_SCOPE_AGENT)
                 + __hip_atomic_load(XSS + (size_t)(mt * 16 + r) * 64 + c32 * 2 + 1, __ATOMIC_RELAXED, __HIP_MEMORY_SCOPE_AGENT);
        sq += shfl_xor_f(sq, 16); sq += shfl_xor_f(sq, 8); sq += shfl_xor_f(sq, 4); sq += shfl_xor_f(sq, 2); sq += shfl_xor_f(sq, 1);
        const float rs = rsqrtf(sq * (1.f / 1024.f) + EPS);
#pragma unroll
        for (int i = 0; i < 8; ++i) {
          const int col = i * 128 + c32 * 4;
          f32x4 v = *(const f32x4*)(yrow + col);
          *(f32x4*)(yrow + col) = v * rs * *(const f32x4*)(wfin + col);
        }
      }
    }
  }
}

__device__ __forceinline__ void phaseH(const Params& p, const int wv, const int rep) {
  const int wid = wv, lane = lane_fresh();
  const int gw = blockIdx.x * 8 + wid, nw = gridDim.x * 8;
  const float* w = p.in[29];
  for (int r_ = gw; r_ < T * rep; r_ += nw) {
    const int r = r_ >= T ? r_ - T : r_;
    float* x = p.out + O_Y + (size_t)r * 1024;
    f32x4 v[4]; float ss = 0.f;
#pragma unroll
    for (int i = 0; i < 4; ++i) { v[i] = *(const f32x4*)(x + (i * 64 + lane) * 4); ss += v[i][0] * v[i][0] + v[i][1] * v[i][1] + v[i][2] * v[i][2] + v[i][3] * v[i][3]; }
    ss = wave_sum(ss);
    const float rstd = rsqrtf(ss * (1.f / 1024.f) + EPS);
#pragma unroll
    for (int i = 0; i < 4; ++i) { f32x4 wv = *(const f32x4*)(w + (i * 64 + lane) * 4); *(f32x4*)(x + (i * 64 + lane) * 4) = v[i] * rstd * wv; }
  }
}

__global__ void __launch_bounds__(NTHREADS) fwd_megakernel(Params p) {
  cg::grid_group grid = cg::this_grid();
  const int wv = __builtin_amdgcn_readfirstlane(threadIdx.x >> 6);
#ifndef REP
#define REP 0
#endif
#define RB(bit) ({ int n_ = (REP & (1 << bit)) ? 2 : 1; asm volatile("" : "+s"(n_)); n_; })
  unsigned* bar = (unsigned*)(p.ws + OFF_BAR);
  if (wv == 0) { if (lane_fresh() == 0) { xb_words = make_uint4(0u, 0u, 0u, 0u); (void)xb_add(&bar[XB_XCNT(xb_xcc_id())], 1u); } }
  __syncthreads();
  phaseA(p, wv, RB(0));
  if (p.ws == nullptr) grid.sync();
  xcd_barrier(bar, wv);
  phaseB(p, wv, RB(1));
  xcd_barrier(bar, wv);
  phaseC(p, wv, RB(8), RB(9), RB(10), RB(11), RB(12), bar);
  xcd_barrier(bar, wv);
  phaseD(p, wv, RB(2));
  xcd_barrier(bar, wv);
  phaseE(p, wv, RB(3));
  xcd_barrier(bar, wv);
  phaseF(p, wv, RB(4));
  xcd_barrier(bar, wv);
  const bool fused = (gridDim.x == 256) && !(REP & 32);
  phaseG(p, wv, RB(5), bar, fused);
  if (!fused) {
    xcd_barrier(bar, wv);
    phaseH(p, wv, 1);
  }
  { int ns = (REP & 8192) ? 8 : 0; asm volatile("" : "+s"(ns)); for (int i = 0; i < ns; ++i) xcd_barrier(bar, wv); }
}

extern "C" void kernel_launch(void* const* d_in, const int* in_sizes, int n_in, void* d_out, int out_size, void* d_ws, size_t ws_size, hipStream_t stream) {
  static int grid_blocks = 0;
  if (!grid_blocks) {
    int dev = 0, cus = 0, per_cu = 0;
    (void)hipGetDevice(&dev);
    (void)hipDeviceGetAttribute(&cus, hipDeviceAttributeMultiprocessorCount, dev);
    (void)hipFuncSetAttribute((const void*)fwd_megakernel, hipFuncAttributeMaxDynamicSharedMemorySize, DYN_LDS);
    (void)hipOccupancyMaxActiveBlocksPerMultiprocessor(&per_cu, fwd_megakernel, NTHREADS, DYN_LDS);
    if (per_cu > 1) per_cu = 1;
    grid_blocks = cus * per_cu;
    if (grid_blocks > 256) grid_blocks = 256;
  }
  if (ws_size < WS_TOTAL || n_in < 30 || grid_blocks <= 0) { fprintf(stderr, "kernel_launch: bad config ws=%zu need=%zu grid=%d\n", ws_size, (size_t)WS_TOTAL, grid_blocks); return; }
  Params p{};
  for (int i = 0; i < 30; ++i) p.in[i] = (const float*)d_in[i];
  p.out = (float*)d_out;
  p.ws = (char*)d_ws;
  (void)hipMemsetAsync((char*)d_ws + OFF_BAR, 0, BAR_BYTES, stream);
  void* args[] = {&p};
  hipError_t e = hipLaunchCooperativeKernel((void*)fwd_megakernel, dim3(grid_blocks), dim3(NTHREADS), args, DYN_LDS, stream);
  if (e != hipSuccess) fprintf(stderr, "cooperative launch failed: %s (grid %d)\n", hipGetErrorString(e), grid_blocks);
}
```

```cpp
#include <hip/hip_runtime.h>
#include <hip/hip_cooperative_groups.h>
#include <cstdio>
namespace cg = cooperative_groups;

typedef unsigned short u16;
typedef short bf16x8 __attribute__((ext_vector_type(8)));
typedef float f32x4 __attribute__((ext_vector_type(4)));
typedef float f32x2 __attribute__((ext_vector_type(2)));
typedef unsigned u32x2 __attribute__((ext_vector_type(2)));
typedef unsigned u32x4 __attribute__((ext_vector_type(4)));

constexpr int TP = 16384, TS = 128, T = TP + TS;
constexpr float EPS = 1e-6f;
constexpr int NTHREADS = 512;
constexpr int DYN_LDS = 159744;

constexpr size_t OFF_WIN = 0;
constexpr size_t OFF_WKV = OFF_WIN + 14680064;
constexpr size_t OFF_WGM = OFF_WKV + 2097152;
constexpr size_t OFF_WSSD = OFF_WGM + 1048576;
constexpr size_t OFF_WXA = OFF_WSSD + 2097152;
constexpr size_t OFF_WOUT = OFF_WXA + 1048576;
constexpr size_t OFF_WUP = OFF_WOUT + 2097152;
constexpr size_t OFF_WDN = OFF_WUP + 8388608;
constexpr size_t OFF_WSB = OFF_WDN + 8388608;
constexpr size_t OFF_MN = OFF_WSB + 131072;
constexpr size_t OFF_KP = OFF_MN + 4194304;
constexpr size_t OFF_VT = OFF_KP + 2097152;
constexpr size_t OFF_DT = OFF_VT + 2097152;
constexpr size_t OFF_YPS = OFF_DT + 1056768;
constexpr size_t OFF_PS = OFF_YPS + 2113536;
constexpr size_t OFF_PSS = OFF_PS + 1048576;
constexpr size_t OFF_R1 = OFF_PSS + 32768;
constexpr size_t SZ_1024B = (size_t)T * 1024 * 2;
constexpr size_t OFF_UV = OFF_R1;
constexpr size_t OFF_ZS = OFF_R1 + SZ_1024B;
constexpr size_t OFF_XBC = OFF_R1 + 2 * SZ_1024B;
constexpr size_t OFF_MERGED = OFF_R1;
constexpr size_t OFF_ACT = OFF_R1;
constexpr size_t OFF_R2 = OFF_R1 + (size_t)T * 4096 * 2;
constexpr size_t OFF_GATE = OFF_R2;
constexpr size_t OFF_H2 = OFF_R2;
constexpr size_t OFF_H2B = OFF_R2 + (size_t)T * 1024 * 4;
constexpr size_t OFF_XA = OFF_R2 + (size_t)T * 3072 * 2;
constexpr size_t OFF_WDT = OFF_XA + (size_t)T * 512 * 2;
constexpr size_t OFF_BAR = OFF_WDT + 32768;
constexpr size_t BAR_BYTES = 32768;
constexpr size_t WS_TOTAL = OFF_BAR + BAR_BYTES;
constexpr size_t OOFF_XN = 0;
constexpr size_t OOFF_Q = SZ_1024B;
constexpr size_t OOFF_GM = SZ_1024B + (size_t)T * 512 * 2;
constexpr size_t O_Y = 0, O_MEMK = 16908288, O_MEMV = 17956864, O_CONVP = 19005440, O_SSMP = 19042304,
                 O_CONVS = 20090880, O_SSMS = 20680704, O_GMV = 37457920;

struct Params { const float* in[30]; float* out; char* ws; };

extern __shared__ __attribute__((aligned(16))) char g_shm[];

typedef __bf16 bf16x2_t __attribute__((ext_vector_type(2)));
__device__ __forceinline__ unsigned cvt_pk(float lo, float hi) { f32x2 v = {lo, hi}; bf16x2_t b = __builtin_convertvector(v, bf16x2_t); return __builtin_bit_cast(unsigned, b); }
__device__ __forceinline__ u32x2 pack4(f32x4 v) { u32x2 r; r.x = cvt_pk(v[0], v[1]); r.y = cvt_pk(v[2], v[3]); return r; }
__device__ __forceinline__ u16 f2bf(float f) { return (u16)(cvt_pk(f, 0.f) & 0xffffu); }
__device__ __forceinline__ float bf2f(u16 h) { return __uint_as_float(((unsigned)h) << 16); }
__device__ __forceinline__ float bflo(unsigned w) { return __uint_as_float(w << 16); }
__device__ __forceinline__ float bfhi(unsigned w) { return __uint_as_float(w & 0xffff0000u); }
__device__ __forceinline__ f32x4 unpack4(u32x2 w) { return (f32x4){bflo(w.x), bfhi(w.x), bflo(w.y), bfhi(w.y)}; }
__device__ __forceinline__ float silu_f(float x) { return x * __builtin_amdgcn_rcpf(1.f + __builtin_amdgcn_exp2f(-1.4426950409f * x)); }
__device__ __forceinline__ float sigm_f(float x) { return __builtin_amdgcn_rcpf(1.f + __builtin_amdgcn_exp2f(-1.4426950409f * x)); }
__device__ __forceinline__ float gelu_f(float v) {
  const float av = fabsf(v), t = __builtin_amdgcn_rcpf(av * 0.2316418882f + 1.0f);
  float q = t * 0.5307027145f + (-0.7265760135f); q = q * t + 0.7107068705f; q = q * t + (-0.142248368f); q = q * t + 0.127414796f; q = q * t;
  const float e = __builtin_amdgcn_exp2f((v * v) * (-0.72134752044f));
  const float m = v * (q * e), r = v - m;
  return v < 0.f ? m : r;
}
__device__ __forceinline__ float softplus_f(float x) { return fmaxf(x, 0.f) + log1pf(__expf(-fabsf(x))); }
__device__ __forceinline__ int lane_fresh() { int l; asm volatile("v_mbcnt_lo_u32_b32 %0, -1, 0\n\tv_mbcnt_hi_u32_b32 %0, -1, %0" : "=v"(l)); return l; }
__device__ __forceinline__ float shfl_xor_f(float v, int mask) { const int l = lane_fresh(); return __int_as_float(__builtin_amdgcn_ds_bpermute((l ^ mask) << 2, __float_as_int(v))); }
__device__ __forceinline__ float shfl_idx_f(float v, int src) { return __int_as_float(__builtin_amdgcn_ds_bpermute(src << 2, __float_as_int(v))); }
__device__ __forceinline__ float wave_sum(float v) {
#pragma unroll
  for (int o = 32; o >= 1; o >>= 1) v += shfl_xor_f(v, o);
  return v;
}
__device__ __forceinline__ float wave_max(float v) {
#pragma unroll
  for (int o = 32; o >= 1; o >>= 1) v = fmaxf(v, shfl_xor_f(v, o));
  return v;
}
#define MFMA16(a, b, c) __builtin_amdgcn_mfma_f32_16x16x32_bf16((a), (b), (c), 0, 0, 0)


#define XB_TMO      128
#define XB_XCNT(j)  (256  + 64 * (j))
#define XB_XSUB(j)  (1280 + 64 * (j))
#define XB_XGEN(j)  (2304 + 64 * (j))
#define XB_TOP      3328
#define XB_TOPGEN   3392
#define XB_SPIN_CAP (1u << 20)
#define LAS __attribute__((address_space(3)))
__device__ __forceinline__ unsigned xb_ld(unsigned* p) { return __hip_atomic_load(p, __ATOMIC_RELAXED, __HIP_MEMORY_SCOPE_AGENT); }
__device__ __forceinline__ unsigned xb_add(unsigned* p, unsigned v) { return __hip_atomic_fetch_add(p, v, __ATOMIC_RELAXED, __HIP_MEMORY_SCOPE_AGENT); }
__device__ __forceinline__ unsigned xb_xcc_id() { return (unsigned)__builtin_amdgcn_s_getreg((3 << 11) | 20) & 0xFu; }
#define XB_SPIN(cond, bar) do { unsigned _sp = 0; while (cond) { __builtin_amdgcn_s_sleep(1); \
    if ((++_sp & 255u) == 0u) { if (xb_ld(&(bar)[XB_TMO])) break; if (_sp > XB_SPIN_CAP) { atomicAdd(&(bar)[XB_TMO], 1u); break; } } } } while (0)
__shared__ uint4 xb_words;
__device__ __forceinline__ void xcd_barrier_complete(unsigned* bar, unsigned x, unsigned& nloc, unsigned& nx) {
  const unsigned G = gridDim.x;
  unsigned sum, cnt, mine, sp = 0u;
  for (;;) {
    sum = 0u; cnt = 0u; mine = 0u;
#pragma unroll
    for (unsigned j = 0; j < 16; ++j) { const unsigned c = xb_ld(&bar[XB_XCNT(j)]); sum += c; cnt += (c > 0u) ? 1u : 0u; mine = (j == x) ? c : mine; }
    if (sum == G) break;
    __builtin_amdgcn_s_sleep(1);
    if ((++sp & 255u) == 0u) { if (xb_ld(&bar[XB_TMO])) break; if (sp > XB_SPIN_CAP) { atomicAdd(&bar[XB_TMO], 1u); break; } }
  }
  nloc = mine > 0u ? mine : 1u; nx = cnt > 0u ? cnt : 1u;
}
__device__ __forceinline__ void xcd_barrier(unsigned* bar, const int wv) {
  asm volatile("s_waitcnt vmcnt(0)" ::: "memory");
  __syncthreads();
  if (wv == 0) {
    if (lane_fresh() == 0) {
      volatile LAS unsigned* st = (volatile LAS unsigned*)&xb_words;
      const unsigned x = xb_xcc_id();
      __builtin_amdgcn_s_waitcnt(0);
      unsigned nloc = st[0], nx = st[1];
      if (nloc == 0u) { xcd_barrier_complete(bar, x, nloc, nx); st[0] = nloc; st[1] = nx; }
      const unsigned old = xb_add(&bar[XB_XSUB(x)], 1u);
      const unsigned gen = old / nloc;
      if (old + 1u == (gen + 1u) * nloc) {
        __builtin_amdgcn_fence(__ATOMIC_RELEASE, "agent");
        asm volatile("s_waitcnt vmcnt(0)" ::: "memory");
        const unsigned og = xb_add(&bar[XB_TOP], 1u);
        const unsigned tg = og / nx;
        if (og + 1u == (tg + 1u) * nx) xb_add(&bar[XB_TOPGEN], 1u);
        else XB_SPIN(xb_ld(&bar[XB_TOPGEN]) == tg, bar);
        __builtin_amdgcn_fence(__ATOMIC_ACQUIRE, "agent");
        xb_add(&bar[XB_XGEN(x)], 1u);
        asm volatile("s_waitcnt vmcnt(0)" ::: "memory");
      } else {
        XB_SPIN(xb_ld(&bar[XB_XGEN(x)]) == gen, bar);
        __builtin_amdgcn_fence(__ATOMIC_ACQUIRE, "agent");
        asm volatile("s_waitcnt vmcnt(0)" ::: "memory");
      }
    }
  }
  __syncthreads();
}

constexpr int BM = 256, BK = 64, HALF = 128, HT = HALF * BK;
__device__ __forceinline__ int lds_byte(int r, int c) { int st = (r >> 4) * 2 + (c >> 5), rr = r & 15, cc = c & 31, ob = rr * 64 + cc * 2; return st * 1024 + (ob ^ (((ob >> 9) & 1) << 5)); }
__device__ __forceinline__ void stage_rc(int b, int& R, int& C) { int st = b / 1024, sb = b % 1024, swz = sb ^ (((sb >> 9) & 1) << 5); R = (st >> 1) * 16 + swz / 64; C = (st & 1) * 32 + (swz % 64) / 2; }

typedef f32x4 Acc[2][2][4][2];

template <int PART  , bool SYNC_FIRST = true>
__device__ __forceinline__ void kloop_t(const u16* __restrict__ A, int lda, const u16* __restrict__ Bt, int ldb, int K, Acc& acc, const int wv) {
  u16* shm = (u16*)g_shm;
#define SA(b, h) (shm + ((b) * 2 + (h)) * HT)
#define SB(b, h) (shm + (4 + (b) * 2 + (h)) * HT)
#define STAGE(P_, BASE, LD, br, kt) do { const u16* _gb = (BASE) + ((br) * (LD) + (kt) * BK); \
    unsigned _o0 = ((&(BASE) == &A) ? oA0 : oB0), _o1 = ((&(BASE) == &A) ? oA1 : oB1); asm volatile("" : "+v"(_o0), "+v"(_o1)); \
    __builtin_amdgcn_global_load_lds((const unsigned*)((const char*)_gb + _o0), (unsigned*)((char*)(P_) + ktid * 16), 16, 0, 0); \
    __builtin_amdgcn_global_load_lds((const unsigned*)((const char*)_gb + _o1), (unsigned*)((char*)(P_) + ktid * 16 + 8192), 16, 0, 0); } while (0)
#define LDA(dst, b, h) for (int m = 0; m < 4; ++m) for (int k = 0; k < 2; ++k) \
    dst[m][k] = *reinterpret_cast<const bf16x8*>((char*)SA(b, h) + lds_byte(wr * 64 + m * 16 + fr, k * 32 + fq * 8))
#define LDB(dst, b, h) for (int n = 0; n < 2; ++n) for (int k = 0; k < 2; ++k) \
    dst[n][k] = *reinterpret_cast<const bf16x8*>((char*)SB(b, h) + lds_byte(wc * 32 + n * 16 + fr, k * 32 + fq * 8))
#define MMA(ai, bj, At_, Bt_) do { __builtin_amdgcn_s_setprio(1); \
    for (int m = 0; m < 4; ++m) for (int n = 0; n < 2; ++n) for (int k = 0; k < 2; ++k) \
      acc[ai][bj][m][n] = MFMA16(Bt_[n][k], At_[m][k], acc[ai][bj][m][n]); \
    __builtin_amdgcn_s_setprio(0); } while (0)
#define WAIT_V(n) asm volatile("s_waitcnt vmcnt(" #n ")" ::: "memory")
#define WAIT_L(n) asm volatile("s_waitcnt lgkmcnt(" #n ")" ::: "memory")
#define BAR __builtin_amdgcn_s_barrier()
#define SCHED __builtin_amdgcn_sched_barrier(0)
  const int wid = wv, lane = lane_fresh(), ktid = wv * 64 + lane, wr = wid >> 2, wc = wid & 3, fr = lane & 15, fq = lane >> 4;
  bf16x8 At[4][2], B0[2][2], B1[2][2];
  const int nt = K / BK;
  unsigned oA0, oA1, oB0, oB1;
  { int r_, c_; stage_rc(ktid * 16, r_, c_); oA0 = (unsigned)(r_ * lda + c_) * 2u; oB0 = (unsigned)(r_ * ldb + c_) * 2u;
    stage_rc(ktid * 16 + 8192, r_, c_); oA1 = (unsigned)(r_ * lda + c_) * 2u; oB1 = (unsigned)(r_ * ldb + c_) * 2u; }
  if (PART != 2) {
    if (SYNC_FIRST) { WAIT_V(0); WAIT_L(0); __syncthreads(); }
    STAGE(SB(0, 0), Bt, ldb, 0, 0); STAGE(SA(0, 0), A, lda, 0, 0);
    STAGE(SB(0, 1), Bt, ldb, HALF, 0); STAGE(SA(0, 1), A, lda, HALF, 0);
  }
  if (PART == 1) return;
  if (wr == 1) BAR;
  WAIT_V(4); BAR;
  STAGE(SB(1, 0), Bt, ldb, 0, 1); STAGE(SA(1, 0), A, lda, 0, 1); STAGE(SB(1, 1), Bt, ldb, HALF, 1);
  WAIT_V(6); BAR;
#pragma unroll 1
  for (int t = 0; t < nt - 2; t += 2) {
    LDB(B0, 0, 0); SCHED; LDA(At, 0, 0); STAGE(SA(1, 1), A, lda, HALF, t + 1);
    WAIT_L(8); BAR; WAIT_L(0); MMA(0, 0, At, B0); BAR; SCHED;
    LDB(B1, 0, 1); STAGE(SB(0, 0), Bt, ldb, 0, t + 2);
    BAR; WAIT_L(0); MMA(0, 1, At, B1); BAR;
    LDA(At, 0, 1); STAGE(SA(0, 0), A, lda, 0, t + 2);
    BAR; WAIT_L(0); MMA(1, 0, At, B0); BAR; SCHED;
    STAGE(SB(0, 1), Bt, ldb, HALF, t + 2);
    WAIT_V(6); BAR; MMA(1, 1, At, B1); BAR;
    LDB(B0, 1, 0); SCHED; LDA(At, 1, 0); STAGE(SA(0, 1), A, lda, HALF, t + 2);
    WAIT_L(8); BAR; WAIT_L(0); MMA(0, 0, At, B0); BAR; SCHED;
    LDB(B1, 1, 1); STAGE(SB(1, 0), Bt, ldb, 0, t + 3);
    BAR; WAIT_L(0); MMA(0, 1, At, B1); BAR;
    LDA(At, 1, 1); STAGE(SA(1, 0), A, lda, 0, t + 3);
    BAR; WAIT_L(0); MMA(1, 0, At, B0); BAR; SCHED;
    STAGE(SB(1, 1), Bt, ldb, HALF, t + 3);
    WAIT_V(6); BAR; MMA(1, 1, At, B1); BAR;
  }
  { LDB(B0, 0, 0); LDA(At, 0, 0); STAGE(SA(1, 1), A, lda, HALF, nt - 1);
    BAR; WAIT_L(0); MMA(0, 0, At, B0); BAR;
    LDB(B1, 0, 1); BAR; WAIT_L(0); MMA(0, 1, At, B1); BAR;
    LDA(At, 0, 1); WAIT_V(4); BAR; WAIT_L(0); MMA(1, 0, At, B0); MMA(1, 1, At, B1); BAR; }
  { LDB(B0, 1, 0); LDA(At, 1, 0); WAIT_V(2); BAR; WAIT_L(0); MMA(0, 0, At, B0); BAR;
    LDB(B1, 1, 1); WAIT_V(0); BAR; WAIT_L(0); MMA(0, 1, At, B1); BAR;
    LDA(At, 1, 1); BAR; WAIT_L(0); MMA(1, 0, At, B0); MMA(1, 1, At, B1); BAR; }
  if (wr == 0) BAR;
  SCHED;
}

__device__ __forceinline__ void kloop(const u16* __restrict__ A, int lda, const u16* __restrict__ Bt, int ldb, int K, Acc& acc, const int wv) { kloop_t<0>(A, lda, Bt, ldb, K, acc, wv); }

#define ACC_ZERO(acc) do { _Pragma("unroll") for (int ai = 0; ai < 2; ++ai) _Pragma("unroll") for (int bj = 0; bj < 2; ++bj) \
  _Pragma("unroll") for (int m = 0; m < 4; ++m) _Pragma("unroll") for (int n = 0; n < 2; ++n) acc[ai][bj][m][n] = (f32x4){0.f, 0.f, 0.f, 0.f}; } while (0)
#define ACC_FOREACH(...) do { const int lane_e = lane_fresh(), fr = lane_e & 15, fq = lane_e >> 4; (void)fr; (void)fq; _Pragma("unroll") for (int ai = 0; ai < 2; ++ai) _Pragma("unroll") for (int m = 0; m < 4; ++m) { \
  const int rrow = ai * 128 + wr * 64 + m * 16 + fr; (void)rrow; \
  _Pragma("unroll") for (int bj = 0; bj < 2; ++bj) _Pragma("unroll") for (int n = 0; n < 2; ++n) { \
    const int rcol = bj * 128 + wc * 32 + n * 16 + fq * 4; (void)rcol; f32x4& v = acc[ai][bj][m][n]; __VA_ARGS__ } } } while (0)
#define ACC_FOREACH_SB(...) do { __builtin_amdgcn_sched_barrier(0); const int lane_e = lane_fresh(), fr = lane_e & 15, fq = lane_e >> 4; (void)fr; (void)fq; _Pragma("unroll") for (int ai = 0; ai < 2; ++ai) _Pragma("unroll") for (int m = 0; m < 4; ++m) { \
  const int rrow = ai * 128 + wr * 64 + m * 16 + fr; (void)rrow; \
  _Pragma("unroll") for (int bj = 0; bj < 2; ++bj) _Pragma("unroll") for (int n = 0; n < 2; ++n) { \
    const int rcol = bj * 128 + wc * 32 + n * 16 + fq * 4; (void)rcol; f32x4& v = acc[ai][bj][m][n]; __VA_ARGS__ } __builtin_amdgcn_sched_barrier(0); } } while (0)

__device__ __forceinline__ void store_pair16(u16* rowp32, u32x2 a, u32x2 b, int fq) {
  auto rx = __builtin_amdgcn_permlane16_swap(a.x, b.x, false, false);
  auto ry = __builtin_amdgcn_permlane16_swap(a.y, b.y, false, false);
  u32x4 w = {rx[0], ry[0], rx[1], ry[1]};
  *(u32x4*)(rowp32 + ((fq & 1) * 16 + (fq >> 1) * 8)) = w;
}
#define ACC_FOREACH_PAIR(...) do { const int lane_e = lane_fresh(), fr = lane_e & 15, fq = lane_e >> 4; (void)fr; (void)fq; \
  _Pragma("unroll") for (int ai = 0; ai < 2; ++ai) _Pragma("unroll") for (int m = 0; m < 4; ++m) { \
  const int rrow = ai * 128 + wr * 64 + m * 16 + fr; (void)rrow; \
  _Pragma("unroll") for (int bj = 0; bj < 2; ++bj) { const int cb32 = bj * 128 + wc * 32; (void)cb32; \
    f32x4& v0 = acc[ai][bj][m][0]; f32x4& v1 = acc[ai][bj][m][1]; __VA_ARGS__ } } } while (0)

__device__ __forceinline__ f32x4 wave_gemm16(const u16* __restrict__ A, int lda, const u16* __restrict__ Bt, int ldb, int K, f32x4 acc) {
  const int lane = lane_fresh(), fr = lane & 15, fq = lane >> 4;
  const u16* ap = A + (size_t)fr * lda + fq * 8;
  const u16* bp = Bt + (size_t)fr * ldb + fq * 8;
#pragma unroll 4
  for (int k = 0; k < K; k += 32) {
    bf16x8 a = *(const bf16x8*)(ap + k);
    bf16x8 b = *(const bf16x8*)(bp + k);
    acc = MFMA16(b, a, acc);
  }
  return acc;
}


template <int NT, class FA, class FB, class FL>
__device__ __forceinline__ void skgemm(FA aptr, FB bptr, FL ldf, const int KS, const int wv) {
  float* part = (float*)g_shm;
  const int lane = lane_fresh(), fr = lane & 15, fq = lane >> 4;
  __syncthreads();
#pragma unroll
  for (int i = 0; i < NT; ++i) {
    f32x4 acc = {0.f, 0.f, 0.f, 0.f};
    const int ld = ldf(i);
    const u16* ap = aptr(i) + (size_t)fr * ld + wv * KS + fq * 8;
    const u16* bp = bptr(i) + (size_t)fr * ld + wv * KS + fq * 8;
#pragma unroll 8
    for (int k = 0; k < KS; k += 32) acc = MFMA16(*(const bf16x8*)(bp + k), *(const bf16x8*)(ap + k), acc);
    *(f32x4*)(part + ((i * 8 + wv) * 64 + lane) * 4) = acc;
  }
  __syncthreads();
}
__device__ __forceinline__ f32x4 skreduce(int i) {
  const float* part = (const float*)g_shm;
  const int lane = lane_fresh();
  f32x4 s = {0.f, 0.f, 0.f, 0.f};
#pragma unroll
  for (int w = 0; w < 8; ++w) s += *(const f32x4*)(part + ((i * 8 + w) * 64 + lane) * 4);
  return s;
}

struct TJob { const float* src; const float* ks; u16* dst; int ldsrc, col0, k0, K, n0; };
__device__ __forceinline__ TJob tjob_decode(const Params& p, int i) {
  TJob j; char* ws = p.ws; j.ks = nullptr;
  if (i < 1792) { int kt = i & 15, ntl = i >> 4; j.src = p.in[8]; j.ldsrc = 7184; j.K = 1024; j.k0 = kt * 64; j.n0 = ntl * 64; j.col0 = j.n0 + (j.n0 >= 3584 ? 16 : 0); j.dst = (u16*)(ws + OFF_WIN); }
  else if ((i -= 1792) < 128) { int kt = i & 15, ntl = i >> 4; j.src = p.in[20]; j.ldsrc = 512; j.K = 1024; j.k0 = kt * 64; j.col0 = ntl * 64; j.n0 = (ntl >> 1) * 256 + (ntl & 1) * 64; j.dst = (u16*)(ws + OFF_WKV); }
  else if ((i -= 128) < 128) { int kt = i & 15, ntl = i >> 4; j.src = p.in[21]; j.ldsrc = 512; j.K = 1024; j.k0 = kt * 64; j.col0 = ntl * 64; j.n0 = (ntl >> 1) * 256 + 128 + (ntl & 1) * 64; j.dst = (u16*)(ws + OFF_WKV); }
  else if ((i -= 128) < 128) { int kt = i & 7, ntl = i >> 3; j.src = p.in[22]; j.ldsrc = 1024; j.K = 512; j.k0 = kt * 64; j.col0 = ntl * 64; j.n0 = j.col0; j.dst = (u16*)(ws + OFF_WGM); }
  else if ((i -= 128) < 256) { int kt = i & 15, ntl = i >> 4; j.src = p.in[23]; j.ldsrc = 1024; j.K = 1024; j.k0 = kt * 64; j.col0 = ntl * 64; j.n0 = j.col0; j.dst = (u16*)(ws + OFF_WSSD); j.ks = p.in[18]; }
  else if ((i -= 256) < 128) { int kt = i & 7, ntl = i >> 3; j.src = p.in[24]; j.ldsrc = 1024; j.K = 512; j.k0 = kt * 64; j.col0 = ntl * 64; j.n0 = j.col0; j.dst = (u16*)(ws + OFF_WXA); }
  else if ((i -= 128) < 256) { int kt = i & 15, ntl = i >> 4; j.src = p.in[25]; j.ldsrc = 1024; j.K = 1024; j.k0 = kt * 64; j.col0 = ntl * 64; j.n0 = j.col0; j.dst = (u16*)(ws + OFF_WOUT); }
  else if ((i -= 256) < 1024) { int kt = i & 15, ntl = i >> 4; j.src = p.in[27]; j.ldsrc = 4096; j.K = 1024; j.k0 = kt * 64; j.col0 = ntl * 64; j.n0 = j.col0; j.dst = (u16*)(ws + OFF_WUP); j.ks = p.in[26]; }
  else { i -= 1024; int kt = i & 63, ntl = i >> 6; j.src = p.in[28]; j.ldsrc = 1024; j.K = 4096; j.k0 = kt * 64; j.col0 = ntl * 64; j.n0 = j.col0; j.dst = (u16*)(ws + OFF_WDN); }
  return j;
}
__device__ __forceinline__ void ttile_load(const TJob& j, int tid, f32x4 (&v)[2]) {
#pragma unroll
  for (int i = 0; i < 2; ++i) {
    const int kk = (tid >> 4) + 32 * i, nn = (tid & 15) * 4;
    v[i] = *(const f32x4*)(j.src + (size_t)(j.k0 + kk) * j.ldsrc + j.col0 + nn);
    if (j.ks) v[i] = v[i] * j.ks[j.k0 + kk];
  }
}
__device__ __forceinline__ void ttile_store(const TJob& j, int tid, const f32x4 (&v)[2]) {
  float* tile = (float*)g_shm;
  __syncthreads();
#pragma unroll
  for (int i = 0; i < 2; ++i) {
    const int kk = (tid >> 4) + 32 * i, nn = (tid & 15) * 4;
    tile[kk * 65 + nn] = v[i][0]; tile[kk * 65 + nn + 1] = v[i][1]; tile[kk * 65 + nn + 2] = v[i][2]; tile[kk * 65 + nn + 3] = v[i][3];
  }
  __syncthreads();
  {
    const int nn = tid >> 3, k8 = (tid & 7) * 8;
    u32x4 w;
    w.x = cvt_pk(tile[(k8 + 0) * 65 + nn], tile[(k8 + 1) * 65 + nn]); w.y = cvt_pk(tile[(k8 + 2) * 65 + nn], tile[(k8 + 3) * 65 + nn]);
    w.z = cvt_pk(tile[(k8 + 4) * 65 + nn], tile[(k8 + 5) * 65 + nn]); w.w = cvt_pk(tile[(k8 + 6) * 65 + nn], tile[(k8 + 7) * 65 + nn]);
    *(u32x4*)(j.dst + (size_t)(j.n0 + nn) * j.K + j.k0 + k8) = w;
  }
}

__device__ __forceinline__ void phaseA(const Params& p, const int wv, const int rep) {
  const int lane = lane_fresh(), wid = wv, tid = wv * 64 + lane;
  char* ws = p.ws;
  {
    const int tend = 4864 * rep;
    int t_ = blockIdx.x;
    TJob job; f32x4 v[2];
    if (t_ < tend) { job = tjob_decode(p, t_ >= 4864 ? t_ - 4864 : t_); ttile_load(job, tid, v); }
    while (t_ < tend) {
      const int tn = t_ + gridDim.x;
      TJob jobn = job; f32x4 vn[2] = {v[0], v[1]};
      if (tn < tend) { jobn = tjob_decode(p, tn >= 4864 ? tn - 4864 : tn); ttile_load(jobn, tid, vn); }
      ttile_store(job, tid, v);
      job = jobn; v[0] = vn[0]; v[1] = vn[1]; t_ = tn;
    }
  }
  const int gw = blockIdx.x * 8 + wid, nw = gridDim.x * 8;
  u16* XN = (u16*)((char*)p.out + OOFF_XN);
  u16* MN = (u16*)(ws + OFF_MN);
  {
    const int rend = (T + 2048) * rep;
    auto rowsrc = [&](int r_) -> const float* {
      const int r = r_ >= T + 2048 ? r_ - (T + 2048) : r_;
      return r < TP ? p.in[0] + (size_t)r * 1024 : r < T ? p.in[1] + (size_t)(r - TP) * 1024 : p.in[2] + (size_t)(r - T) * 1024;
    };
    int r_ = gw;
    f32x4 v[4];
    if (r_ < rend) { const float* x = rowsrc(r_);
#pragma unroll
      for (int i = 0; i < 4; ++i) v[i] = *(const f32x4*)(x + (i * 64 + lane) * 4); }
    while (r_ < rend) {
      const int rn = r_ + nw;
      f32x4 vn[4] = {v[0], v[1], v[2], v[3]};
      if (rn < rend) { const float* x = rowsrc(rn);
#pragma unroll
        for (int i = 0; i < 4; ++i) vn[i] = *(const f32x4*)(x + (i * 64 + lane) * 4); }
      const int r = r_ >= T + 2048 ? r_ - (T + 2048) : r_;
      const float* w = r < T ? p.in[7] : p.in[19];
      u16* dst = r < T ? XN + (size_t)r * 1024 : MN + (size_t)(r - T) * 1024;
      float ss = 0.f;
#pragma unroll
      for (int i = 0; i < 4; ++i) ss += v[i][0] * v[i][0] + v[i][1] * v[i][1] + v[i][2] * v[i][2] + v[i][3] * v[i][3];
      ss = wave_sum(ss);
      const float rstd = rsqrtf(ss * (1.f / 1024.f) + EPS);
#pragma unroll
      for (int i = 0; i < 4; ++i) { f32x4 wv4 = *(const f32x4*)(w + (i * 64 + lane) * 4); *(u32x2*)(dst + (i * 64 + lane) * 4) = pack4(v[i] * rstd * wv4); }
#pragma unroll
      for (int i = 0; i < 4; ++i) v[i] = vn[i];
      r_ = rn;
    }
  }
  for (int i = blockIdx.x * NTHREADS + tid; i < 16384; i += gridDim.x * NTHREADS) {
    int k = i & 1023, hh = i >> 10;
    ((u16*)(ws + OFF_WDT))[i] = f2bf(p.in[8][(size_t)k * 7184 + 3584 + hh]);
  }
  u16* WSB = (u16*)(ws + OFF_WSB);
  for (int i = blockIdx.x * NTHREADS + tid; i < 65536; i += gridDim.x * NTHREADS) {
    int s = i & 127, tt = (i >> 7) & 127;
    WSB[i] = f2bf(s <= tt ? p.in[11][i] : 0.f);
  }
  for (int i = blockIdx.x * NTHREADS + tid; i < 128 * 3072; i += gridDim.x * NTHREADS) {
    int b = i / 3072, rem = i - b * 3072;
    p.out[O_CONVS + (size_t)b * 4608 + rem] = p.in[5][(size_t)b * 4608 + 1536 + rem];
  }
}

template <int SEC> __device__ __forceinline__ void epiB(const Params& p, int row, int col, f32x4 v) {
  char* ws = p.ws;
  if (SEC == 0) { f32x4 o = {gelu_f(v[0]), gelu_f(v[1]), gelu_f(v[2]), gelu_f(v[3])}; *(u32x2*)((u16*)(ws + OFF_UV) + (size_t)row * 1024 + col) = pack4(o); }
  else if (SEC == 1) { f32x4 o = {silu_f(v[0]), silu_f(v[1]), silu_f(v[2]), silu_f(v[3])}; *(u32x2*)((u16*)(ws + OFF_ZS) + (size_t)row * 1024 + (col - 1024)) = pack4(o); }
  else if (SEC == 2) {
    int c = col - 2048;
    *(u32x2*)((u16*)(ws + OFF_XBC) + (size_t)row * 1536 + c) = pack4(v);
    if (row >= TP) { *(f32x4*)(p.out + O_CONVS + (size_t)(row - TP) * 4608 + 3072 + c) = v; }
    else { int pos = row & 2047; if (pos >= 2045) *(f32x4*)(p.out + O_CONVP + (size_t)(row >> 11) * 4608 + (pos - 2045) * 1536 + c) = v; }
  }
  else if (SEC == 3) { *(u32x2*)((u16*)((char*)p.out + OOFF_Q) + (size_t)row * 512 + (col - 3584)) = pack4(v); }
  else if (SEC == 4) { f32x4 o = {sigm_f(v[0]), sigm_f(v[1]), sigm_f(v[2]), sigm_f(v[3])}; *(u32x2*)((u16*)(ws + OFF_GATE) + (size_t)row * 3072 + (col - 4096)) = pack4(o); }
  else {
    if (col < 512) {
      *(f32x4*)(p.out + O_MEMK + (size_t)row * 512 + col) = v;
      *(u32x2*)((u16*)(ws + OFF_KP) + (size_t)row * 512 + col) = pack4(v);
    } else {
      int c = col - 512;
      *(f32x4*)(p.out + O_MEMV + (size_t)row * 512 + c) = v;
      int b = row >> 8, mm = row & 255, hh = c >> 7, d = c & 127;
      int x = mm & 31, pos = (mm & ~31) + 8 * ((x >> 2) & 3) + 4 * (x >> 4) + (x & 3);
      u16* vt = (u16*)(ws + OFF_VT) + ((size_t)(b * 4 + hh) * 128 + d) * 256 + pos;
      vt[0] = f2bf(v[0]); vt[256] = f2bf(v[1]); vt[512] = f2bf(v[2]); vt[768] = f2bf(v[3]);
    }
  }
}
template <int SEC> __device__ __forceinline__ void epiB2(const Params& p, int row, int col32, f32x4 v0, f32x4 v1, int fq) {
  char* ws = p.ws;
  if (SEC == 0) { f32x4 o0 = {gelu_f(v0[0]), gelu_f(v0[1]), gelu_f(v0[2]), gelu_f(v0[3])}, o1 = {gelu_f(v1[0]), gelu_f(v1[1]), gelu_f(v1[2]), gelu_f(v1[3])};
    store_pair16((u16*)(ws + OFF_UV) + (size_t)row * 1024 + col32, pack4(o0), pack4(o1), fq); }
  else if (SEC == 1) { f32x4 o0 = {silu_f(v0[0]), silu_f(v0[1]), silu_f(v0[2]), silu_f(v0[3])}, o1 = {silu_f(v1[0]), silu_f(v1[1]), silu_f(v1[2]), silu_f(v1[3])};
    store_pair16((u16*)(ws + OFF_ZS) + (size_t)row * 1024 + (col32 - 1024), pack4(o0), pack4(o1), fq); }
  else if (SEC == 2) {
    const int c32 = col32 - 2048;
    store_pair16((u16*)(ws + OFF_XBC) + (size_t)row * 1536 + c32, pack4(v0), pack4(v1), fq);
    const int pos = row & 2047;
    if (pos >= 2045) {
      float* cp = p.out + O_CONVP + (size_t)(row >> 11) * 4608 + (pos - 2045) * 1536 + c32 + fq * 4;
      *(f32x4*)cp = v0; *(f32x4*)(cp + 16) = v1;
    }
  }
  else if (SEC == 3) { store_pair16((u16*)((char*)p.out + OOFF_Q) + (size_t)row * 512 + (col32 - 3584), pack4(v0), pack4(v1), fq); }
  else { f32x4 o0 = {sigm_f(v0[0]), sigm_f(v0[1]), sigm_f(v0[2]), sigm_f(v0[3])}, o1 = {sigm_f(v1[0]), sigm_f(v1[1]), sigm_f(v1[2]), sigm_f(v1[3])};
    store_pair16((u16*)(ws + OFF_GATE) + (size_t)row * 3072 + (col32 - 4096), pack4(o0), pack4(o1), fq); }
}
__device__ __forceinline__ int secB(int col) { return col < 1024 ? 0 : col < 2048 ? 1 : col < 3584 ? 2 : col < 4096 ? 3 : 4; }

__device__ __forceinline__ void phaseB(const Params& p, const int wv, const int rep) {
  const int wid = wv, wr = wid >> 2, wc = wid & 3;
  char* ws = p.ws;
  const u16* XN = (const u16*)((char*)p.out + OOFF_XN);
  {
    const u16* WIN = (const u16*)(ws + OFF_WIN);
    int t_ = blockIdx.x;
    const int tend = 1792 * rep;
    Acc acc;
    if (t_ < tend) {
      const int t = t_ >= 1792 ? t_ - 1792 : t_;
      kloop_t<1, true>(XN + (size_t)((t & 63) * 256) * 1024, 1024, WIN + (size_t)((t >> 6) * 256) * 1024, 1024, 1024, acc, wv);
    }
    while (t_ < tend) {
      const int t = t_ >= 1792 ? t_ - 1792 : t_;
      const int brow = (t & 63) * 256, bcol = (t >> 6) * 256, sec = secB(bcol);
      ACC_ZERO(acc);
      kloop_t<2>(XN + (size_t)brow * 1024, 1024, WIN + (size_t)bcol * 1024, 1024, 1024, acc, wv);
      t_ += gridDim.x;
      if (t_ < tend) {
        const int tn = t_ >= 1792 ? t_ - 1792 : t_;
        kloop_t<1, false>(XN + (size_t)((tn & 63) * 256) * 1024, 1024, WIN + (size_t)((tn >> 6) * 256) * 1024, 1024, 1024, acc, wv);
      }
      switch (sec) {
        case 0: ACC_FOREACH_PAIR({ epiB2<0>(p, brow + rrow, bcol + cb32, v0, v1, fq); }); break;
        case 1: ACC_FOREACH_PAIR({ epiB2<1>(p, brow + rrow, bcol + cb32, v0, v1, fq); }); break;
        case 2: ACC_FOREACH_PAIR({ epiB2<2>(p, brow + rrow, bcol + cb32, v0, v1, fq); }); break;
        case 3: ACC_FOREACH_PAIR({ epiB2<3>(p, brow + rrow, bcol + cb32, v0, v1, fq); }); break;
        default: ACC_FOREACH_PAIR({ epiB2<4>(p, brow + rrow, bcol + cb32, v0, v1, fq); }); break;
      }
    }
  }
  for (int gb = blockIdx.x; gb < 256; gb += gridDim.x) {
    const int task0 = gb * 14, mt = task0 / 448, nt0 = task0 - mt * 448;
    const u16* Ab = XN + (size_t)(TP + mt * 16) * 1024;
    const u16* Bb = (const u16*)(ws + OFF_WIN) + (size_t)(nt0 * 16) * 1024;
    skgemm<14>([&](int) { return Ab; }, [&](int i) { return Bb + (size_t)i * 16 * 1024; }, [&](int) { return 1024; }, 128, wv);
    for (int i = wv; i < 14; i += 8) {
      const int lane_e = lane_fresh(), fr = lane_e & 15, fq = lane_e >> 4;
      f32x4 a = skreduce(i);
      int row = TP + mt * 16 + fr, col = (nt0 + i) * 16 + fq * 4;
      switch (secB(col)) {
        case 0: epiB<0>(p, row, col, a); break;
        case 1: epiB<1>(p, row, col, a); break;
        case 2: epiB<2>(p, row, col, a); break;
        case 3: epiB<3>(p, row, col, a); break;
        default: epiB<4>(p, row, col, a); break;
      }
    }
  }
  for (int gb = blockIdx.x; gb < 256; gb += gridDim.x) {
    const u16* Bd = (const u16*)(ws + OFF_WDT);
    skgemm<5>([&](int i) { int tk = gb + 256 * i; tk = tk < T / 16 ? tk : 0; return XN + (size_t)(tk * 16) * 1024; }, [&](int) { return Bd; }, [&](int) { return 1024; }, 128, wv);
    for (int i = wv; i < 5; i += 8) {
      const int tk = gb + 256 * i;
      if (tk < T / 16) {
        const int lane_d = lane_fresh(), frd = lane_d & 15, fqd = lane_d >> 4;
        f32x4 a = skreduce(i);
        f32x4 bb = *(const f32x4*)(p.in[15] + fqd * 4);
        f32x4 o = {softplus_f(a[0] + bb[0]), softplus_f(a[1] + bb[1]), softplus_f(a[2] + bb[2]), softplus_f(a[3] + bb[3])};
        *(f32x4*)((float*)(ws + OFF_DT) + (size_t)(tk * 16 + frd) * 16 + fqd * 4) = o;
      }
    }
  }
}

__device__ __forceinline__ void ssd_prompt_item(const Params& p, int item, const int wv) {
  const int lane = lane_fresh(), wid = wv, tid = wv * 64 + lane, fr = lane & 15, fq = lane >> 4;
  const int h = item & 15, b = item >> 4, g = h >> 3;
  char* ws = p.ws;
  u16* C_l = (u16*)g_shm;
  u16* B_l = C_l + 128 * 136;
  u16* G_l = B_l;
  u16* BT_l = B_l + 128 * 136;
  u16* xT_l = BT_l + 128 * 136;
  u16* xw_l = xT_l + 64 * 136;
  u16* h_l = xw_l + 64 * 136;
  float* acum_l = (float*)(h_l + 64 * 136);
  float* dt_l = acum_l + 128;
  const u16* XBC = (const u16*)(ws + OFF_XBC);
  const u16* ZS = (const u16*)(ws + OFF_ZS);
  const float* DT = (const float*)(ws + OFF_DT);
  u16* Y = (u16*)((char*)p.out + OOFF_XN);
  float* YPS = (float*)(ws + OFF_YPS);
  const float Ah = -__expf(p.in[16][h]);
  const float Dh = p.in[17][h];
  const float* convw = p.in[13];
  const float* convb = p.in[14];
  const int cc = tid & 31, rg = tid >> 5;
  const int colbc = (cc < 16) ? (1024 + g * 128 + cc * 8) : (1280 + g * 128 + (cc - 16) * 8);
  const int xc = tid & 7, xr = tid >> 3;
  const int colx = h * 64 + xc * 8;
  const int j0 = rg * 8;
  f32x4 hacc[4];
#pragma unroll
  for (int pb = 0; pb < 4; ++pb) hacc[pb] = (f32x4){0.f, 0.f, 0.f, 0.f};
  u32x4 u[11], ux[5];
  float a0 = 0.f, a1 = 0.f;
#define SSD_PREFETCH(cn) do { const int t0n = b * 2048 + (cn) * 128; \
    _Pragma("unroll") for (int i_ = 0; i_ < 11; ++i_) { const int j_ = j0 - 3 + i_; const bool ok_ = ((cn) > 0) | (j_ >= 0); \
      u[i_] = *(const u32x4*)(XBC + (size_t)(t0n + (ok_ ? j_ : 0)) * 1536 + colbc); const unsigned m_ = ok_ ? 0xffffffffu : 0u; \
      u[i_].x &= m_; u[i_].y &= m_; u[i_].z &= m_; u[i_].w &= m_; } \
    _Pragma("unroll") for (int k_ = 0; k_ < 5; ++k_) { const int j_ = 2 * xr - 3 + k_; const bool ok_ = ((cn) > 0) | (j_ >= 0); \
      ux[k_] = *(const u32x4*)(XBC + (size_t)(t0n + (ok_ ? j_ : 0)) * 1536 + colx); const unsigned m_ = ok_ ? 0xffffffffu : 0u; \
      ux[k_].x &= m_; ux[k_].y &= m_; ux[k_].z &= m_; ux[k_].w &= m_; } \
    if (wid == 0) { a0 = DT[(size_t)(t0n + 2 * lane) * 16 + h]; a1 = DT[(size_t)(t0n + 2 * lane + 1) * 16 + h]; } } while (0)
  SSD_PREFETCH(0);
#pragma unroll 1
  for (int c = 0; c < 16; ++c) {
    const int t0 = b * 2048 + c * 128;
    __syncthreads();
#pragma unroll
    for (int pb = 0; pb < 4; ++pb) *(u32x2*)(h_l + (pb * 16 + fr) * 136 + wid * 16 + fq * 4) = pack4(hacc[pb]);
    if (wid == 0) {
      dt_l[2 * lane] = a0; dt_l[2 * lane + 1] = a1;
      float s = (a0 + a1) * Ah;
#pragma unroll
      for (int o = 1; o < 64; o <<= 1) { float v = shfl_idx_f(s, (lane - o) & 63); if (lane >= o) s += v; }
      acum_l[2 * lane + 1] = s; acum_l[2 * lane] = s - a1 * Ah;
    }
    {
      float w[4][8], bias[8];
#pragma unroll
      for (int k = 0; k < 4; ++k) { f32x4 w0 = *(const f32x4*)(convw + k * 1536 + colbc), w1 = *(const f32x4*)(convw + k * 1536 + colbc + 4);
        w[k][0] = w0[0]; w[k][1] = w0[1]; w[k][2] = w0[2]; w[k][3] = w0[3]; w[k][4] = w1[0]; w[k][5] = w1[1]; w[k][6] = w1[2]; w[k][7] = w1[3]; }
      { f32x4 b0 = *(const f32x4*)(convb + colbc), b1 = *(const f32x4*)(convb + colbc + 4);
        bias[0] = b0[0]; bias[1] = b0[1]; bias[2] = b0[2]; bias[3] = b0[3]; bias[4] = b1[0]; bias[5] = b1[1]; bias[6] = b1[2]; bias[7] = b1[3]; }
      unsigned outp[8][4];
#pragma unroll
      for (int jj = 0; jj < 8; ++jj) {
        float o[8];
#pragma unroll
        for (int e = 0; e < 8; ++e) o[e] = bias[e];
#pragma unroll
        for (int k = 0; k < 4; ++k) {
          u32x4 uu = u[jj + k];
          o[0] += w[k][0] * bflo(uu.x); o[1] += w[k][1] * bfhi(uu.x); o[2] += w[k][2] * bflo(uu.y); o[3] += w[k][3] * bfhi(uu.y);
          o[4] += w[k][4] * bflo(uu.z); o[5] += w[k][5] * bfhi(uu.z); o[6] += w[k][6] * bflo(uu.w); o[7] += w[k][7] * bfhi(uu.w);
        }
#pragma unroll
        for (int e = 0; e < 8; ++e) o[e] = silu_f(o[e]);
#pragma unroll
        for (int e2 = 0; e2 < 4; ++e2) outp[jj][e2] = cvt_pk(o[2 * e2], o[2 * e2 + 1]);
      }
      if (cc < 16) {
#pragma unroll
        for (int jj = 0; jj < 8; ++jj) *(u32x4*)(B_l + (j0 + jj) * 136 + cc * 8) = (u32x4){outp[jj][0], outp[jj][1], outp[jj][2], outp[jj][3]};
#pragma unroll
        for (int e2 = 0; e2 < 4; ++e2) {
          u32x4 lo, hi;
          lo.x = (outp[0][e2] & 0xffffu) | (outp[1][e2] << 16); lo.y = (outp[2][e2] & 0xffffu) | (outp[3][e2] << 16);
          lo.z = (outp[4][e2] & 0xffffu) | (outp[5][e2] << 16); lo.w = (outp[6][e2] & 0xffffu) | (outp[7][e2] << 16);
          hi.x = (outp[0][e2] >> 16) | (outp[1][e2] & 0xffff0000u); hi.y = (outp[2][e2] >> 16) | (outp[3][e2] & 0xffff0000u);
          hi.z = (outp[4][e2] >> 16) | (outp[5][e2] & 0xffff0000u); hi.w = (outp[6][e2] >> 16) | (outp[7][e2] & 0xffff0000u);
          *(u32x4*)(BT_l + (cc * 8 + 2 * e2) * 136 + j0) = lo;
          *(u32x4*)(BT_l + (cc * 8 + 2 * e2 + 1) * 136 + j0) = hi;
        }
      } else {
#pragma unroll
        for (int jj = 0; jj < 8; ++jj) *(u32x4*)(C_l + (j0 + jj) * 136 + (cc - 16) * 8) = (u32x4){outp[jj][0], outp[jj][1], outp[jj][2], outp[jj][3]};
      }
    }
    {
      f32x4 b0 = *(const f32x4*)(convb + colx), b1 = *(const f32x4*)(convb + colx + 4);
      f32x4 w0[4], w1[4];
#pragma unroll
      for (int k = 0; k < 4; ++k) { w0[k] = *(const f32x4*)(convw + k * 1536 + colx); w1[k] = *(const f32x4*)(convw + k * 1536 + colx + 4); }
      float xo[2][8];
#pragma unroll
      for (int r2 = 0; r2 < 2; ++r2) {
        float o[8] = {b0[0], b0[1], b0[2], b0[3], b1[0], b1[1], b1[2], b1[3]};
#pragma unroll
        for (int k = 0; k < 4; ++k) {
          u32x4 uu = ux[r2 + k];
          o[0] += w0[k][0] * bflo(uu.x); o[1] += w0[k][1] * bfhi(uu.x); o[2] += w0[k][2] * bflo(uu.y); o[3] += w0[k][3] * bfhi(uu.y);
          o[4] += w1[k][0] * bflo(uu.z); o[5] += w1[k][1] * bfhi(uu.z); o[6] += w1[k][2] * bflo(uu.w); o[7] += w1[k][3] * bfhi(uu.w);
        }
#pragma unroll
        for (int e = 0; e < 8; ++e) xo[r2][e] = silu_f(o[e]);
      }
#pragma unroll
      for (int e = 0; e < 8; ++e) *(unsigned*)(xT_l + (xc * 8 + e) * 136 + 2 * xr) = cvt_pk(xo[0][e], xo[1][e]);
    }
    __syncthreads();
    if (c < 15) SSD_PREFETCH(c + 1);
    u32x2 zsr[4];
#pragma unroll
    for (int pb = 0; pb < 4; ++pb) zsr[pb] = *(const u32x2*)(ZS + (size_t)(t0 + wid * 16 + fr) * 1024 + h * 64 + pb * 16 + fq * 4);
    bf16x8 cf[4];
#pragma unroll
    for (int ks = 0; ks < 4; ++ks) cf[ks] = *(const bf16x8*)(C_l + (wid * 16 + fr) * 136 + ks * 32 + fq * 8);
    f32x4 cb[8];
#pragma unroll
    for (int jb = 0; jb < 8; ++jb) {
      cb[jb] = (f32x4){0.f, 0.f, 0.f, 0.f};
      if (jb <= wid) {
#pragma unroll
        for (int ks = 0; ks < 4; ++ks) { bf16x8 bf = *(const bf16x8*)(B_l + (jb * 16 + fr) * 136 + ks * 32 + fq * 8); cb[jb] = MFMA16(bf, cf[ks], cb[jb]); }
      }
    }
    const float alast = acum_l[127];
#pragma unroll
    for (int r2 = 0; r2 < 2; ++r2) {
      int pp = (tid >> 4) + 32 * r2, jc = tid & 15;
      u32x4 xv = *(const u32x4*)(xT_l + pp * 136 + jc * 8);
      float wj[8];
#pragma unroll
      for (int e = 0; e < 8; ++e) wj[e] = dt_l[jc * 8 + e] * __expf(alast - acum_l[jc * 8 + e]);
      u32x4 ov;
      ov.x = cvt_pk(bflo(xv.x) * wj[0], bfhi(xv.x) * wj[1]); ov.y = cvt_pk(bflo(xv.y) * wj[2], bfhi(xv.y) * wj[3]);
      ov.z = cvt_pk(bflo(xv.z) * wj[4], bfhi(xv.z) * wj[5]); ov.w = cvt_pk(bflo(xv.w) * wj[6], bfhi(xv.w) * wj[7]);
      *(u32x4*)(xw_l + pp * 136 + jc * 8) = ov;
    }
    __syncthreads();
    {
      const int i = wid * 16 + fr;
      const float ai = acum_l[i];
#pragma unroll
      for (int jb = 0; jb < 8; ++jb) {
        f32x4 gv = {0.f, 0.f, 0.f, 0.f};
        if (jb <= wid) {
          f32x4 aj = *(const f32x4*)(acum_l + jb * 16 + fq * 4);
          f32x4 dj = *(const f32x4*)(dt_l + jb * 16 + fq * 4);
#pragma unroll
          for (int e = 0; e < 4; ++e) { int j = jb * 16 + fq * 4 + e; gv[e] = (j <= i) ? cb[jb][e] * __expf(ai - aj[e]) * dj[e] : 0.f; }
        }
        *(u32x2*)(G_l + i * 136 + jb * 16 + fq * 4) = pack4(gv);
      }
    }
    __syncthreads();
    {
      const int i = wid * 16 + fr, tok = t0 + i;
      const float ea = __expf(acum_l[i]);
      float ss = 0.f;
      bf16x8 gf[4];
#pragma unroll
      for (int ks = 0; ks < 4; ++ks) gf[ks] = *(const bf16x8*)(G_l + (wid * 16 + fr) * 136 + ks * 32 + fq * 8);
#pragma unroll
      for (int pb = 0; pb < 4; ++pb) {
        f32x4 y = {0.f, 0.f, 0.f, 0.f};
#pragma unroll
        for (int ks = 0; ks < 4; ++ks) { bf16x8 hf = *(const bf16x8*)(h_l + (pb * 16 + fr) * 136 + ks * 32 + fq * 8); y = MFMA16(hf, cf[ks], y); }
        y = y * ea;
#pragma unroll
        for (int ks = 0; ks < 4; ++ks) {
          if (ks <= (wid >> 1)) {
            bf16x8 xf = *(const bf16x8*)(xT_l + (pb * 16 + fr) * 136 + ks * 32 + fq * 8);
            y = MFMA16(xf, gf[ks], y);
          }
        }
        const int pc = pb * 16 + fq * 4;
        f32x4 zs = unpack4(zsr[pb]);
#pragma unroll
        for (int e = 0; e < 4; ++e) { float xv = bf2f(xT_l[(pc + e) * 136 + i]); y[e] = (y[e] + xv * Dh) * zs[e]; ss += y[e] * y[e]; }
        *(u32x2*)(Y + (size_t)tok * 1024 + h * 64 + pc) = pack4(y);
      }
      ss += shfl_xor_f(ss, 16); ss += shfl_xor_f(ss, 32);
      if (fq == 0) { YPS[(size_t)tok * 32 + g * 16 + (h & 7) * 2] = ss; YPS[(size_t)tok * 32 + g * 16 + (h & 7) * 2 + 1] = 0.f; }
    }
    {
      const float dl = __expf(alast);
      bf16x8 btf[4];
#pragma unroll
      for (int ks = 0; ks < 4; ++ks) btf[ks] = *(const bf16x8*)(BT_l + (wid * 16 + fr) * 136 + ks * 32 + fq * 8);
#pragma unroll
      for (int pb = 0; pb < 4; ++pb) {
        hacc[pb] = hacc[pb] * dl;
#pragma unroll
        for (int ks = 0; ks < 4; ++ks) {
          bf16x8 xwf = *(const bf16x8*)(xw_l + (pb * 16 + fr) * 136 + ks * 32 + fq * 8);
          hacc[pb] = MFMA16(btf[ks], xwf, hacc[pb]);
        }
      }
    }
  }
#undef SSD_PREFETCH
#pragma unroll
  for (int pb = 0; pb < 4; ++pb)
    *(f32x4*)(p.out + O_SSMP + ((size_t)(b * 16 + h) * 64 + pb * 16 + fr) * 128 + wid * 16 + fq * 4) = hacc[pb];
}

__device__ __forceinline__ void memkv_tile(const Params& p, int item, const int wv, unsigned* bar) {
  const int wid = wv, wr = wid >> 2, wc = wid & 3;
  const int h = item & 3, b = item >> 2;
  char* ws = p.ws;
  Acc acc; ACC_ZERO(acc);
  kloop((const u16*)(ws + OFF_MN) + (size_t)(b * 256) * 1024, 1024, (const u16*)(ws + OFF_WKV) + (size_t)(h * 256) * 1024, 1024, 1024, acc, wv);
  ACC_FOREACH({
    const int row = b * 256 + rrow;
    const int col = (rcol < 128) ? (h * 128 + rcol) : (512 + h * 128 + rcol - 128);
    epiB<5>(p, row, col, v);
  });
  asm volatile("s_waitcnt vmcnt(0)" ::: "memory");
  __syncthreads();
  if (wv == 0) { if (lane_fresh() == 0) { __builtin_amdgcn_fence(__ATOMIC_RELEASE, "agent"); asm volatile("s_waitcnt vmcnt(0)" ::: "memory"); (void)xb_add(&bar[6144 + item * 16], 1u); } }
}

__device__ __forceinline__ void attn_prompt_item(const Params& p, int item, const int wv, unsigned* bar) {
  const int lane = lane_fresh(), wid = wv, tid = wv * 64 + lane, fr = lane & 15, fq = lane >> 4;
  const int qt = item & 7, h = (item >> 3) & 3, b = item >> 5;
  char* ws = p.ws;
  u16* K_l = (u16*)g_shm;
  u16* VT_l = K_l + 256 * 136;
  const u16* KP = (const u16*)(ws + OFF_KP);
  const u16* VT = (const u16*)(ws + OFF_VT);
  u16* Q = (u16*)((char*)p.out + OOFF_Q);
  if (wv == 0) { if (lane == 0) { XB_SPIN(xb_ld(&bar[6144 + (b * 4 + h) * 16]) == 0u, bar); } }
  __syncthreads();
  __builtin_amdgcn_fence(__ATOMIC_ACQUIRE, "agent");
#pragma unroll
  for (int i = 0; i < 8; ++i) {
    int idx = i * 512 + tid, mm = idx >> 4, ch = idx & 15;
    *(u32x4*)(K_l + mm * 136 + ch * 8) = *(const u32x4*)(KP + (size_t)(b * 256 + mm) * 512 + h * 128 + ch * 8);
  }
#pragma unroll
  for (int i = 0; i < 8; ++i) {
    int idx = i * 512 + tid, d = idx >> 5, ch = idx & 31;
    *(u32x4*)(VT_l + d * 264 + ch * 8) = *(const u32x4*)(VT + ((size_t)(b * 4 + h) * 128 + d) * 256 + ch * 8);
  }
  const int q0 = b * 2048 + qt * 256 + wid * 32;
  bf16x8 qf[2][4];
#pragma unroll
  for (int qb = 0; qb < 2; ++qb)
#pragma unroll
    for (int ks = 0; ks < 4; ++ks) qf[qb][ks] = *(const bf16x8*)(Q + (size_t)(q0 + qb * 16 + fr) * 512 + h * 128 + ks * 32 + fq * 8);
  __syncthreads();
  f32x4 s[16][2];
#pragma unroll
  for (int mb = 0; mb < 16; ++mb) {
    s[mb][0] = (f32x4){0.f, 0.f, 0.f, 0.f}; s[mb][1] = (f32x4){0.f, 0.f, 0.f, 0.f};
#pragma unroll
    for (int ks = 0; ks < 4; ++ks) {
      bf16x8 kf = *(const bf16x8*)(K_l + (mb * 16 + fr) * 136 + ks * 32 + fq * 8);
      s[mb][0] = MFMA16(kf, qf[0][ks], s[mb][0]);
      s[mb][1] = MFMA16(kf, qf[1][ks], s[mb][1]);
    }
  }
  const float cexp = 0.08838834764831845f * 1.4426950408889634f;
  float inv[2];
  bf16x8 pf[2][8];
#pragma unroll
  for (int qb = 0; qb < 2; ++qb) {
    float mx = -1e30f;
#pragma unroll
    for (int mb = 0; mb < 16; ++mb) mx = fmaxf(mx, fmaxf(fmaxf(s[mb][qb][0], s[mb][qb][1]), fmaxf(s[mb][qb][2], s[mb][qb][3])));
    mx = fmaxf(mx, shfl_xor_f(mx, 16)); mx = fmaxf(mx, shfl_xor_f(mx, 32));
    float sum = 0.f;
#pragma unroll
    for (int mb = 0; mb < 16; ++mb)
#pragma unroll
      for (int e = 0; e < 4; ++e) { float pv = exp2f((s[mb][qb][e] - mx) * cexp); s[mb][qb][e] = pv; sum += pv; }
    sum += shfl_xor_f(sum, 16); sum += shfl_xor_f(sum, 32);
    inv[qb] = 1.f / sum;
#pragma unroll
    for (int st = 0; st < 8; ++st) {
      u32x2 lo = pack4(s[2 * st][qb]), hi = pack4(s[2 * st + 1][qb]);
      u32x4 w = {lo.x, lo.y, hi.x, hi.y};
      pf[qb][st] = __builtin_bit_cast(bf16x8, w);
    }
  }
  f32x4 o[8][2];
#pragma unroll
  for (int db = 0; db < 8; ++db) { o[db][0] = (f32x4){0.f, 0.f, 0.f, 0.f}; o[db][1] = (f32x4){0.f, 0.f, 0.f, 0.f}; }
#pragma unroll
  for (int st = 0; st < 8; ++st)
#pragma unroll
    for (int db = 0; db < 8; ++db) {
      bf16x8 vf = *(const bf16x8*)(VT_l + (db * 16 + fr) * 264 + st * 32 + fq * 8);
      o[db][0] = MFMA16(vf, pf[0][st], o[db][0]);
      o[db][1] = MFMA16(vf, pf[1][st], o[db][1]);
    }
#pragma unroll
  for (int qb = 0; qb < 2; ++qb)
#pragma unroll
    for (int db = 0; db < 8; ++db)
      *(u32x2*)((u16*)(ws + OFF_XA) + (size_t)(q0 + qb * 16 + fr) * 512 + h * 128 + db * 16 + fq * 4) = pack4(o[db][qb] * inv[qb]);
}

__device__ __forceinline__ void gmlp_prompt_item(const Params& p, int item, const int wv) {
  const int lane = lane_fresh(), wid = wv, tid = wv * 64 + lane, fr = lane & 15, fq = lane >> 4;
  const int gp = item & 1, c = (item >> 1) & 15, b = item >> 5;
  const int t0 = b * 2048 + c * 128;
  char* ws = p.ws;
  u16* VnT = (u16*)g_shm;
  const u16* UV = (const u16*)(ws + OFF_UV);
  const u16* WSB = (const u16*)(ws + OFF_WSB);
  u16* GM = (u16*)((char*)p.out + OOFF_GM);
  __syncthreads();
  {
    const int row = tid >> 2, qq = tid & 3;
    const u16* vrow = UV + (size_t)(t0 + row) * 1024 + 512;
    float sm = 0.f, sq = 0.f;
#pragma unroll
    for (int i = 0; i < 16; ++i) {
      u32x4 w = *(const u32x4*)(vrow + qq * 128 + i * 8);
      float f[8] = {bflo(w.x), bfhi(w.x), bflo(w.y), bfhi(w.y), bflo(w.z), bfhi(w.z), bflo(w.w), bfhi(w.w)};
#pragma unroll
      for (int e = 0; e < 8; ++e) { sm += f[e]; sq += f[e] * f[e]; }
    }
    sm += shfl_xor_f(sm, 1); sm += shfl_xor_f(sm, 2); sq += shfl_xor_f(sq, 1); sq += shfl_xor_f(sq, 2);
    const float mean = sm * (1.f / 512.f), var = fmaxf(sq * (1.f / 512.f) - mean * mean, 0.f), rstd = rsqrtf(var + EPS);
#pragma unroll
    for (int i = 0; i < 8; ++i) {
      const int cl = qq * 64 + i * 8, col = gp * 256 + cl;
      u32x4 w = *(const u32x4*)(vrow + col);
      float f[8] = {bflo(w.x), bfhi(w.x), bflo(w.y), bfhi(w.y), bflo(w.z), bfhi(w.z), bflo(w.w), bfhi(w.w)};
#pragma unroll
      for (int e = 0; e < 8; ++e) {
        float vn = (f[e] - mean) * rstd * p.in[9][col + e] + p.in[10][col + e];
        VnT[(cl + e) * 136 + row] = f2bf(vn);
      }
    }
  }
  __syncthreads();
  f32x4 acc[16];
#pragma unroll
  for (int db = 0; db < 16; ++db) acc[db] = (f32x4){0.f, 0.f, 0.f, 0.f};
#pragma unroll
  for (int ks = 0; ks < 4; ++ks) {
    if (ks <= (wid >> 1)) {
      bf16x8 w0 = *(const bf16x8*)(WSB + ((size_t)(gp * 2) * 128 + wid * 16 + fr) * 128 + ks * 32 + fq * 8);
      bf16x8 w1 = *(const bf16x8*)(WSB + ((size_t)(gp * 2 + 1) * 128 + wid * 16 + fr) * 128 + ks * 32 + fq * 8);
#pragma unroll
      for (int db = 0; db < 16; ++db) {
        bf16x8 vf = *(const bf16x8*)(VnT + (db * 16 + fr) * 136 + ks * 32 + fq * 8);
        acc[db] = MFMA16(vf, db < 8 ? w0 : w1, acc[db]);
      }
    }
  }
  const int tt = wid * 16 + fr, tok = t0 + tt;
#pragma unroll
  for (int db = 0; db < 16; ++db) {
    const int gs = gp * 2 + (db >> 3), col = gs * 128 + (db & 7) * 16 + fq * 4;
    const float bsv = p.in[12][gs * 128 + tt];
    f32x4 u = unpack4(*(const u32x2*)(UV + (size_t)tok * 1024 + col));
    f32x4 o = u * (acc[db] + bsv);
    *(u32x2*)(GM + (size_t)tok * 512 + col) = pack4(o);
  }
}

__device__ __forceinline__ void gmlp_sample_row(const Params& p, int bidx, const int wv) {
  const int lane = lane_fresh();
  char* ws = p.ws;
  const u16* UV = (const u16*)(ws + OFF_UV);
  u16* GM = (u16*)((char*)p.out + OOFF_GM);
  const int tok = TP + bidx;
  u32x4 w = *(const u32x4*)(UV + (size_t)tok * 1024 + 512 + lane * 8);
  float f[8] = {bflo(w.x), bfhi(w.x), bflo(w.y), bfhi(w.y), bflo(w.z), bfhi(w.z), bflo(w.w), bfhi(w.w)};
  float sm = 0.f, sq = 0.f;
#pragma unroll
  for (int e = 0; e < 8; ++e) { sm += f[e]; sq += f[e] * f[e]; }
  sm = wave_sum(sm); sq = wave_sum(sq);
  const float mean = sm * (1.f / 512.f), var = fmaxf(sq * (1.f / 512.f) - mean * mean, 0.f), rstd = rsqrtf(var + EPS);
  const int col = lane * 8, gs = col >> 7;
  const float w00 = p.in[11][gs * 16384], bs0 = p.in[12][gs * 128];
  u32x4 uw = *(const u32x4*)(UV + (size_t)tok * 1024 + col);
  float u[8] = {bflo(uw.x), bfhi(uw.x), bflo(uw.y), bfhi(uw.y), bflo(uw.z), bfhi(uw.z), bflo(uw.w), bfhi(uw.w)};
  float vn[8], o[8];
#pragma unroll
  for (int e = 0; e < 8; ++e) { vn[e] = (f[e] - mean) * rstd * p.in[9][col + e] + p.in[10][col + e]; o[e] = u[e] * (w00 * vn[e] + bs0); }
  *(f32x4*)(p.out + O_GMV + (size_t)bidx * 512 + col) = (f32x4){vn[0], vn[1], vn[2], vn[3]};
  *(f32x4*)(p.out + O_GMV + (size_t)bidx * 512 + col + 4) = (f32x4){vn[4], vn[5], vn[6], vn[7]};
  u32x4 ow = {cvt_pk(o[0], o[1]), cvt_pk(o[2], o[3]), cvt_pk(o[4], o[5]), cvt_pk(o[6], o[7])};
  *(u32x4*)(GM + (size_t)tok * 512 + col) = ow;
}

__device__ __forceinline__ void ssd_sample_item(const Params& p, int item, const int wv) {
  const int lane = lane_fresh();
  const int h = item & 15, b = item >> 4, g = h >> 3, tok = TP + b;
  char* ws = p.ws;
  const u16* XBC = (const u16*)(ws + OFF_XBC);
  const u16* ZS = (const u16*)(ws + OFF_ZS);
  const float* DT = (const float*)(ws + OFF_DT);
  u16* Y = (u16*)((char*)p.out + OOFF_XN);
  float* YPS = (float*)(ws + OFF_YPS);
  const float* sc = p.in[5] + (size_t)b * 4608;
  const float* convw = p.in[13];
  const float* convb = p.in[14];
  auto conv1 = [&](int col) -> float {
    float o = convb[col] + convw[col] * sc[col] + convw[1536 + col] * sc[1536 + col] + convw[3072 + col] * sc[3072 + col]
            + convw[4608 + col] * bf2f(XBC[(size_t)tok * 1536 + col]);
    return silu_f(o);
  };
  const float x = conv1(h * 64 + lane);
  const int n4 = (lane & 31) * 4, hf = lane >> 5;
  float Bv[4], Cv[4];
#pragma unroll
  for (int e = 0; e < 4; ++e) { Bv[e] = conv1(1024 + g * 128 + n4 + e); Cv[e] = conv1(1280 + g * 128 + n4 + e); }
  const float dt = DT[(size_t)tok * 16 + h];
  const float dA = __expf(-dt * __expf(p.in[16][h]));
  const float* st = p.in[6] + ((size_t)(b * 16 + h) * 64) * 128;
  float* so = p.out + O_SSMS + ((size_t)(b * 16 + h) * 64) * 128;
  float ymine = 0.f;
#pragma unroll 8
  for (int r = 0; r < 32; ++r) {
    const int pp = 2 * r + hf;
    f32x4 hv = *(const f32x4*)(st + (size_t)pp * 128 + n4);
    const float xp = shfl_idx_f(x, pp) * dt;
    f32x4 hn;
    float yp = 0.f;
#pragma unroll
    for (int e = 0; e < 4; ++e) { hn[e] = dA * hv[e] + xp * Bv[e]; yp += hn[e] * Cv[e]; }
    *(f32x4*)(so + (size_t)pp * 128 + n4) = hn;
#pragma unroll
    for (int o = 16; o >= 1; o >>= 1) yp += shfl_xor_f(yp, o);
    if ((lane & 31) == r) ymine = yp;
  }
  const int pm = 2 * (lane & 31) + hf;
  const float xm = shfl_idx_f(x, pm);
  const float zs = bf2f(ZS[(size_t)tok * 1024 + h * 64 + pm]);
  const float yg = (ymine + xm * p.in[17][h]) * zs;
  float ss = wave_sum(yg * yg);
  Y[(size_t)tok * 1024 + h * 64 + pm] = f2bf(yg);
  if (lane == 0) { YPS[(size_t)tok * 32 + g * 16 + (h & 7) * 2] = ss; YPS[(size_t)tok * 32 + g * 16 + (h & 7) * 2 + 1] = 0.f; }
}

__device__ __forceinline__ void attn_sample_item(const Params& p, int item, const int wv) {
  const int lane = lane_fresh(), wid = wv, tid = wv * 64 + lane;
  const int h = item & 3, b = item >> 2, tok = TP + b;
  float* sc_l = (float*)g_shm;
  float* red_l = sc_l + 256;
  u16* Q = (u16*)((char*)p.out + OOFF_Q);
  const float* Kc = p.in[3] + ((size_t)b * 256 * 4 + h) * 128;
  const float* Vc = p.in[4] + ((size_t)b * 256 * 4 + h) * 128;
  const int vdch = tid & 31, vmg = tid >> 5;
  f32x4 vreg[16];
#pragma unroll
  for (int i = 0; i < 16; ++i) vreg[i] = *(const f32x4*)(Vc + (size_t)(vmg * 16 + i) * 512 + vdch * 4);
  __syncthreads();
  {
    const int dch = lane & 15, ksub = lane >> 4;
    u32x4 qw = *(const u32x4*)(Q + (size_t)tok * 512 + h * 128 + dch * 8);
    float q[8] = {bflo(qw.x), bfhi(qw.x), bflo(qw.y), bfhi(qw.y), bflo(qw.z), bfhi(qw.z), bflo(qw.w), bfhi(qw.w)};
#pragma unroll
    for (int it = 0; it < 8; ++it) {
      const int mm = wid * 32 + it * 4 + ksub;
      f32x4 k0 = *(const f32x4*)(Kc + (size_t)mm * 512 + dch * 8), k1 = *(const f32x4*)(Kc + (size_t)mm * 512 + dch * 8 + 4);
      float d = q[0] * k0[0] + q[1] * k0[1] + q[2] * k0[2] + q[3] * k0[3] + q[4] * k1[0] + q[5] * k1[1] + q[6] * k1[2] + q[7] * k1[3];
      d += shfl_xor_f(d, 1); d += shfl_xor_f(d, 2); d += shfl_xor_f(d, 4); d += shfl_xor_f(d, 8);
      if (dch == 0) sc_l[mm] = d * 0.08838834764831845f;
    }
  }
  __syncthreads();
  float pv[4];
  {
    float mx = -1e30f;
#pragma unroll
    for (int i = 0; i < 4; ++i) { pv[i] = sc_l[lane + 64 * i]; mx = fmaxf(mx, pv[i]); }
    mx = wave_max(mx);
    float sum = 0.f;
#pragma unroll
    for (int i = 0; i < 4; ++i) { pv[i] = __expf(pv[i] - mx); sum += pv[i]; }
    sum = wave_sum(sum);
    const float inv = 1.f / sum;
#pragma unroll
    for (int i = 0; i < 4; ++i) pv[i] *= inv;
  }
  __syncthreads();
  if (wid == 0) {
#pragma unroll
    for (int i = 0; i < 4; ++i) sc_l[lane + 64 * i] = pv[i];
  }
  __syncthreads();
  {
    f32x4 acc = {0.f, 0.f, 0.f, 0.f};
#pragma unroll
    for (int i = 0; i < 16; ++i) acc += vreg[i] * sc_l[vmg * 16 + i];
    *(f32x4*)(red_l + vmg * 128 + vdch * 4) = acc;
  }
  __syncthreads();
  if (tid < 128) {
    float o = 0.f;
#pragma unroll
    for (int mg = 0; mg < 16; ++mg) o += red_l[mg * 128 + tid];
    ((u16*)(p.ws + OFF_XA))[(size_t)tok * 512 + h * 128 + tid] = f2bf(o);
  }
}

__device__ __forceinline__ void phaseC(const Params& p, const int wv, const int r0, const int r1, const int r2, const int r3, const int r4, unsigned* bar) {
  const int wid = wv;
  const int nS = gridDim.x >> 1;
  if ((int)blockIdx.x < nS) {
    for (int it = blockIdx.x; it < 128 * r0; it += nS) ssd_prompt_item(p, it & 127, wv);
  } else {
    const int ob = blockIdx.x - nS, nO = gridDim.x - nS;
    const int gw = ob * 8 + wid, nw = nO * 8;
    for (int it = ob; it < 32; it += nO) memkv_tile(p, it, wv, bar);
    for (int it = gw; it < 2048 * r1; it += nw) ssd_sample_item(p, it & 2047, wv);
    if (nO >= 64) {
      if (ob < 32) attn_sample_item(p, ob, wv);
      else for (int it = 32 + (ob - 32); it < 512; it += nO - 32) attn_sample_item(p, it, wv);
    } else {
      for (int it = ob; it < 512; it += nO) attn_sample_item(p, it, wv);
    }
    for (int it = ob; it < 256 * r2; it += nO) attn_prompt_item(p, it & 255, wv, bar);
    for (int it = ob; it < 256 * r3; it += nO) gmlp_prompt_item(p, it & 255, wv);
    for (int it = gw; it < 128; it += nw) gmlp_sample_row(p, it, wv);
  }
}

__device__ __forceinline__ void phaseD(const Params& p, const int wv, const int rep) {
  const int wid = wv, wr = wid >> 2, wc = wid & 3;
  char* ws = p.ws;
  const u16* GM = (const u16*)((char*)p.out + OOFF_GM);
  const u16* Y = (const u16*)((char*)p.out + OOFF_XN);
  const u16* XA = (const u16*)(ws + OFF_XA);
  const u16* GATE = (const u16*)(ws + OFF_GATE);
  const float* YPS = (const float*)(ws + OFF_YPS);
  u16* MERGED = (u16*)(ws + OFF_MERGED);
  const u16* WGM = (const u16*)(ws + OFF_WGM);
  const u16* WSSD = (const u16*)(ws + OFF_WSSD);
  const u16* WXA = (const u16*)(ws + OFF_WXA);
  float* rs_l = (float*)(g_shm + 131072);
  for (int t_ = blockIdx.x; t_ < 256 * rep; t_ += gridDim.x) {
    const int t = t_ & 255;
    const int pm = t & 63, pn = t >> 6, brow = pm * 256, bcol = pn * 256;
    __syncthreads();
    {
      const int tid = wv * 64 + lane_fresh();
      const int r = tid >> 1, gg = tid & 1;
      const float* ps = YPS + (size_t)(brow + r) * 32 + gg * 16;
      f32x4 a = *(const f32x4*)ps + *(const f32x4*)(ps + 4) + *(const f32x4*)(ps + 8) + *(const f32x4*)(ps + 12);
      rs_l[r * 2 + gg] = rsqrtf((a[0] + a[1] + a[2] + a[3]) * (1.f / 512.f) + EPS);
    }
    auto opnd = [&](int br, const u16*& Ap, const u16*& Bp, int& ld) {
      if (br == 0) { Ap = GM + (size_t)brow * 512; Bp = WGM + (size_t)bcol * 512; ld = 512; }
      else if (br == 1) { Ap = Y + (size_t)brow * 1024; Bp = WSSD + (size_t)bcol * 1024; ld = 1024; }
      else if (br == 2) { Ap = Y + (size_t)brow * 1024 + 512; Bp = WSSD + (size_t)bcol * 1024 + 512; ld = 1024; }
      else { Ap = XA + (size_t)brow * 512; Bp = WXA + (size_t)bcol * 512; ld = 512; }
    };
    Acc acc; ACC_ZERO(acc);
    { const u16 *Ap, *Bp; int ld; opnd(0, Ap, Bp, ld); kloop_t<1, true>(Ap, ld, Bp, ld, 512, acc, wv); }
#pragma unroll 1
    for (int br = 0; br < 4; ++br) {
      const u16 *Ap, *Bp; int ld; opnd(br, Ap, Bp, ld);
      kloop_t<2>(Ap, ld, Bp, ld, 512, acc, wv);
      const int gnum = (br == 0) ? 0 : (br == 2) ? 1024 : 2048, gden = (br == 0) ? 1024 : 2048;
      const int lane_e = lane_fresh(), fr = lane_e & 15, fq = lane_e >> 4;
      const int r0 = brow + wr * 64 + fr, c0 = bcol + wc * 32 + fq * 4;
      u32x2 gq[2][4], dq[2][4];
#define D_LOAD(g, buf) do { const int row_ = r0 + ((g) >> 2) * 128 + ((g) & 3) * 16; \
        _Pragma("unroll") for (int q = 0; q < 4; ++q) { const int col_ = c0 + (q >> 1) * 128 + (q & 1) * 16; \
          gq[buf][q] = (u32x2){0x3f803f80u, 0x3f803f80u}; dq[buf][q] = (u32x2){0x3f803f80u, 0x3f803f80u}; \
          if (br != 1) gq[buf][q] = *(const u32x2*)(GATE + (size_t)row_ * 3072 + gnum + col_); \
          if (br == 0 || br == 2) dq[buf][q] = *(const u32x2*)(GATE + (size_t)row_ * 3072 + gden + col_); } } while (0)
      D_LOAD(0, 0);
      if (br < 3) { const u16 *An, *Bn; int ldn; opnd(br + 1, An, Bn, ldn); kloop_t<1, false>(An, ldn, Bn, ldn, 512, acc, wv); }
#pragma unroll
      for (int g = 0; g < 8; ++g) {
        if (g < 7) D_LOAD(g + 1, (g + 1) & 1);
        __builtin_amdgcn_sched_barrier(0);
        const int ai = g >> 2, m = g & 3, rrow = ai * 128 + wr * 64 + m * 16 + fr, row_ = brow + rrow;
        const float rs0 = rs_l[rrow * 2], rs1 = rs_l[rrow * 2 + 1];
        const float rsc = (br == 0) ? __builtin_amdgcn_rcpf(rs0) : (br == 1) ? rs0 * __builtin_amdgcn_rcpf(rs1) : (br == 2) ? rs1 : 1.f;
#pragma unroll
        for (int q = 0; q < 4; ++q) {
          const int col_ = c0 + (q >> 1) * 128 + (q & 1) * 16;
          const f32x4 gn = unpack4(gq[g & 1][q]), gd = unpack4(dq[g & 1][q]);
          f32x4 sc;
#pragma unroll
          for (int e = 0; e < 4; ++e) sc[e] = gn[e] * rsc * __builtin_amdgcn_rcpf(fmaxf(gd[e], 1e-30f));
          f32x4 o = acc[ai][q >> 1][m][q & 1] * sc;
          acc[ai][q >> 1][m][q & 1] = o;
          if (br == 3) *(u32x2*)(MERGED + (size_t)row_ * 1024 + col_) = pack4(o);
        }
        __builtin_amdgcn_sched_barrier(0);
      }
#undef D_LOAD
    }
  }
  for (int gb = blockIdx.x; gb < 256; gb += gridDim.x) {
    const int task0 = gb * 2, mt = task0 >> 6, nt0 = task0 & 63, r0 = TP + mt * 16;
    skgemm<8>([&](int i) { const int br = i & 3; return br == 0 ? GM + (size_t)r0 * 512 : br == 1 ? Y + (size_t)r0 * 1024 : br == 2 ? Y + (size_t)r0 * 1024 + 512 : XA + (size_t)r0 * 512; },
              [&](int i) { const int br = i & 3, c0 = (nt0 + (i >> 2)) * 16; return br == 0 ? WGM + (size_t)c0 * 512 : br == 1 ? WSSD + (size_t)c0 * 1024 : br == 2 ? WSSD + (size_t)c0 * 1024 + 512 : WXA + (size_t)c0 * 512; },
              [&](int i) { const int br = i & 3; return (br == 1 || br == 2) ? 1024 : 512; }, 64, wv);
    if (wv < 2) {
      const int lane_e = lane_fresh(), fr = lane_e & 15, fq = lane_e >> 4;
      const int row = r0 + fr, col = (nt0 + wv) * 16 + fq * 4;
      const u16* gp_ = GATE + (size_t)row * 3072 + col;
      f32x4 g0 = unpack4(*(const u32x2*)gp_), g1 = unpack4(*(const u32x2*)(gp_ + 1024)), g2 = unpack4(*(const u32x2*)(gp_ + 2048));
      float rs[2];
#pragma unroll
      for (int gg = 0; gg < 2; ++gg) {
        const float* ps = YPS + (size_t)row * 32 + gg * 16;
        f32x4 a = *(const f32x4*)ps + *(const f32x4*)(ps + 4) + *(const f32x4*)(ps + 8) + *(const f32x4*)(ps + 12);
        rs[gg] = rsqrtf((a[0] + a[1] + a[2] + a[3]) * (1.f / 512.f) + EPS);
      }
      f32x4 a0 = skreduce(wv * 4 + 0), a1 = skreduce(wv * 4 + 1), a2 = skreduce(wv * 4 + 2), a3 = skreduce(wv * 4 + 3);
      f32x4 o = g0 * a0 + g1 * (a1 * rs[0] + a2 * rs[1]) + g2 * a3;
      *(u32x2*)(MERGED + (size_t)row * 1024 + col) = pack4(o);
    }
  }
}

__device__ __forceinline__ void phaseE(const Params& p, const int wv, const int rep) {
  const int wid = wv, wr = wid >> 2, wc = wid & 3;
  char* ws = p.ws;
  const u16* MERGED = (const u16*)(ws + OFF_MERGED);
  const u16* WOUT = (const u16*)(ws + OFF_WOUT);
  u16* H2B = (u16*)(ws + OFF_H2B);
  float* PS = (float*)(ws + OFF_PS);
  float* PSS = (float*)(ws + OFF_PSS);
  for (int t_ = blockIdx.x; t_ < 256 * rep; t_ += gridDim.x) {
    const int t = t_ & 255;
    const int pm = t & 63, pn = t >> 6, brow = pm * 256, bcol = pn * 256;
    Acc acc; ACC_ZERO(acc);
    kloop(MERGED + (size_t)brow * 1024, 1024, WOUT + (size_t)bcol * 1024, 1024, 1024, acc, wv);
    const int lane_e = lane_fresh(), fr = lane_e & 15, fq = lane_e >> 4; (void)fr; (void)fq;
#pragma unroll
    for (int ai = 0; ai < 2; ++ai)
#pragma unroll
      for (int m = 0; m < 4; ++m) {
        const int row = brow + ai * 128 + wr * 64 + m * 16 + fr;
        float ss = 0.f;
#pragma unroll
        for (int bj = 0; bj < 2; ++bj)
#pragma unroll
          for (int n = 0; n < 2; ++n) {
            const int col = bcol + bj * 128 + wc * 32 + n * 16 + fq * 4;
            f32x4 v = acc[ai][bj][m][n] + *(const f32x4*)(p.in[0] + (size_t)row * 1024 + col);
            *(u32x2*)(H2B + (size_t)row * 1024 + col) = pack4(v);
            ss += v[0] * v[0] + v[1] * v[1] + v[2] * v[2] + v[3] * v[3];
          }
        ss += shfl_xor_f(ss, 16); ss += shfl_xor_f(ss, 32);
        if (fq == 0) PS[(size_t)row * 16 + pn * 4 + wc] = ss;
      }
  }
  for (int gb = blockIdx.x; gb < 256; gb += gridDim.x) {
    const int task0 = gb * 2, mt = task0 >> 6, nt0 = task0 & 63;
    const u16* Ab = MERGED + (size_t)(TP + mt * 16) * 1024;
    skgemm<2>([&](int) { return Ab; }, [&](int i) { return WOUT + (size_t)((nt0 + i) * 16) * 1024; }, [&](int) { return 1024; }, 128, wv);
    if (wv < 2) {
      const int lane_e = lane_fresh(), fr = lane_e & 15, fq = lane_e >> 4;
      const int ntl = nt0 + wv, row = TP + mt * 16 + fr, col = ntl * 16 + fq * 4;
      f32x4 v = skreduce(wv) + *(const f32x4*)(p.in[1] + (size_t)(row - TP) * 1024 + col);
      *(u32x2*)(H2B + (size_t)row * 1024 + col) = pack4(v);
      float ss = v[0] * v[0] + v[1] * v[1] + v[2] * v[2] + v[3] * v[3];
      ss += shfl_xor_f(ss, 16); ss += shfl_xor_f(ss, 32);
      if (fq == 0) PSS[(size_t)(row - TP) * 64 + ntl] = ss;
    }
  }
}

__device__ __forceinline__ void phaseF(const Params& p, const int wv, const int rep) {
  const int wid = wv, wr = wid >> 2, wc = wid & 3;
  char* ws = p.ws;
  const u16* H2B = (const u16*)(ws + OFF_H2B);
  const u16* WUP = (const u16*)(ws + OFF_WUP);
  u16* ACT = (u16*)(ws + OFF_ACT);
  const float* PS = (const float*)(ws + OFF_PS);
  const float* PSS = (const float*)(ws + OFF_PSS);
  {
    float* rs_l = (float*)(g_shm + 131072);
    auto fill_rs = [&](int t, int buf) {
      const int tid = wv * 64 + lane_fresh();
      if (tid < 256) {
        const float* ps = PS + (size_t)((t & 63) * 256 + tid) * 16;
        f32x4 a = *(const f32x4*)ps + *(const f32x4*)(ps + 4) + *(const f32x4*)(ps + 8) + *(const f32x4*)(ps + 12);
        rs_l[buf * 256 + tid] = rsqrtf((a[0] + a[1] + a[2] + a[3]) * (1.f / 1024.f) + EPS);
      }
    };
    int t_ = blockIdx.x, it = 0;
    const int tend = 1024 * rep;
    Acc acc;
    if (t_ < tend) {
      const int t = t_ & 1023;
      fill_rs(t, 0);
      kloop_t<1, true>(H2B + (size_t)((t & 63) * 256) * 1024, 1024, WUP + (size_t)((t >> 6) * 256) * 1024, 1024, 1024, acc, wv);
    }
    while (t_ < tend) {
      const int t = t_ & 1023;
      const int pm = t & 63, pn = t >> 6, brow = pm * 256, bcol = pn * 256;
      ACC_ZERO(acc);
      kloop_t<2>(H2B + (size_t)brow * 1024, 1024, WUP + (size_t)bcol * 1024, 1024, 1024, acc, wv);
      t_ += gridDim.x;
      if (t_ < tend) {
        const int tn = t_ & 1023;
        fill_rs(tn, (it + 1) & 1);
        kloop_t<1, false>(H2B + (size_t)((tn & 63) * 256) * 1024, 1024, WUP + (size_t)((tn >> 6) * 256) * 1024, 1024, 1024, acc, wv);
      }
      const float* rs_c = rs_l + (it & 1) * 256;
      ACC_FOREACH_PAIR({
        const float rstd = rs_c[rrow];
        f32x4 o0 = v0 * rstd, o1 = v1 * rstd;
        o0[0] = fmaxf(o0[0], 0.f); o0[1] = fmaxf(o0[1], 0.f); o0[2] = fmaxf(o0[2], 0.f); o0[3] = fmaxf(o0[3], 0.f);
        o1[0] = fmaxf(o1[0], 0.f); o1[1] = fmaxf(o1[1], 0.f); o1[2] = fmaxf(o1[2], 0.f); o1[3] = fmaxf(o1[3], 0.f);
        o0 = o0 * o0; o1 = o1 * o1;
        store_pair16(ACT + (size_t)(brow + rrow) * 4096 + bcol + cb32, pack4(o0), pack4(o1), fq);
      });
      ++it;
    }
  }
  for (int gb = blockIdx.x; gb < 256; gb += gridDim.x) {
    const int task0 = gb * 8, mt = task0 >> 8, nt0 = task0 & 255;
    const u16* Ab = H2B + (size_t)(TP + mt * 16) * 1024;
    skgemm<8>([&](int) { return Ab; }, [&](int i) { return WUP + (size_t)((nt0 + i) * 16) * 1024; }, [&](int) { return 1024; }, 128, wv);
    {
      const int lane_e = lane_fresh(), fr = lane_e & 15, fq = lane_e >> 4;
      const int ntl = nt0 + wv, row = TP + mt * 16 + fr, col = ntl * 16 + fq * 4;
      const float* ps = PSS + (size_t)(row - TP) * 64 + fq * 16;
      f32x4 a4 = *(const f32x4*)ps + *(const f32x4*)(ps + 4) + *(const f32x4*)(ps + 8) + *(const f32x4*)(ps + 12);
      float sq = a4[0] + a4[1] + a4[2] + a4[3];
      sq += shfl_xor_f(sq, 16); sq += shfl_xor_f(sq, 32);
      const float rstd = rsqrtf(sq * (1.f / 1024.f) + EPS);
      f32x4 v = skreduce(wv) * rstd;
#pragma unroll
      for (int e = 0; e < 4; ++e) { float r = fmaxf(v[e], 0.f); v[e] = r * r; }
      *(u32x2*)(ACT + (size_t)row * 4096 + col) = pack4(v);
    }
  }
}

__device__ __forceinline__ void phaseG(const Params& p, const int wv, const int rep, unsigned* bar, const bool fused) {
  const int wid = wv, wr = wid >> 2, wc = wid & 3;
  char* ws = p.ws;
  const u16* ACT = (const u16*)(ws + OFF_ACT);
  const u16* WDN = (const u16*)(ws + OFF_WDN);
  const u16* H2 = (const u16*)(ws + OFF_H2B);
  unsigned* CNT = bar + 4096;
  unsigned* CNTS = bar + 4096 + 1024;
  float* XS = (float*)(ws + OFF_PS);
  float* XSS = (float*)(ws + OFF_PSS);
  const float* wfin = p.in[29];
  for (int t_ = blockIdx.x; t_ < 256 * rep; t_ += gridDim.x) {
    const int t = t_ & 255;
    const int pm = t & 63, pn = t >> 6, brow = pm * 256, bcol = pn * 256;
    Acc acc; ACC_ZERO(acc);
    kloop(ACT + (size_t)brow * 4096, 4096, WDN + (size_t)bcol * 4096, 4096, 4096, acc, wv);
    if (!fused) {
      ACC_FOREACH({
        const size_t o = (size_t)(brow + rrow) * 1024 + bcol + rcol;
        *(f32x4*)(p.out + O_Y + o) = v + unpack4(*(const u32x2*)(H2 + o));
      });
    } else {
      float* red = (float*)g_shm;
      float* rstd_l = red + 1024;
      {
        const int lane_e = lane_fresh(), fr = lane_e & 15, fq = lane_e >> 4;
#pragma unroll
        for (int ai = 0; ai < 2; ++ai)
#pragma unroll
          for (int m = 0; m < 4; ++m) {
            const int rrow = ai * 128 + wr * 64 + m * 16 + fr;
            float ss = 0.f;
#pragma unroll
            for (int bj = 0; bj < 2; ++bj)
#pragma unroll
              for (int n = 0; n < 2; ++n) {
                const int rcol = bj * 128 + wc * 32 + n * 16 + fq * 4;
                f32x4 v = acc[ai][bj][m][n] + unpack4(*(const u32x2*)(H2 + (size_t)(brow + rrow) * 1024 + bcol + rcol));
                acc[ai][bj][m][n] = v;
                ss += v[0] * v[0] + v[1] * v[1] + v[2] * v[2] + v[3] * v[3];
              }
            ss += shfl_xor_f(ss, 16); ss += shfl_xor_f(ss, 32);
            if (fq == 0) red[rrow * 4 + wc] = ss;
          }
      }
      __syncthreads();
      {
        const int tid = wv * 64 + lane_fresh();
        if (tid < 256) {
          f32x4 r4 = *(const f32x4*)(red + tid * 4);
          __hip_atomic_store(XS + (size_t)(brow + tid) * 4 + pn, r4[0] + r4[1] + r4[2] + r4[3], __ATOMIC_RELAXED, __HIP_MEMORY_SCOPE_AGENT);
        }
        asm volatile("s_waitcnt vmcnt(0)" ::: "memory");
        __syncthreads();
        if (tid == 0) {
          (void)xb_add(&CNT[pm * 16], 1u);
          XB_SPIN(xb_ld(&CNT[pm * 16]) < 4u, bar);
        }
        __syncthreads();
        if (tid < 256) {
          float sq = 0.f;
#pragma unroll
          for (int q = 0; q < 4; ++q) sq += __hip_atomic_load(XS + (size_t)(brow + tid) * 4 + q, __ATOMIC_RELAXED, __HIP_MEMORY_SCOPE_AGENT);
          rstd_l[tid] = rsqrtf(sq * (1.f / 1024.f) + EPS);
        }
        __syncthreads();
      }
      ACC_FOREACH({
        const float rs = rstd_l[rrow];
        const f32x4 wv4 = *(const f32x4*)(wfin + bcol + rcol);
        *(f32x4*)(p.out + O_Y + (size_t)(brow + rrow) * 1024 + bcol + rcol) = v * rs * wv4;
      });
    }
  }
  for (int gb = blockIdx.x; gb < 256; gb += gridDim.x) {
    const int task0 = gb * 2, mt = task0 >> 6, nt0 = task0 & 63;
    const u16* Ab = ACT + (size_t)(TP + mt * 16) * 4096;
    skgemm<2>([&](int) { return Ab; }, [&](int i) { return WDN + (size_t)((nt0 + i) * 16) * 4096; }, [&](int) { return 4096; }, 512, wv);
    if (!fused) {
      if (wv < 2) {
        const int lane_e = lane_fresh(), fr = lane_e & 15, fq = lane_e >> 4;
        const int row = TP + mt * 16 + fr, col = (nt0 + wv) * 16 + fq * 4;
        const size_t o = (size_t)row * 1024 + col;
        *(f32x4*)(p.out + O_Y + o) = skreduce(wv) + unpack4(*(const u32x2*)(H2 + o));
      }
    } else {
      unsigned* last_l = (unsigned*)g_shm + 8192;
      if (wv < 2) {
        const int lane_e = lane_fresh(), fr = lane_e & 15, fq = lane_e >> 4;
        const int row = TP + mt * 16 + fr, col = (nt0 + wv) * 16 + fq * 4;
        const size_t o = (size_t)row * 1024 + col;
        f32x4 v = skreduce(wv) + unpack4(*(const u32x2*)(H2 + o));
        float* yo = p.out + O_Y + o;
#pragma unroll
        for (int e = 0; e < 4; ++e) __hip_atomic_store(yo + e, v[e], __ATOMIC_RELAXED, __HIP_MEMORY_SCOPE_AGENT);
        float ss = v[0] * v[0] + v[1] * v[1] + v[2] * v[2] + v[3] * v[3];
        ss += shfl_xor_f(ss, 16); ss += shfl_xor_f(ss, 32);
        if (fq == 0) __hip_atomic_store(XSS + (size_t)(row - TP) * 64 + nt0 + wv, ss, __ATOMIC_RELAXED, __HIP_MEMORY_SCOPE_AGENT);
      }
      asm volatile("s_waitcnt vmcnt(0)" ::: "memory");
      __syncthreads();
      const int tid = wv * 64 + lane_fresh();
      if (tid == 0) last_l[0] = (xb_add(&CNTS[mt * 16], 1u) == 31u) ? 1u : 0u;
      __syncthreads();
      if (last_l[0]) {
        __builtin_amdgcn_fence(__ATOMIC_ACQUIRE, "agent");
        const int r = tid >> 5, c32 = tid & 31;
        float* yrow = p.out + O_Y + (size_t)(TP + mt * 16 + r) * 1024;
        float sq = __hip_atomic_load(XSS + (size_t)(mt * 16 + r) * 64 + c32 * 2, __ATOMIC_RELAXED, __HIP_MEMORY_SCOPE_AGENT)
                 + __hip_atomic_load(XSS + (size_t)(mt * 16 + r) * 64 + c32 * 2 + 1, __ATOMIC_RELAXED, __HIP_MEMORY_SCOPE_AGENT);
        sq += shfl_xor_f(sq, 16); sq += shfl_xor_f(sq, 8); sq += shfl_xor_f(sq, 4); sq += shfl_xor_f(sq, 2); sq += shfl_xor_f(sq, 1);
        const float rs = rsqrtf(sq * (1.f / 1024.f) + EPS);
#pragma unroll
        for (int i = 0; i < 8; ++i) {
          const int col = i * 128 + c32 * 4;
          f32x4 v = *(const f32x4*)(yrow + col);
          *(f32x4*)(yrow + col) = v * rs * *(const f32x4*)(wfin + col);
        }
      }
    }
  }
}

__device__ __forceinline__ void phaseH(const Params& p, const int wv, const int rep) {
  const int wid = wv, lane = lane_fresh();
  const int gw = blockIdx.x * 8 + wid, nw = gridDim.x * 8;
  const float* w = p.in[29];
  for (int r_ = gw; r_ < T * rep; r_ += nw) {
    const int r = r_ >= T ? r_ - T : r_;
    float* x = p.out + O_Y + (size_t)r * 1024;
    f32x4 v[4]; float ss = 0.f;
#pragma unroll
    for (int i = 0; i < 4; ++i) { v[i] = *(const f32x4*)(x + (i * 64 + lane) * 4); ss += v[i][0] * v[i][0] + v[i][1] * v[i][1] + v[i][2] * v[i][2] + v[i][3] * v[i][3]; }
    ss = wave_sum(ss);
    const float rstd = rsqrtf(ss * (1.f / 1024.f) + EPS);
#pragma unroll
    for (int i = 0; i < 4; ++i) { f32x4 wv = *(const f32x4*)(w + (i * 64 + lane) * 4); *(f32x4*)(x + (i * 64 + lane) * 4) = v[i] * rstd * wv; }
  }
}

__global__ void __launch_bounds__(NTHREADS) fwd_megakernel(Params p) {
  cg::grid_group grid = cg::this_grid();
  const int wv = __builtin_amdgcn_readfirstlane(threadIdx.x >> 6);
#ifndef REP
#define REP 0
#endif
#define RB(bit) ({ int n_ = (REP & (1 << bit)) ? 2 : 1; asm volatile("" : "+s"(n_)); n_; })
  unsigned* bar = (unsigned*)(p.ws + OFF_BAR);
  if (wv == 0) { if (lane_fresh() == 0) { xb_words = make_uint4(0u, 0u, 0u, 0u); (void)xb_add(&bar[XB_XCNT(xb_xcc_id())], 1u); } }
  __syncthreads();
  phaseA(p, wv, RB(0));
  if (p.ws == nullptr) grid.sync();
  xcd_barrier(bar, wv);
  phaseB(p, wv, RB(1));
  xcd_barrier(bar, wv);
  phaseC(p, wv, RB(8), RB(9), RB(10), RB(11), RB(12), bar);
  xcd_barrier(bar, wv);
  phaseD(p, wv, RB(2));
  xcd_barrier(bar, wv);
  phaseE(p, wv, RB(3));
  xcd_barrier(bar, wv);
  phaseF(p, wv, RB(4));
  xcd_barrier(bar, wv);
  const bool fused = (gridDim.x == 256) && !(REP & 32);
  phaseG(p, wv, RB(5), bar, fused);
  if (!fused) {
    xcd_barrier(bar, wv);
    phaseH(p, wv, 1);
  }
  { int ns = (REP & 8192) ? 8 : 0; asm volatile("" : "+s"(ns)); for (int i = 0; i < ns; ++i) xcd_barrier(bar, wv); }
}

extern "C" void kernel_launch(void* const* d_in, const int* in_sizes, int n_in, void* d_out, int out_size, void* d_ws, size_t ws_size, hipStream_t stream) {
  static int grid_blocks = 0;
  if (!grid_blocks) {
    int dev = 0, cus = 0, per_cu = 0;
    (void)hipGetDevice(&dev);
    (void)hipDeviceGetAttribute(&cus, hipDeviceAttributeMultiprocessorCount, dev);
    (void)hipFuncSetAttribute((const void*)fwd_megakernel, hipFuncAttributeMaxDynamicSharedMemorySize, DYN_LDS);
    (void)hipOccupancyMaxActiveBlocksPerMultiprocessor(&per_cu, fwd_megakernel, NTHREADS, DYN_LDS);
    if (per_cu > 1) per_cu = 1;
    grid_blocks = cus * per_cu;
    if (grid_blocks > 256) grid_blocks = 256;
  }
  if (ws_size < WS_TOTAL || n_in < 30 || grid_blocks <= 0) { fprintf(stderr, "kernel_launch: bad config ws=%zu need=%zu grid=%d\n", ws_size, (size_t)WS_TOTAL, grid_blocks); return; }
  Params p{};
  for (int i = 0; i < 30; ++i) p.in[i] = (const float*)d_in[i];
  p.out = (float*)d_out;
  p.ws = (char*)d_ws;
  (void)hipMemsetAsync((char*)d_ws + OFF_BAR, 0, BAR_BYTES, stream);
  void* args[] = {&p};
  hipError_t e = hipLaunchCooperativeKernel((void*)fwd_megakernel, dim3(grid_blocks), dim3(NTHREADS), args, DYN_LDS, stream);
  if (e != hipSuccess) fprintf(stderr, "cooperative launch failed: %s (grid %d)\n", hipGetErrorString(e), grid_blocks);
}
```

```cpp
#include <hip/hip_runtime.h>
#include <hip/hip_cooperative_groups.h>
#include <cstdio>
namespace cg = cooperative_groups;

typedef unsigned short u16;
typedef short bf16x8 __attribute__((ext_vector_type(8)));
typedef float f32x4 __attribute__((ext_vector_type(4)));
typedef float f32x2 __attribute__((ext_vector_type(2)));
typedef unsigned u32x2 __attribute__((ext_vector_type(2)));
typedef unsigned u32x4 __attribute__((ext_vector_type(4)));

constexpr int TP = 16384, TS = 128, T = TP + TS;
constexpr float EPS = 1e-6f;
constexpr int NTHREADS = 512;
constexpr int DYN_LDS = 159744;

constexpr size_t OFF_WIN = 0;
constexpr size_t OFF_WKV = OFF_WIN + 14680064;
constexpr size_t OFF_WGM = OFF_WKV + 2097152;
constexpr size_t OFF_WSSD = OFF_WGM + 1048576;
constexpr size_t OFF_WXA = OFF_WSSD + 2097152;
constexpr size_t OFF_WOUT = OFF_WXA + 1048576;
constexpr size_t OFF_WUP = OFF_WOUT + 2097152;
constexpr size_t OFF_WDN = OFF_WUP + 8388608;
constexpr size_t OFF_WSB = OFF_WDN + 8388608;
constexpr size_t OFF_MN = OFF_WSB + 131072;
constexpr size_t OFF_KP = OFF_MN + 4194304;
constexpr size_t OFF_VT = OFF_KP + 2097152;
constexpr size_t OFF_DT = OFF_VT + 2097152;
constexpr size_t OFF_YPS = OFF_DT + 1056768;
constexpr size_t OFF_PS = OFF_YPS + 2113536;
constexpr size_t OFF_PSS = OFF_PS + 1048576;
constexpr size_t OFF_R1 = OFF_PSS + 32768;
constexpr size_t SZ_1024B = (size_t)T * 1024 * 2;
constexpr size_t OFF_UV = OFF_R1;
constexpr size_t OFF_ZS = OFF_R1 + SZ_1024B;
constexpr size_t OFF_XBC = OFF_R1 + 2 * SZ_1024B;
constexpr size_t OFF_MERGED = OFF_R1;
constexpr size_t OFF_ACT = OFF_R1;
constexpr size_t OFF_R2 = OFF_R1 + (size_t)T * 4096 * 2;
constexpr size_t OFF_GATE = OFF_R2;
constexpr size_t OFF_H2 = OFF_R2;
constexpr size_t OFF_H2B = OFF_R2 + (size_t)T * 1024 * 4;
constexpr size_t OFF_XA = OFF_R2 + (size_t)T * 3072 * 2;
constexpr size_t OFF_WDT = OFF_XA + (size_t)T * 512 * 2;
constexpr size_t OFF_BAR = OFF_WDT + 32768;
constexpr size_t BAR_BYTES = 32768;
constexpr size_t WS_TOTAL = OFF_BAR + BAR_BYTES;
constexpr size_t OOFF_XN = 0;
constexpr size_t OOFF_Q = SZ_1024B;
constexpr size_t OOFF_GM = SZ_1024B + (size_t)T * 512 * 2;
constexpr size_t O_Y = 0, O_MEMK = 16908288, O_MEMV = 17956864, O_CONVP = 19005440, O_SSMP = 19042304,
                 O_CONVS = 20090880, O_SSMS = 20680704, O_GMV = 37457920;

struct Params { const float* in[30]; float* out; char* ws; };

extern __shared__ __attribute__((aligned(16))) char g_shm[];

typedef __bf16 bf16x2_t __attribute__((ext_vector_type(2)));
__device__ __forceinline__ unsigned cvt_pk(float lo, float hi) { f32x2 v = {lo, hi}; bf16x2_t b = __builtin_convertvector(v, bf16x2_t); return __builtin_bit_cast(unsigned, b); }
__device__ __forceinline__ u32x2 pack4(f32x4 v) { u32x2 r; r.x = cvt_pk(v[0], v[1]); r.y = cvt_pk(v[2], v[3]); return r; }
__device__ __forceinline__ u16 f2bf(float f) { return (u16)(cvt_pk(f, 0.f) & 0xffffu); }
__device__ __forceinline__ float bf2f(u16 h) { return __uint_as_float(((unsigned)h) << 16); }
__device__ __forceinline__ float bflo(unsigned w) { return __uint_as_float(w << 16); }
__device__ __forceinline__ float bfhi(unsigned w) { return __uint_as_float(w & 0xffff0000u); }
__device__ __forceinline__ f32x4 unpack4(u32x2 w) { return (f32x4){bflo(w.x), bfhi(w.x), bflo(w.y), bfhi(w.y)}; }
__device__ __forceinline__ float silu_f(float x) { return x * __builtin_amdgcn_rcpf(1.f + __builtin_amdgcn_exp2f(-1.4426950409f * x)); }
__device__ __forceinline__ float sigm_f(float x) { return __builtin_amdgcn_rcpf(1.f + __builtin_amdgcn_exp2f(-1.4426950409f * x)); }
__device__ __forceinline__ float gelu_f(float v) {
  const float av = fabsf(v), t = __builtin_amdgcn_rcpf(av * 0.2316418882f + 1.0f);
  float q = t * 0.5307027145f + (-0.7265760135f); q = q * t + 0.7107068705f; q = q * t + (-0.142248368f); q = q * t + 0.127414796f; q = q * t;
  const float e = __builtin_amdgcn_exp2f((v * v) * (-0.72134752044f));
  const float m = v * (q * e), r = v - m;
  return v < 0.f ? m : r;
}
__device__ __forceinline__ float softplus_f(float x) { return fmaxf(x, 0.f) + log1pf(__expf(-fabsf(x))); }
__device__ __forceinline__ int lane_fresh() { int l; asm volatile("v_mbcnt_lo_u32_b32 %0, -1, 0\n\tv_mbcnt_hi_u32_b32 %0, -1, %0" : "=v"(l)); return l; }
__device__ __forceinline__ float shfl_xor_f(float v, int mask) { const int l = lane_fresh(); return __int_as_float(__builtin_amdgcn_ds_bpermute((l ^ mask) << 2, __float_as_int(v))); }
__device__ __forceinline__ float shfl_idx_f(float v, int src) { return __int_as_float(__builtin_amdgcn_ds_bpermute(src << 2, __float_as_int(v))); }
__device__ __forceinline__ float wave_sum(float v) {
#pragma unroll
  for (int o = 32; o >= 1; o >>= 1) v += shfl_xor_f(v, o);
  return v;
}
__device__ __forceinline__ float wave_max(float v) {
#pragma unroll
  for (int o = 32; o >= 1; o >>= 1) v = fmaxf(v, shfl_xor_f(v, o));
  return v;
}
#define MFMA16(a, b, c) __builtin_amdgcn_mfma_f32_16x16x32_bf16((a), (b), (c), 0, 0, 0)


#define XB_TMO      128
#define XB_XCNT(j)  (256  + 64 * (j))
#define XB_XSUB(j)  (1280 + 64 * (j))
#define XB_XGEN(j)  (2304 + 64 * (j))
#define XB_TOP      3328
#define XB_TOPGEN   3392
#define XB_SPIN_CAP (1u << 20)
#define LAS __attribute__((address_space(3)))
__device__ __forceinline__ unsigned xb_ld(unsigned* p) { return __hip_atomic_load(p, __ATOMIC_RELAXED, __HIP_MEMORY_SCOPE_AGENT); }
__device__ __forceinline__ unsigned xb_add(unsigned* p, unsigned v) { return __hip_atomic_fetch_add(p, v, __ATOMIC_RELAXED, __HIP_MEMORY_SCOPE_AGENT); }
__device__ __forceinline__ unsigned xb_xcc_id() { return (unsigned)__builtin_amdgcn_s_getreg((3 << 11) | 20) & 0xFu; }
#define XB_SPIN(cond, bar) do { unsigned _sp = 0; while (cond) { __builtin_amdgcn_s_sleep(1); \
    if ((++_sp & 255u) == 0u) { if (xb_ld(&(bar)[XB_TMO])) break; if (_sp > XB_SPIN_CAP) { atomicAdd(&(bar)[XB_TMO], 1u); break; } } } } while (0)
__shared__ uint4 xb_words;
__device__ __forceinline__ void xcd_barrier_complete(unsigned* bar, unsigned x, unsigned& nloc, unsigned& nx) {
  const unsigned G = gridDim.x;
  unsigned sum, cnt, mine, sp = 0u;
  for (;;) {
    sum = 0u; cnt = 0u; mine = 0u;
#pragma unroll
    for (unsigned j = 0; j < 16; ++j) { const unsigned c = xb_ld(&bar[XB_XCNT(j)]); sum += c; cnt += (c > 0u) ? 1u : 0u; mine = (j == x) ? c : mine; }
    if (sum == G) break;
    __builtin_amdgcn_s_sleep(1);
    if ((++sp & 255u) == 0u) { if (xb_ld(&bar[XB_TMO])) break; if (sp > XB_SPIN_CAP) { atomicAdd(&bar[XB_TMO], 1u); break; } }
  }
  nloc = mine > 0u ? mine : 1u; nx = cnt > 0u ? cnt : 1u;
}
__device__ __forceinline__ void xcd_barrier(unsigned* bar, const int wv) {
  asm volatile("s_waitcnt vmcnt(0)" ::: "memory");
  __syncthreads();
  if (wv == 0) {
    if (lane_fresh() == 0) {
      volatile LAS unsigned* st = (volatile LAS unsigned*)&xb_words;
      const unsigned x = xb_xcc_id();
      __builtin_amdgcn_s_waitcnt(0);
      unsigned nloc = st[0], nx = st[1];
      if (nloc == 0u) { xcd_barrier_complete(bar, x, nloc, nx); st[0] = nloc; st[1] = nx; }
      const unsigned old = xb_add(&bar[XB_XSUB(x)], 1u);
      const unsigned gen = old / nloc;
      if (old + 1u == (gen + 1u) * nloc) {
        __builtin_amdgcn_fence(__ATOMIC_RELEASE, "agent");
        asm volatile("s_waitcnt vmcnt(0)" ::: "memory");
        const unsigned og = xb_add(&bar[XB_TOP], 1u);
        const unsigned tg = og / nx;
        if (og + 1u == (tg + 1u) * nx) xb_add(&bar[XB_TOPGEN], 1u);
        else XB_SPIN(xb_ld(&bar[XB_TOPGEN]) == tg, bar);
        __builtin_amdgcn_fence(__ATOMIC_ACQUIRE, "agent");
        xb_add(&bar[XB_XGEN(x)], 1u);
        asm volatile("s_waitcnt vmcnt(0)" ::: "memory");
      } else {
        XB_SPIN(xb_ld(&bar[XB_XGEN(x)]) == gen, bar);
        __builtin_amdgcn_fence(__ATOMIC_ACQUIRE, "agent");
        asm volatile("s_waitcnt vmcnt(0)" ::: "memory");
      }
    }
  }
  __syncthreads();
}

constexpr int BM = 256, BK = 64, HALF = 128, HT = HALF * BK;
__device__ __forceinline__ int lds_byte(int r, int c) { int st = (r >> 4) * 2 + (c >> 5), rr = r & 15, cc = c & 31, ob = rr * 64 + cc * 2; return st * 1024 + (ob ^ (((ob >> 9) & 1) << 5)); }
__device__ __forceinline__ void stage_rc(int b, int& R, int& C) { int st = b / 1024, sb = b % 1024, swz = sb ^ (((sb >> 9) & 1) << 5); R = (st >> 1) * 16 + swz / 64; C = (st & 1) * 32 + (swz % 64) / 2; }

typedef f32x4 Acc[2][2][4][2];

template <int PART  , bool SYNC_FIRST = true>
__device__ __forceinline__ void kloop_t(const u16* __restrict__ A, int lda, const u16* __restrict__ Bt, int ldb, int K, Acc& acc, const int wv) {
  u16* shm = (u16*)g_shm;
#define SA(b, h) (shm + ((b) * 2 + (h)) * HT)
#define SB(b, h) (shm + (4 + (b) * 2 + (h)) * HT)
#define STAGE(P_, BASE, LD, br, kt) do { const u16* _gb = (BASE) + ((br) * (LD) + (kt) * BK); \
    unsigned _o0 = ((&(BASE) == &A) ? oA0 : oB0), _o1 = ((&(BASE) == &A) ? oA1 : oB1); asm volatile("" : "+v"(_o0), "+v"(_o1)); \
    __builtin_amdgcn_global_load_lds((const unsigned*)((const char*)_gb + _o0), (unsigned*)((char*)(P_) + ktid * 16), 16, 0, 0); \
    __builtin_amdgcn_global_load_lds((const unsigned*)((const char*)_gb + _o1), (unsigned*)((char*)(P_) + ktid * 16 + 8192), 16, 0, 0); } while (0)
#define LDA(dst, b, h) for (int m = 0; m < 4; ++m) for (int k = 0; k < 2; ++k) \
    dst[m][k] = *reinterpret_cast<const bf16x8*>((char*)SA(b, h) + lds_byte(wr * 64 + m * 16 + fr, k * 32 + fq * 8))
#define LDB(dst, b, h) for (int n = 0; n < 2; ++n) for (int k = 0; k < 2; ++k) \
    dst[n][k] = *reinterpret_cast<const bf16x8*>((char*)SB(b, h) + lds_byte(wc * 32 + n * 16 + fr, k * 32 + fq * 8))
#define MMA(ai, bj, At_, Bt_) do { __builtin_amdgcn_s_setprio(1); \
    for (int m = 0; m < 4; ++m) for (int n = 0; n < 2; ++n) for (int k = 0; k < 2; ++k) \
      acc[ai][bj][m][n] = MFMA16(Bt_[n][k], At_[m][k], acc[ai][bj][m][n]); \
    __builtin_amdgcn_s_setprio(0); } while (0)
#define WAIT_V(n) asm volatile("s_waitcnt vmcnt(" #n ")" ::: "memory")
#define WAIT_L(n) asm volatile("s_waitcnt lgkmcnt(" #n ")" ::: "memory")
#define BAR __builtin_amdgcn_s_barrier()
#define SCHED __builtin_amdgcn_sched_barrier(0)
  const int wid = wv, lane = lane_fresh(), ktid = wv * 64 + lane, wr = wid >> 2, wc = wid & 3, fr = lane & 15, fq = lane >> 4;
  bf16x8 At[4][2], B0[2][2], B1[2][2];
  const int nt = K / BK;
  unsigned oA0, oA1, oB0, oB1;
  { int r_, c_; stage_rc(ktid * 16, r_, c_); oA0 = (unsigned)(r_ * lda + c_) * 2u; oB0 = (unsigned)(r_ * ldb + c_) * 2u;
    stage_rc(ktid * 16 + 8192, r_, c_); oA1 = (unsigned)(r_ * lda + c_) * 2u; oB1 = (unsigned)(r_ * ldb + c_) * 2u; }
  if (PART != 2) {
    if (SYNC_FIRST) { WAIT_V(0); WAIT_L(0); __syncthreads(); }
    STAGE(SB(0, 0), Bt, ldb, 0, 0); STAGE(SA(0, 0), A, lda, 0, 0);
    STAGE(SB(0, 1), Bt, ldb, HALF, 0); STAGE(SA(0, 1), A, lda, HALF, 0);
  }
  if (PART == 1) return;
  if (wr == 1) BAR;
  WAIT_V(4); BAR;
  STAGE(SB(1, 0), Bt, ldb, 0, 1); STAGE(SA(1, 0), A, lda, 0, 1); STAGE(SB(1, 1), Bt, ldb, HALF, 1);
  WAIT_V(6); BAR;
#pragma unroll 1
  for (int t = 0; t < nt - 2; t += 2) {
    LDB(B0, 0, 0); SCHED; LDA(At, 0, 0); STAGE(SA(1, 1), A, lda, HALF, t + 1);
    WAIT_L(8); BAR; WAIT_L(0); MMA(0, 0, At, B0); BAR; SCHED;
    LDB(B1, 0, 1); STAGE(SB(0, 0), Bt, ldb, 0, t + 2);
    BAR; WAIT_L(0); MMA(0, 1, At, B1); BAR;
    LDA(At, 0, 1); STAGE(SA(0, 0), A, lda, 0, t + 2);
    BAR; WAIT_L(0); MMA(1, 0, At, B0); BAR; SCHED;
    STAGE(SB(0, 1), Bt, ldb, HALF, t + 2);
    WAIT_V(6); BAR; MMA(1, 1, At, B1); BAR;
    LDB(B0, 1, 0); SCHED; LDA(At, 1, 0); STAGE(SA(0, 1), A, lda, HALF, t + 2);
    WAIT_L(8); BAR; WAIT_L(0); MMA(0, 0, At, B0); BAR; SCHED;
    LDB(B1, 1, 1); STAGE(SB(1, 0), Bt, ldb, 0, t + 3);
    BAR; WAIT_L(0); MMA(0, 1, At, B1); BAR;
    LDA(At, 1, 1); STAGE(SA(1, 0), A, lda, 0, t + 3);
    BAR; WAIT_L(0); MMA(1, 0, At, B0); BAR; SCHED;
    STAGE(SB(1, 1), Bt, ldb, HALF, t + 3);
    WAIT_V(6); BAR; MMA(1, 1, At, B1); BAR;
  }
  { LDB(B0, 0, 0); LDA(At, 0, 0); STAGE(SA(1, 1), A, lda, HALF, nt - 1);
    BAR; WAIT_L(0); MMA(0, 0, At, B0); BAR;
    LDB(B1, 0, 1); BAR; WAIT_L(0); MMA(0, 1, At, B1); BAR;
    LDA(At, 0, 1); WAIT_V(4); BAR; WAIT_L(0); MMA(1, 0, At, B0); MMA(1, 1, At, B1); BAR; }
  { LDB(B0, 1, 0); LDA(At, 1, 0); WAIT_V(2); BAR; WAIT_L(0); MMA(0, 0, At, B0); BAR;
    LDB(B1, 1, 1); WAIT_V(0); BAR; WAIT_L(0); MMA(0, 1, At, B1); BAR;
    LDA(At, 1, 1); BAR; WAIT_L(0); MMA(1, 0, At, B0); MMA(1, 1, At, B1); BAR; }
  if (wr == 0) BAR;
  SCHED;
}

__device__ __forceinline__ void kloop(const u16* __restrict__ A, int lda, const u16* __restrict__ Bt, int ldb, int K, Acc& acc, const int wv) { kloop_t<0>(A, lda, Bt, ldb, K, acc, wv); }

#define ACC_ZERO(acc) do { _Pragma("unroll") for (int ai = 0; ai < 2; ++ai) _Pragma("unroll") for (int bj = 0; bj < 2; ++bj) \
  _Pragma("unroll") for (int m = 0; m < 4; ++m) _Pragma("unroll") for (int n = 0; n < 2; ++n) acc[ai][bj][m][n] = (f32x4){0.f, 0.f, 0.f, 0.f}; } while (0)
#define ACC_FOREACH(...) do { const int lane_e = lane_fresh(), fr = lane_e & 15, fq = lane_e >> 4; (void)fr; (void)fq; _Pragma("unroll") for (int ai = 0; ai < 2; ++ai) _Pragma("unroll") for (int m = 0; m < 4; ++m) { \
  const int rrow = ai * 128 + wr * 64 + m * 16 + fr; (void)rrow; \
  _Pragma("unroll") for (int bj = 0; bj < 2; ++bj) _Pragma("unroll") for (int n = 0; n < 2; ++n) { \
    const int rcol = bj * 128 + wc * 32 + n * 16 + fq * 4; (void)rcol; f32x4& v = acc[ai][bj][m][n]; __VA_ARGS__ } } } while (0)
#define ACC_FOREACH_SB(...) do { __builtin_amdgcn_sched_barrier(0); const int lane_e = lane_fresh(), fr = lane_e & 15, fq = lane_e >> 4; (void)fr; (void)fq; _Pragma("unroll") for (int ai = 0; ai < 2; ++ai) _Pragma("unroll") for (int m = 0; m < 4; ++m) { \
  const int rrow = ai * 128 + wr * 64 + m * 16 + fr; (void)rrow; \
  _Pragma("unroll") for (int bj = 0; bj < 2; ++bj) _Pragma("unroll") for (int n = 0; n < 2; ++n) { \
    const int rcol = bj * 128 + wc * 32 + n * 16 + fq * 4; (void)rcol; f32x4& v = acc[ai][bj][m][n]; __VA_ARGS__ } __builtin_amdgcn_sched_barrier(0); } } while (0)

__device__ __forceinline__ void store_pair16(u16* rowp32, u32x2 a, u32x2 b, int fq) {
  auto rx = __builtin_amdgcn_permlane16_swap(a.x, b.x, false, false);
  auto ry = __builtin_amdgcn_permlane16_swap(a.y, b.y, false, false);
  u32x4 w = {rx[0], ry[0], rx[1], ry[1]};
  *(u32x4*)(rowp32 + ((fq & 1) * 16 + (fq >> 1) * 8)) = w;
}
#define ACC_FOREACH_PAIR(...) do { const int lane_e = lane_fresh(), fr = lane_e & 15, fq = lane_e >> 4; (void)fr; (void)fq; \
  _Pragma("unroll") for (int ai = 0; ai < 2; ++ai) _Pragma("unroll") for (int m = 0; m < 4; ++m) { \
  const int rrow = ai * 128 + wr * 64 + m * 16 + fr; (void)rrow; \
  _Pragma("unroll") for (int bj = 0; bj < 2; ++bj) { const int cb32 = bj * 128 + wc * 32; (void)cb32; \
    f32x4& v0 = acc[ai][bj][m][0]; f32x4& v1 = acc[ai][bj][m][1]; __VA_ARGS__ } } } while (0)

__device__ __forceinline__ f32x4 wave_gemm16(const u16* __restrict__ A, int lda, const u16* __restrict__ Bt, int ldb, int K, f32x4 acc) {
  const int lane = lane_fresh(), fr = lane & 15, fq = lane >> 4;
  const u16* ap = A + (size_t)fr * lda + fq * 8;
  const u16* bp = Bt + (size_t)fr * ldb + fq * 8;
#pragma unroll 4
  for (int k = 0; k < K; k += 32) {
    bf16x8 a = *(const bf16x8*)(ap + k);
    bf16x8 b = *(const bf16x8*)(bp + k);
    acc = MFMA16(b, a, acc);
  }
  return acc;
}


template <int NT, class FA, class FB, class FL>
__device__ __forceinline__ void skgemm(FA aptr, FB bptr, FL ldf, const int KS, const int wv) {
  float* part = (float*)g_shm;
  const int lane = lane_fresh(), fr = lane & 15, fq = lane >> 4;
  __syncthreads();
#pragma unroll
  for (int i = 0; i < NT; ++i) {
    f32x4 acc = {0.f, 0.f, 0.f, 0.f};
    const int ld = ldf(i);
    const u16* ap = aptr(i) + (size_t)fr * ld + wv * KS + fq * 8;
    const u16* bp = bptr(i) + (size_t)fr * ld + wv * KS + fq * 8;
#pragma unroll 8
    for (int k = 0; k < KS; k += 32) acc = MFMA16(*(const bf16x8*)(bp + k), *(const bf16x8*)(ap + k), acc);
    *(f32x4*)(part + ((i * 8 + wv) * 64 + lane) * 4) = acc;
  }
  __syncthreads();
}
__device__ __forceinline__ f32x4 skreduce(int i) {
  const float* part = (const float*)g_shm;
  const int lane = lane_fresh();
  f32x4 s = {0.f, 0.f, 0.f, 0.f};
#pragma unroll
  for (int w = 0; w < 8; ++w) s += *(const f32x4*)(part + ((i * 8 + w) * 64 + lane) * 4);
  return s;
}

struct TJob { const float* src; const float* ks; u16* dst; int ldsrc, col0, k0, K, n0; };
__device__ __forceinline__ TJob tjob_decode(const Params& p, int i) {
  TJob j; char* ws = p.ws; j.ks = nullptr;
  if (i < 1792) { int kt = i & 15, ntl = i >> 4; j.src = p.in[8]; j.ldsrc = 7184; j.K = 1024; j.k0 = kt * 64; j.n0 = ntl * 64; j.col0 = j.n0 + (j.n0 >= 3584 ? 16 : 0); j.dst = (u16*)(ws + OFF_WIN); }
  else if ((i -= 1792) < 128) { int kt = i & 15, ntl = i >> 4; j.src = p.in[20]; j.ldsrc = 512; j.K = 1024; j.k0 = kt * 64; j.col0 = ntl * 64; j.n0 = (ntl >> 1) * 256 + (ntl & 1) * 64; j.dst = (u16*)(ws + OFF_WKV); }
  else if ((i -= 128) < 128) { int kt = i & 15, ntl = i >> 4; j.src = p.in[21]; j.ldsrc = 512; j.K = 1024; j.k0 = kt * 64; j.col0 = ntl * 64; j.n0 = (ntl >> 1) * 256 + 128 + (ntl & 1) * 64; j.dst = (u16*)(ws + OFF_WKV); }
  else if ((i -= 128) < 128) { int kt = i & 7, ntl = i >> 3; j.src = p.in[22]; j.ldsrc = 1024; j.K = 512; j.k0 = kt * 64; j.col0 = ntl * 64; j.n0 = j.col0; j.dst = (u16*)(ws + OFF_WGM); }
  else if ((i -= 128) < 256) { int kt = i & 15, ntl = i >> 4; j.src = p.in[23]; j.ldsrc = 1024; j.K = 1024; j.k0 = kt * 64; j.col0 = ntl * 64; j.n0 = j.col0; j.dst = (u16*)(ws + OFF_WSSD); j.ks = p.in[18]; }
  else if ((i -= 256) < 128) { int kt = i & 7, ntl = i >> 3; j.src = p.in[24]; j.ldsrc = 1024; j.K = 512; j.k0 = kt * 64; j.col0 = ntl * 64; j.n0 = j.col0; j.dst = (u16*)(ws + OFF_WXA); }
  else if ((i -= 128) < 256) { int kt = i & 15, ntl = i >> 4; j.src = p.in[25]; j.ldsrc = 1024; j.K = 1024; j.k0 = kt * 64; j.col0 = ntl * 64; j.n0 = j.col0; j.dst = (u16*)(ws + OFF_WOUT); }
  else if ((i -= 256) < 1024) { int kt = i & 15, ntl = i >> 4; j.src = p.in[27]; j.ldsrc = 4096; j.K = 1024; j.k0 = kt * 64; j.col0 = ntl * 64; j.n0 = j.col0; j.dst = (u16*)(ws + OFF_WUP); j.ks = p.in[26]; }
  else { i -= 1024; int kt = i & 63, ntl = i >> 6; j.src = p.in[28]; j.ldsrc = 1024; j.K = 4096; j.k0 = kt * 64; j.col0 = ntl * 64; j.n0 = j.col0; j.dst = (u16*)(ws + OFF_WDN); }
  return j;
}
__device__ __forceinline__ void ttile_load(const TJob& j, int tid, f32x4 (&v)[2]) {
#pragma unroll
  for (int i = 0; i < 2; ++i) {
    const int kk = (tid >> 4) + 32 * i, nn = (tid & 15) * 4;
    v[i] = *(const f32x4*)(j.src + (size_t)(j.k0 + kk) * j.ldsrc + j.col0 + nn);
    if (j.ks) v[i] = v[i] * j.ks[j.k0 + kk];
  }
}
__device__ __forceinline__ void ttile_store(const TJob& j, int tid, const f32x4 (&v)[2]) {
  float* tile = (float*)g_shm;
  __syncthreads();
#pragma unroll
  for (int i = 0; i < 2; ++i) {
    const int kk = (tid >> 4) + 32 * i, nn = (tid & 15) * 4;
    tile[kk * 65 + nn] = v[i][0]; tile[kk * 65 + nn + 1] = v[i][1]; tile[kk * 65 + nn + 2] = v[i][2]; tile[kk * 65 + nn + 3] = v[i][3];
  }
  __syncthreads();
  {
    const int nn = tid >> 3, k8 = (tid & 7) * 8;
    u32x4 w;
    w.x = cvt_pk(tile[(k8 + 0) * 65 + nn], tile[(k8 + 1) * 65 + nn]); w.y = cvt_pk(tile[(k8 + 2) * 65 + nn], tile[(k8 + 3) * 65 + nn]);
    w.z = cvt_pk(tile[(k8 + 4) * 65 + nn], tile[(k8 + 5) * 65 + nn]); w.w = cvt_pk(tile[(k8 + 6) * 65 + nn], tile[(k8 + 7) * 65 + nn]);
    *(u32x4*)(j.dst + (size_t)(j.n0 + nn) * j.K + j.k0 + k8) = w;
  }
}

__device__ __forceinline__ void phaseA(const Params& p, const int wv, const int rep) {
  const int lane = lane_fresh(), wid = wv, tid = wv * 64 + lane;
  char* ws = p.ws;
  {
    const int tend = 4864 * rep;
    int t_ = blockIdx.x;
    TJob job; f32x4 v[2];
    if (t_ < tend) { job = tjob_decode(p, t_ >= 4864 ? t_ - 4864 : t_); ttile_load(job, tid, v); }
    while (t_ < tend) {
      const int tn = t_ + gridDim.x;
      TJob jobn = job; f32x4 vn[2] = {v[0], v[1]};
      if (tn < tend) { jobn = tjob_decode(p, tn >= 4864 ? tn - 4864 : tn); ttile_load(jobn, tid, vn); }
      ttile_store(job, tid, v);
      job = jobn; v[0] = vn[0]; v[1] = vn[1]; t_ = tn;
    }
  }
  const int gw = blockIdx.x * 8 + wid, nw = gridDim.x * 8;
  u16* XN = (u16*)((char*)p.out + OOFF_XN);
  u16* MN = (u16*)(ws + OFF_MN);
  {
    const int rend = (T + 2048) * rep;
    auto rowsrc = [&](int r_) -> const float* {
      const int r = r_ >= T + 2048 ? r_ - (T + 2048) : r_;
      return r < TP ? p.in[0] + (size_t)r * 1024 : r < T ? p.in[1] + (size_t)(r - TP) * 1024 : p.in[2] + (size_t)(r - T) * 1024;
    };
    int r_ = gw;
    f32x4 v[4];
    if (r_ < rend) { const float* x = rowsrc(r_);
#pragma unroll
      for (int i = 0; i < 4; ++i) v[i] = *(const f32x4*)(x + (i * 64 + lane) * 4); }
    while (r_ < rend) {
      const int rn = r_ + nw;
      f32x4 vn[4] = {v[0], v[1], v[2], v[3]};
      if (rn < rend) { const float* x = rowsrc(rn);
#pragma unroll
        for (int i = 0; i < 4; ++i) vn[i] = *(const f32x4*)(x + (i * 64 + lane) * 4); }
      const int r = r_ >= T + 2048 ? r_ - (T + 2048) : r_;
      const float* w = r < T ? p.in[7] : p.in[19];
      u16* dst = r < T ? XN + (size_t)r * 1024 : MN + (size_t)(r - T) * 1024;
      float ss = 0.f;
#pragma unroll
      for (int i = 0; i < 4; ++i) ss += v[i][0] * v[i][0] + v[i][1] * v[i][1] + v[i][2] * v[i][2] + v[i][3] * v[i][3];
      ss = wave_sum(ss);
      const float rstd = rsqrtf(ss * (1.f / 1024.f) + EPS);
#pragma unroll
      for (int i = 0; i < 4; ++i) { f32x4 wv4 = *(const f32x4*)(w + (i * 64 + lane) * 4); *(u32x2*)(dst + (i * 64 + lane) * 4) = pack4(v[i] * rstd * wv4); }
#pragma unroll
      for (int i = 0; i < 4; ++i) v[i] = vn[i];
      r_ = rn;
    }
  }
  for (int i = blockIdx.x * NTHREADS + tid; i < 16384; i += gridDim.x * NTHREADS) {
    int k = i & 1023, hh = i >> 10;
    ((u16*)(ws + OFF_WDT))[i] = f2bf(p.in[8][(size_t)k * 7184 + 3584 + hh]);
  }
  u16* WSB = (u16*)(ws + OFF_WSB);
  for (int i = blockIdx.x * NTHREADS + tid; i < 65536; i += gridDim.x * NTHREADS) {
    int s = i & 127, tt = (i >> 7) & 127;
    WSB[i] = f2bf(s <= tt ? p.in[11][i] : 0.f);
  }
  for (int i = blockIdx.x * NTHREADS + tid; i < 128 * 3072; i += gridDim.x * NTHREADS) {
    int b = i / 3072, rem = i - b * 3072;
    p.out[O_CONVS + (size_t)b * 4608 + rem] = p.in[5][(size_t)b * 4608 + 1536 + rem];
  }
}

template <int SEC> __device__ __forceinline__ void epiB(const Params& p, int row, int col, f32x4 v) {
  char* ws = p.ws;
  if (SEC == 0) { f32x4 o = {gelu_f(v[0]), gelu_f(v[1]), gelu_f(v[2]), gelu_f(v[3])}; *(u32x2*)((u16*)(ws + OFF_UV) + (size_t)row * 1024 + col) = pack4(o); }
  else if (SEC == 1) { f32x4 o = {silu_f(v[0]), silu_f(v[1]), silu_f(v[2]), silu_f(v[3])}; *(u32x2*)((u16*)(ws + OFF_ZS) + (size_t)row * 1024 + (col - 1024)) = pack4(o); }
  else if (SEC == 2) {
    int c = col - 2048;
    *(u32x2*)((u16*)(ws + OFF_XBC) + (size_t)row * 1536 + c) = pack4(v);
    if (row >= TP) { *(f32x4*)(p.out + O_CONVS + (size_t)(row - TP) * 4608 + 3072 + c) = v; }
    else { int pos = row & 2047; if (pos >= 2045) *(f32x4*)(p.out + O_CONVP + (size_t)(row >> 11) * 4608 + (pos - 2045) * 1536 + c) = v; }
  }
  else if (SEC == 3) { *(u32x2*)((u16*)((char*)p.out + OOFF_Q) + (size_t)row * 512 + (col - 3584)) = pack4(v); }
  else if (SEC == 4) { f32x4 o = {sigm_f(v[0]), sigm_f(v[1]), sigm_f(v[2]), sigm_f(v[3])}; *(u32x2*)((u16*)(ws + OFF_GATE) + (size_t)row * 3072 + (col - 4096)) = pack4(o); }
  else {
    if (col < 512) {
      *(f32x4*)(p.out + O_MEMK + (size_t)row * 512 + col) = v;
      *(u32x2*)((u16*)(ws + OFF_KP) + (size_t)row * 512 + col) = pack4(v);
    } else {
      int c = col - 512;
      *(f32x4*)(p.out + O_MEMV + (size_t)row * 512 + c) = v;
      int b = row >> 8, mm = row & 255, hh = c >> 7, d = c & 127;
      int x = mm & 31, pos = (mm & ~31) + 8 * ((x >> 2) & 3) + 4 * (x >> 4) + (x & 3);
      u16* vt = (u16*)(ws + OFF_VT) + ((size_t)(b * 4 + hh) * 128 + d) * 256 + pos;
      vt[0] = f2bf(v[0]); vt[256] = f2bf(v[1]); vt[512] = f2bf(v[2]); vt[768] = f2bf(v[3]);
    }
  }
}
template <int SEC> __device__ __forceinline__ void epiB2(const Params& p, int row, int col32, f32x4 v0, f32x4 v1, int fq) {
  char* ws = p.ws;
  if (SEC == 0) { f32x4 o0 = {gelu_f(v0[0]), gelu_f(v0[1]), gelu_f(v0[2]), gelu_f(v0[3])}, o1 = {gelu_f(v1[0]), gelu_f(v1[1]), gelu_f(v1[2]), gelu_f(v1[3])};
    store_pair16((u16*)(ws + OFF_UV) + (size_t)row * 1024 + col32, pack4(o0), pack4(o1), fq); }
  else if (SEC == 1) { f32x4 o0 = {silu_f(v0[0]), silu_f(v0[1]), silu_f(v0[2]), silu_f(v0[3])}, o1 = {silu_f(v1[0]), silu_f(v1[1]), silu_f(v1[2]), silu_f(v1[3])};
    store_pair16((u16*)(ws + OFF_ZS) + (size_t)row * 1024 + (col32 - 1024), pack4(o0), pack4(o1), fq); }
  else if (SEC == 2) {
    const int c32 = col32 - 2048;
    store_pair16((u16*)(ws + OFF_XBC) + (size_t)row * 1536 + c32, pack4(v0), pack4(v1), fq);
    const int pos = row & 2047;
    if (pos >= 2045) {
      float* cp = p.out + O_CONVP + (size_t)(row >> 11) * 4608 + (pos - 2045) * 1536 + c32 + fq * 4;
      *(f32x4*)cp = v0; *(f32x4*)(cp + 16) = v1;
    }
  }
  else if (SEC == 3) { store_pair16((u16*)((char*)p.out + OOFF_Q) + (size_t)row * 512 + (col32 - 3584), pack4(v0), pack4(v1), fq); }
  else { f32x4 o0 = {sigm_f(v0[0]), sigm_f(v0[1]), sigm_f(v0[2]), sigm_f(v0[3])}, o1 = {sigm_f(v1[0]), sigm_f(v1[1]), sigm_f(v1[2]), sigm_f(v1[3])};
    store_pair16((u16*)(ws + OFF_GATE) + (size_t)row * 3072 + (col32 - 4096), pack4(o0), pack4(o1), fq); }
}
__device__ __forceinline__ int secB(int col) { return col < 1024 ? 0 : col < 2048 ? 1 : col < 3584 ? 2 : col < 4096 ? 3 : 4; }

__device__ __forceinline__ void phaseB(const Params& p, const int wv, const int rep) {
  const int wid = wv, wr = wid >> 2, wc = wid & 3;
  char* ws = p.ws;
  const u16* XN = (const u16*)((char*)p.out + OOFF_XN);
  {
    const u16* WIN = (const u16*)(ws + OFF_WIN);
    int t_ = blockIdx.x;
    const int tend = 1792 * rep;
    Acc acc;
    if (t_ < tend) {
      const int t = t_ >= 1792 ? t_ - 1792 : t_;
      kloop_t<1, true>(XN + (size_t)((t & 63) * 256) * 1024, 1024, WIN + (size_t)((t >> 6) * 256) * 1024, 1024, 1024, acc, wv);
    }
    while (t_ < tend) {
      const int t = t_ >= 1792 ? t_ - 1792 : t_;
      const int brow = (t & 63) * 256, bcol = (t >> 6) * 256, sec = secB(bcol);
      ACC_ZERO(acc);
      kloop_t<2>(XN + (size_t)brow * 1024, 1024, WIN + (size_t)bcol * 1024, 1024, 1024, acc, wv);
      t_ += gridDim.x;
      if (t_ < tend) {
        const int tn = t_ >= 1792 ? t_ - 1792 : t_;
        kloop_t<1, false>(XN + (size_t)((tn & 63) * 256) * 1024, 1024, WIN + (size_t)((tn >> 6) * 256) * 1024, 1024, 1024, acc, wv);
      }
      switch (sec) {
        case 0: ACC_FOREACH_PAIR({ epiB2<0>(p, brow + rrow, bcol + cb32, v0, v1, fq); }); break;
        case 1: ACC_FOREACH_PAIR({ epiB2<1>(p, brow + rrow, bcol + cb32, v0, v1, fq); }); break;
        case 2: ACC_FOREACH_PAIR({ epiB2<2>(p, brow + rrow, bcol + cb32, v0, v1, fq); }); break;
        case 3: ACC_FOREACH_PAIR({ epiB2<3>(p, brow + rrow, bcol + cb32, v0, v1, fq); }); break;
        default: ACC_FOREACH_PAIR({ epiB2<4>(p, brow + rrow, bcol + cb32, v0, v1, fq); }); break;
      }
    }
  }
  for (int gb = blockIdx.x; gb < 256; gb += gridDim.x) {
    const int task0 = gb * 14, mt = task0 / 448, nt0 = task0 - mt * 448;
    const u16* Ab = XN + (size_t)(TP + mt * 16) * 1024;
    const u16* Bb = (const u16*)(ws + OFF_WIN) + (size_t)(nt0 * 16) * 1024;
    skgemm<14>([&](int) { return Ab; }, [&](int i) { return Bb + (size_t)i * 16 * 1024; }, [&](int) { return 1024; }, 128, wv);
    for (int i = wv; i < 14; i += 8) {
      const int lane_e = lane_fresh(), fr = lane_e & 15, fq = lane_e >> 4;
      f32x4 a = skreduce(i);
      int row = TP + mt * 16 + fr, col = (nt0 + i) * 16 + fq * 4;
      switch (secB(col)) {
        case 0: epiB<0>(p, row, col, a); break;
        case 1: epiB<1>(p, row, col, a); break;
        case 2: epiB<2>(p, row, col, a); break;
        case 3: epiB<3>(p, row, col, a); break;
        default: epiB<4>(p, row, col, a); break;
      }
    }
  }
  for (int gb = blockIdx.x; gb < 256; gb += gridDim.x) {
    const u16* Bd = (const u16*)(ws + OFF_WDT);
    skgemm<5>([&](int i) { int tk = gb + 256 * i; tk = tk < T / 16 ? tk : 0; return XN + (size_t)(tk * 16) * 1024; }, [&](int) { return Bd; }, [&](int) { return 1024; }, 128, wv);
    for (int i = wv; i < 5; i += 8) {
      const int tk = gb + 256 * i;
      if (tk < T / 16) {
        const int lane_d = lane_fresh(), frd = lane_d & 15, fqd = lane_d >> 4;
        f32x4 a = skreduce(i);
        f32x4 bb = *(const f32x4*)(p.in[15] + fqd * 4);
        f32x4 o = {softplus_f(a[0] + bb[0]), softplus_f(a[1] + bb[1]), softplus_f(a[2] + bb[2]), softplus_f(a[3] + bb[3])};
        *(f32x4*)((float*)(ws + OFF_DT) + (size_t)(tk * 16 + frd) * 16 + fqd * 4) = o;
      }
    }
  }
}

__device__ __forceinline__ void ssd_prompt_item(const Params& p, int item, const int wv) {
  const int lane = lane_fresh(), wid = wv, tid = wv * 64 + lane, fr = lane & 15, fq = lane >> 4;
  const int h = item & 15, b = item >> 4, g = h >> 3;
  char* ws = p.ws;
  u16* C_l = (u16*)g_shm;
  u16* B_l = C_l + 128 * 136;
  u16* G_l = B_l;
  u16* BT_l = B_l + 128 * 136;
  u16* xT_l = BT_l + 128 * 136;
  u16* xw_l = xT_l + 64 * 136;
  u16* h_l = xw_l + 64 * 136;
  float* acum_l = (float*)(h_l + 64 * 136);
  float* dt_l = acum_l + 128;
  const u16* XBC = (const u16*)(ws + OFF_XBC);
  const u16* ZS = (const u16*)(ws + OFF_ZS);
  const float* DT = (const float*)(ws + OFF_DT);
  u16* Y = (u16*)((char*)p.out + OOFF_XN);
  float* YPS = (float*)(ws + OFF_YPS);
  const float Ah = -__expf(p.in[16][h]);
  const float Dh = p.in[17][h];
  const float* convw = p.in[13];
  const float* convb = p.in[14];
  const int cc = tid & 31, rg = tid >> 5;
  const int colbc = (cc < 16) ? (1024 + g * 128 + cc * 8) : (1280 + g * 128 + (cc - 16) * 8);
  const int xc = tid & 7, xr = tid >> 3;
  const int colx = h * 64 + xc * 8;
  const int j0 = rg * 8;
  f32x4 hacc[4];
#pragma unroll
  for (int pb = 0; pb < 4; ++pb) hacc[pb] = (f32x4){0.f, 0.f, 0.f, 0.f};
  u32x4 u[11], ux[5];
  float a0 = 0.f, a1 = 0.f;
#define SSD_PREFETCH(cn) do { const int t0n = b * 2048 + (cn) * 128; \
    _Pragma("unroll") for (int i_ = 0; i_ < 11; ++i_) { const int j_ = j0 - 3 + i_; const bool ok_ = ((cn) > 0) | (j_ >= 0); \
      u[i_] = *(const u32x4*)(XBC + (size_t)(t0n + (ok_ ? j_ : 0)) * 1536 + colbc); const unsigned m_ = ok_ ? 0xffffffffu : 0u; \
      u[i_].x &= m_; u[i_].y &= m_; u[i_].z &= m_; u[i_].w &= m_; } \
    _Pragma("unroll") for (int k_ = 0; k_ < 5; ++k_) { const int j_ = 2 * xr - 3 + k_; const bool ok_ = ((cn) > 0) | (j_ >= 0); \
      ux[k_] = *(const u32x4*)(XBC + (size_t)(t0n + (ok_ ? j_ : 0)) * 1536 + colx); const unsigned m_ = ok_ ? 0xffffffffu : 0u; \
      ux[k_].x &= m_; ux[k_].y &= m_; ux[k_].z &= m_; ux[k_].w &= m_; } \
    if (wid == 0) { a0 = DT[(size_t)(t0n + 2 * lane) * 16 + h]; a1 = DT[(size_t)(t0n + 2 * lane + 1) * 16 + h]; } } while (0)
  SSD_PREFETCH(0);
#pragma unroll 1
  for (int c = 0; c < 16; ++c) {
    const int t0 = b * 2048 + c * 128;
    __syncthreads();
#pragma unroll
    for (int pb = 0; pb < 4; ++pb) *(u32x2*)(h_l + (pb * 16 + fr) * 136 + wid * 16 + fq * 4) = pack4(hacc[pb]);
    if (wid == 0) {
      dt_l[2 * lane] = a0; dt_l[2 * lane + 1] = a1;
      float s = (a0 + a1) * Ah;
#pragma unroll
      for (int o = 1; o < 64; o <<= 1) { float v = shfl_idx_f(s, (lane - o) & 63); if (lane >= o) s += v; }
      acum_l[2 * lane + 1] = s; acum_l[2 * lane] = s - a1 * Ah;
    }
    {
      float w[4][8], bias[8];
#pragma unroll
      for (int k = 0; k < 4; ++k) { f32x4 w0 = *(const f32x4*)(convw + k * 1536 + colbc), w1 = *(const f32x4*)(convw + k * 1536 + colbc + 4);
        w[k][0] = w0[0]; w[k][1] = w0[1]; w[k][2] = w0[2]; w[k][3] = w0[3]; w[k][4] = w1[0]; w[k][5] = w1[1]; w[k][6] = w1[2]; w[k][7] = w1[3]; }
      { f32x4 b0 = *(const f32x4*)(convb + colbc), b1 = *(const f32x4*)(convb + colbc + 4);
        bias[0] = b0[0]; bias[1] = b0[1]; bias[2] = b0[2]; bias[3] = b0[3]; bias[4] = b1[0]; bias[5] = b1[1]; bias[6] = b1[2]; bias[7] = b1[3]; }
      unsigned outp[8][4];
#pragma unroll
      for (int jj = 0; jj < 8; ++jj) {
        float o[8];
#pragma unroll
        for (int e = 0; e < 8; ++e) o[e] = bias[e];
#pragma unroll
        for (int k = 0; k < 4; ++k) {
          u32x4 uu = u[jj + k];
          o[0] += w[k][0] * bflo(uu.x); o[1] += w[k][1] * bfhi(uu.x); o[2] += w[k][2] * bflo(uu.y); o[3] += w[k][3] * bfhi(uu.y);
          o[4] += w[k][4] * bflo(uu.z); o[5] += w[k][5] * bfhi(uu.z); o[6] += w[k][6] * bflo(uu.w); o[7] += w[k][7] * bfhi(uu.w);
        }
#pragma unroll
        for (int e = 0; e < 8; ++e) o[e] = silu_f(o[e]);
#pragma unroll
        for (int e2 = 0; e2 < 4; ++e2) outp[jj][e2] = cvt_pk(o[2 * e2], o[2 * e2 + 1]);
      }
      if (cc < 16) {
#pragma unroll
        for (int jj = 0; jj < 8; ++jj) *(u32x4*)(B_l + (j0 + jj) * 136 + cc * 8) = (u32x4){outp[jj][0], outp[jj][1], outp[jj][2], outp[jj][3]};
#pragma unroll
        for (int e2 = 0; e2 < 4; ++e2) {
          u32x4 lo, hi;
          lo.x = (outp[0][e2] & 0xffffu) | (outp[1][e2] << 16); lo.y = (outp[2][e2] & 0xffffu) | (outp[3][e2] << 16);
          lo.z = (outp[4][e2] & 0xffffu) | (outp[5][e2] << 16); lo.w = (outp[6][e2] & 0xffffu) | (outp[7][e2] << 16);
          hi.x = (outp[0][e2] >> 16) | (outp[1][e2] & 0xffff0000u); hi.y = (outp[2][e2] >> 16) | (outp[3][e2] & 0xffff0000u);
          hi.z = (outp[4][e2] >> 16) | (outp[5][e2] & 0xffff0000u); hi.w = (outp[6][e2] >> 16) | (outp[7][e2] & 0xffff0000u);
          *(u32x4*)(BT_l + (cc * 8 + 2 * e2) * 136 + j0) = lo;
          *(u32x4*)(BT_l + (cc * 8 + 2 * e2 + 1) * 136 + j0) = hi;
        }
      } else {
#pragma unroll
        for (int jj = 0; jj < 8; ++jj) *(u32x4*)(C_l + (j0 + jj) * 136 + (cc - 16) * 8) = (u32x4){outp[jj][0], outp[jj][1], outp[jj][2], outp[jj][3]};
      }
    }
    {
      f32x4 b0 = *(const f32x4*)(convb + colx), b1 = *(const f32x4*)(convb + colx + 4);
      f32x4 w0[4], w1[4];
#pragma unroll
      for (int k = 0; k < 4; ++k) { w0[k] = *(const f32x4*)(convw + k * 1536 + colx); w1[k] = *(const f32x4*)(convw + k * 1536 + colx + 4); }
      float xo[2][8];
#pragma unroll
      for (int r2 = 0; r2 < 2; ++r2) {
        float o[8] = {b0[0], b0[1], b0[2], b0[3], b1[0], b1[1], b1[2], b1[3]};
#pragma unroll
        for (int k = 0; k < 4; ++k) {
          u32x4 uu = ux[r2 + k];
          o[0] += w0[k][0] * bflo(uu.x); o[1] += w0[k][1] * bfhi(uu.x); o[2] += w0[k][2] * bflo(uu.y); o[3] += w0[k][3] * bfhi(uu.y);
          o[4] += w1[k][0] * bflo(uu.z); o[5] += w1[k][1] * bfhi(uu.z); o[6] += w1[k][2] * bflo(uu.w); o[7] += w1[k][3] * bfhi(uu.w);
        }
#pragma unroll
        for (int e = 0; e < 8; ++e) xo[r2][e] = silu_f(o[e]);
      }
#pragma unroll
      for (int e = 0; e < 8; ++e) *(unsigned*)(xT_l + (xc * 8 + e) * 136 + 2 * xr) = cvt_pk(xo[0][e], xo[1][e]);
    }
    __syncthreads();
    if (c < 15) SSD_PREFETCH(c + 1);
    u32x2 zsr[4];
#pragma unroll
    for (int pb = 0; pb < 4; ++pb) zsr[pb] = *(const u32x2*)(ZS + (size_t)(t0 + wid * 16 + fr) * 1024 + h * 64 + pb * 16 + fq * 4);
    bf16x8 cf[4];
#pragma unroll
    for (int ks = 0; ks < 4; ++ks) cf[ks] = *(const bf16x8*)(C_l + (wid * 16 + fr) * 136 + ks * 32 + fq * 8);
    f32x4 cb[8];
#pragma unroll
    for (int jb = 0; jb < 8; ++jb) {
      cb[jb] = (f32x4){0.f, 0.f, 0.f, 0.f};
      if (jb <= wid) {
#pragma unroll
        for (int ks = 0; ks < 4; ++ks) { bf16x8 bf = *(const bf16x8*)(B_l + (jb * 16 + fr) * 136 + ks * 32 + fq * 8); cb[jb] = MFMA16(bf, cf[ks], cb[jb]); }
      }
    }
    const float alast = acum_l[127];
#pragma unroll
    for (int r2 = 0; r2 < 2; ++r2) {
      int pp = (tid >> 4) + 32 * r2, jc = tid & 15;
      u32x4 xv = *(const u32x4*)(xT_l + pp * 136 + jc * 8);
      float wj[8];
#pragma unroll
      for (int e = 0; e < 8; ++e) wj[e] = dt_l[jc * 8 + e] * __expf(alast - acum_l[jc * 8 + e]);
      u32x4 ov;
      ov.x = cvt_pk(bflo(xv.x) * wj[0], bfhi(xv.x) * wj[1]); ov.y = cvt_pk(bflo(xv.y) * wj[2], bfhi(xv.y) * wj[3]);
      ov.z = cvt_pk(bflo(xv.z) * wj[4], bfhi(xv.z) * wj[5]); ov.w = cvt_pk(bflo(xv.w) * wj[6], bfhi(xv.w) * wj[7]);
      *(u32x4*)(xw_l + pp * 136 + jc * 8) = ov;
    }
    __syncthreads();
    {
      const int i = wid * 16 + fr;
      const float ai = acum_l[i];
#pragma unroll
      for (int jb = 0; jb < 8; ++jb) {
        f32x4 gv = {0.f, 0.f, 0.f, 0.f};
        if (jb <= wid) {
          f32x4 aj = *(const f32x4*)(acum_l + jb * 16 + fq * 4);
          f32x4 dj = *(const f32x4*)(dt_l + jb * 16 + fq * 4);
#pragma unroll
          for (int e = 0; e < 4; ++e) { int j = jb * 16 + fq * 4 + e; gv[e] = (j <= i) ? cb[jb][e] * __expf(ai - aj[e]) * dj[e] : 0.f; }
        }
        *(u32x2*)(G_l + i * 136 + jb * 16 + fq * 4) = pack4(gv);
      }
    }
    __syncthreads();
    {
      const int i = wid * 16 + fr, tok = t0 + i;
      const float ea = __expf(acum_l[i]);
      float ss = 0.f;
      u32x2 ypk[4];
      bf16x8 gf[4];
#pragma unroll
      for (int ks = 0; ks < 4; ++ks) gf[ks] = *(const bf16x8*)(G_l + (wid * 16 + fr) * 136 + ks * 32 + fq * 8);
#pragma unroll
      for (int pb = 0; pb < 4; ++pb) {
        f32x4 y = {0.f, 0.f, 0.f, 0.f};
#pragma unroll
        for (int ks = 0; ks < 4; ++ks) { bf16x8 hf = *(const bf16x8*)(h_l + (pb * 16 + fr) * 136 + ks * 32 + fq * 8); y = MFMA16(hf, cf[ks], y); }
        y = y * ea;
#pragma unroll
        for (int ks = 0; ks < 4; ++ks) {
          if (ks <= (wid >> 1)) {
            bf16x8 xf = *(const bf16x8*)(xT_l + (pb * 16 + fr) * 136 + ks * 32 + fq * 8);
            y = MFMA16(xf, gf[ks], y);
          }
        }
        const int pc = pb * 16 + fq * 4;
        f32x4 zs = unpack4(zsr[pb]);
#pragma unroll
        for (int e = 0; e < 4; ++e) { float xv = bf2f(xT_l[(pc + e) * 136 + i]); y[e] = (y[e] + xv * Dh) * zs[e]; ss += y[e] * y[e]; }
        ypk[pb] = pack4(y);
      }
      store_pair16(Y + (size_t)tok * 1024 + h * 64, ypk[0], ypk[1], fq);
      store_pair16(Y + (size_t)tok * 1024 + h * 64 + 32, ypk[2], ypk[3], fq);
      ss += shfl_xor_f(ss, 16); ss += shfl_xor_f(ss, 32);
      if (fq == 0) { YPS[(size_t)tok * 32 + g * 16 + (h & 7) * 2] = ss; YPS[(size_t)tok * 32 + g * 16 + (h & 7) * 2 + 1] = 0.f; }
    }
    {
      const float dl = __expf(alast);
      bf16x8 btf[4];
#pragma unroll
      for (int ks = 0; ks < 4; ++ks) btf[ks] = *(const bf16x8*)(BT_l + (wid * 16 + fr) * 136 + ks * 32 + fq * 8);
#pragma unroll
      for (int pb = 0; pb < 4; ++pb) {
        hacc[pb] = hacc[pb] * dl;
#pragma unroll
        for (int ks = 0; ks < 4; ++ks) {
          bf16x8 xwf = *(const bf16x8*)(xw_l + (pb * 16 + fr) * 136 + ks * 32 + fq * 8);
          hacc[pb] = MFMA16(btf[ks], xwf, hacc[pb]);
        }
      }
    }
  }
#undef SSD_PREFETCH
#pragma unroll
  for (int pb = 0; pb < 4; ++pb)
    *(f32x4*)(p.out + O_SSMP + ((size_t)(b * 16 + h) * 64 + pb * 16 + fr) * 128 + wid * 16 + fq * 4) = hacc[pb];
}

__device__ __forceinline__ void memkv_tile(const Params& p, int item, const int wv, unsigned* bar) {
  const int wid = wv, wr = wid >> 2, wc = wid & 3;
  const int h = item & 3, b = item >> 2;
  char* ws = p.ws;
  Acc acc; ACC_ZERO(acc);
  kloop((const u16*)(ws + OFF_MN) + (size_t)(b * 256) * 1024, 1024, (const u16*)(ws + OFF_WKV) + (size_t)(h * 256) * 1024, 1024, 1024, acc, wv);
  ACC_FOREACH({
    const int row = b * 256 + rrow;
    const int col = (rcol < 128) ? (h * 128 + rcol) : (512 + h * 128 + rcol - 128);
    epiB<5>(p, row, col, v);
  });
  asm volatile("s_waitcnt vmcnt(0)" ::: "memory");
  __syncthreads();
  if (wv == 0) { if (lane_fresh() == 0) { __builtin_amdgcn_fence(__ATOMIC_RELEASE, "agent"); asm volatile("s_waitcnt vmcnt(0)" ::: "memory"); (void)xb_add(&bar[6144 + item * 16], 1u); } }
}

__device__ __forceinline__ void attn_prompt_item(const Params& p, int item, const int wv, unsigned* bar) {
  const int lane = lane_fresh(), wid = wv, tid = wv * 64 + lane, fr = lane & 15, fq = lane >> 4;
  const int qt = item & 7, h = (item >> 3) & 3, b = item >> 5;
  char* ws = p.ws;
  u16* K_l = (u16*)g_shm;
  u16* VT_l = K_l + 256 * 136;
  const u16* KP = (const u16*)(ws + OFF_KP);
  const u16* VT = (const u16*)(ws + OFF_VT);
  u16* Q = (u16*)((char*)p.out + OOFF_Q);
  if (wv == 0) { if (lane == 0) { XB_SPIN(xb_ld(&bar[6144 + (b * 4 + h) * 16]) == 0u, bar); } }
  __syncthreads();
  __builtin_amdgcn_fence(__ATOMIC_ACQUIRE, "agent");
#pragma unroll
  for (int i = 0; i < 8; ++i) {
    int idx = i * 512 + tid, mm = idx >> 4, ch = idx & 15;
    *(u32x4*)(K_l + mm * 136 + ch * 8) = *(const u32x4*)(KP + (size_t)(b * 256 + mm) * 512 + h * 128 + ch * 8);
  }
#pragma unroll
  for (int i = 0; i < 8; ++i) {
    int idx = i * 512 + tid, d = idx >> 5, ch = idx & 31;
    *(u32x4*)(VT_l + d * 264 + ch * 8) = *(const u32x4*)(VT + ((size_t)(b * 4 + h) * 128 + d) * 256 + ch * 8);
  }
  const int q0 = b * 2048 + qt * 256 + wid * 32;
  bf16x8 qf[2][4];
#pragma unroll
  for (int qb = 0; qb < 2; ++qb)
#pragma unroll
    for (int ks = 0; ks < 4; ++ks) qf[qb][ks] = *(const bf16x8*)(Q + (size_t)(q0 + qb * 16 + fr) * 512 + h * 128 + ks * 32 + fq * 8);
  __syncthreads();
  f32x4 s[16][2];
#pragma unroll
  for (int mb = 0; mb < 16; ++mb) {
    s[mb][0] = (f32x4){0.f, 0.f, 0.f, 0.f}; s[mb][1] = (f32x4){0.f, 0.f, 0.f, 0.f};
#pragma unroll
    for (int ks = 0; ks < 4; ++ks) {
      bf16x8 kf = *(const bf16x8*)(K_l + (mb * 16 + fr) * 136 + ks * 32 + fq * 8);
      s[mb][0] = MFMA16(kf, qf[0][ks], s[mb][0]);
      s[mb][1] = MFMA16(kf, qf[1][ks], s[mb][1]);
    }
  }
  const float cexp = 0.08838834764831845f * 1.4426950408889634f;
  float inv[2];
  bf16x8 pf[2][8];
#pragma unroll
  for (int qb = 0; qb < 2; ++qb) {
    float mx = -1e30f;
#pragma unroll
    for (int mb = 0; mb < 16; ++mb) mx = fmaxf(mx, fmaxf(fmaxf(s[mb][qb][0], s[mb][qb][1]), fmaxf(s[mb][qb][2], s[mb][qb][3])));
    mx = fmaxf(mx, shfl_xor_f(mx, 16)); mx = fmaxf(mx, shfl_xor_f(mx, 32));
    float sum = 0.f;
#pragma unroll
    for (int mb = 0; mb < 16; ++mb)
#pragma unroll
      for (int e = 0; e < 4; ++e) { float pv = exp2f((s[mb][qb][e] - mx) * cexp); s[mb][qb][e] = pv; sum += pv; }
    sum += shfl_xor_f(sum, 16); sum += shfl_xor_f(sum, 32);
    inv[qb] = 1.f / sum;
#pragma unroll
    for (int st = 0; st < 8; ++st) {
      u32x2 lo = pack4(s[2 * st][qb]), hi = pack4(s[2 * st + 1][qb]);
      u32x4 w = {lo.x, lo.y, hi.x, hi.y};
      pf[qb][st] = __builtin_bit_cast(bf16x8, w);
    }
  }
  f32x4 o[8][2];
#pragma unroll
  for (int db = 0; db < 8; ++db) { o[db][0] = (f32x4){0.f, 0.f, 0.f, 0.f}; o[db][1] = (f32x4){0.f, 0.f, 0.f, 0.f}; }
#pragma unroll
  for (int st = 0; st < 8; ++st)
#pragma unroll
    for (int db = 0; db < 8; ++db) {
      bf16x8 vf = *(const bf16x8*)(VT_l + (db * 16 + fr) * 264 + st * 32 + fq * 8);
      o[db][0] = MFMA16(vf, pf[0][st], o[db][0]);
      o[db][1] = MFMA16(vf, pf[1][st], o[db][1]);
    }
#pragma unroll
  for (int qb = 0; qb < 2; ++qb)
#pragma unroll
    for (int dp = 0; dp < 4; ++dp)
      store_pair16((u16*)(ws + OFF_XA) + (size_t)(q0 + qb * 16 + fr) * 512 + h * 128 + dp * 32, pack4(o[2 * dp][qb] * inv[qb]), pack4(o[2 * dp + 1][qb] * inv[qb]), fq);
}

__device__ __forceinline__ void gmlp_prompt_item(const Params& p, int item, const int wv) {
  const int lane = lane_fresh(), wid = wv, tid = wv * 64 + lane, fr = lane & 15, fq = lane >> 4;
  const int gp = item & 1, c = (item >> 1) & 15, b = item >> 5;
  const int t0 = b * 2048 + c * 128;
  char* ws = p.ws;
  u16* VnT = (u16*)g_shm;
  const u16* UV = (const u16*)(ws + OFF_UV);
  const u16* WSB = (const u16*)(ws + OFF_WSB);
  u16* GM = (u16*)((char*)p.out + OOFF_GM);
  __syncthreads();
  {
    const int row = tid >> 2, qq = tid & 3;
    const u16* vrow = UV + (size_t)(t0 + row) * 1024 + 512;
    float sm = 0.f, sq = 0.f;
#pragma unroll
    for (int i = 0; i < 16; ++i) {
      u32x4 w = *(const u32x4*)(vrow + qq * 128 + i * 8);
      float f[8] = {bflo(w.x), bfhi(w.x), bflo(w.y), bfhi(w.y), bflo(w.z), bfhi(w.z), bflo(w.w), bfhi(w.w)};
#pragma unroll
      for (int e = 0; e < 8; ++e) { sm += f[e]; sq += f[e] * f[e]; }
    }
    sm += shfl_xor_f(sm, 1); sm += shfl_xor_f(sm, 2); sq += shfl_xor_f(sq, 1); sq += shfl_xor_f(sq, 2);
    const float mean = sm * (1.f / 512.f), var = fmaxf(sq * (1.f / 512.f) - mean * mean, 0.f), rstd = rsqrtf(var + EPS);
#pragma unroll
    for (int i = 0; i < 8; ++i) {
      const int cl = qq * 64 + i * 8, col = gp * 256 + cl;
      u32x4 w = *(const u32x4*)(vrow + col);
      float f[8] = {bflo(w.x), bfhi(w.x), bflo(w.y), bfhi(w.y), bflo(w.z), bfhi(w.z), bflo(w.w), bfhi(w.w)};
#pragma unroll
      for (int e = 0; e < 8; ++e) {
        float vn = (f[e] - mean) * rstd * p.in[9][col + e] + p.in[10][col + e];
        VnT[(cl + e) * 136 + row] = f2bf(vn);
      }
    }
  }
  __syncthreads();
  f32x4 acc[16];
#pragma unroll
  for (int db = 0; db < 16; ++db) acc[db] = (f32x4){0.f, 0.f, 0.f, 0.f};
#pragma unroll
  for (int ks = 0; ks < 4; ++ks) {
    if (ks <= (wid >> 1)) {
      bf16x8 w0 = *(const bf16x8*)(WSB + ((size_t)(gp * 2) * 128 + wid * 16 + fr) * 128 + ks * 32 + fq * 8);
      bf16x8 w1 = *(const bf16x8*)(WSB + ((size_t)(gp * 2 + 1) * 128 + wid * 16 + fr) * 128 + ks * 32 + fq * 8);
#pragma unroll
      for (int db = 0; db < 16; ++db) {
        bf16x8 vf = *(const bf16x8*)(VnT + (db * 16 + fr) * 136 + ks * 32 + fq * 8);
        acc[db] = MFMA16(vf, db < 8 ? w0 : w1, acc[db]);
      }
    }
  }
  const int tt = wid * 16 + fr, tok = t0 + tt;
#pragma unroll
  for (int dp = 0; dp < 8; ++dp) {
    const int gs = gp * 2 + (dp >> 2), cb = gs * 128 + (dp & 3) * 32;
    const float bsv = p.in[12][gs * 128 + tt];
    f32x4 u0 = unpack4(*(const u32x2*)(UV + (size_t)tok * 1024 + cb + fq * 4)), u1 = unpack4(*(const u32x2*)(UV + (size_t)tok * 1024 + cb + 16 + fq * 4));
    store_pair16(GM + (size_t)tok * 512 + cb, pack4(u0 * (acc[2 * dp] + bsv)), pack4(u1 * (acc[2 * dp + 1] + bsv)), fq);
  }
}

__device__ __forceinline__ void gmlp_sample_row(const Params& p, int bidx, const int wv) {
  const int lane = lane_fresh();
  char* ws = p.ws;
  const u16* UV = (const u16*)(ws + OFF_UV);
  u16* GM = (u16*)((char*)p.out + OOFF_GM);
  const int tok = TP + bidx;
  u32x4 w = *(const u32x4*)(UV + (size_t)tok * 1024 + 512 + lane * 8);
  float f[8] = {bflo(w.x), bfhi(w.x), bflo(w.y), bfhi(w.y), bflo(w.z), bfhi(w.z), bflo(w.w), bfhi(w.w)};
  float sm = 0.f, sq = 0.f;
#pragma unroll
  for (int e = 0; e < 8; ++e) { sm += f[e]; sq += f[e] * f[e]; }
  sm = wave_sum(sm); sq = wave_sum(sq);
  const float mean = sm * (1.f / 512.f), var = fmaxf(sq * (1.f / 512.f) - mean * mean, 0.f), rstd = rsqrtf(var + EPS);
  const int col = lane * 8, gs = col >> 7;
  const float w00 = p.in[11][gs * 16384], bs0 = p.in[12][gs * 128];
  u32x4 uw = *(const u32x4*)(UV + (size_t)tok * 1024 + col);
  float u[8] = {bflo(uw.x), bfhi(uw.x), bflo(uw.y), bfhi(uw.y), bflo(uw.z), bfhi(uw.z), bflo(uw.w), bfhi(uw.w)};
  float vn[8], o[8];
#pragma unroll
  for (int e = 0; e < 8; ++e) { vn[e] = (f[e] - mean) * rstd * p.in[9][col + e] + p.in[10][col + e]; o[e] = u[e] * (w00 * vn[e] + bs0); }
  *(f32x4*)(p.out + O_GMV + (size_t)bidx * 512 + col) = (f32x4){vn[0], vn[1], vn[2], vn[3]};
  *(f32x4*)(p.out + O_GMV + (size_t)bidx * 512 + col + 4) = (f32x4){vn[4], vn[5], vn[6], vn[7]};
  u32x4 ow = {cvt_pk(o[0], o[1]), cvt_pk(o[2], o[3]), cvt_pk(o[4], o[5]), cvt_pk(o[6], o[7])};
  *(u32x4*)(GM + (size_t)tok * 512 + col) = ow;
}

__device__ __forceinline__ void ssd_sample_item(const Params& p, int item, const int wv) {
  const int lane = lane_fresh();
  const int h = item & 15, b = item >> 4, g = h >> 3, tok = TP + b;
  char* ws = p.ws;
  const u16* XBC = (const u16*)(ws + OFF_XBC);
  const u16* ZS = (const u16*)(ws + OFF_ZS);
  const float* DT = (const float*)(ws + OFF_DT);
  u16* Y = (u16*)((char*)p.out + OOFF_XN);
  float* YPS = (float*)(ws + OFF_YPS);
  const float* sc = p.in[5] + (size_t)b * 4608;
  const float* convw = p.in[13];
  const float* convb = p.in[14];
  auto conv1 = [&](int col) -> float {
    float o = convb[col] + convw[col] * sc[col] + convw[1536 + col] * sc[1536 + col] + convw[3072 + col] * sc[3072 + col]
            + convw[4608 + col] * bf2f(XBC[(size_t)tok * 1536 + col]);
    return silu_f(o);
  };
  const float x = conv1(h * 64 + lane);
  const int n4 = (lane & 31) * 4, hf = lane >> 5;
  float Bv[4], Cv[4];
#pragma unroll
  for (int e = 0; e < 4; ++e) { Bv[e] = conv1(1024 + g * 128 + n4 + e); Cv[e] = conv1(1280 + g * 128 + n4 + e); }
  const float dt = DT[(size_t)tok * 16 + h];
  const float dA = __expf(-dt * __expf(p.in[16][h]));
  const float* st = p.in[6] + ((size_t)(b * 16 + h) * 64) * 128;
  float* so = p.out + O_SSMS + ((size_t)(b * 16 + h) * 64) * 128;
  float ymine = 0.f;
#pragma unroll 8
  for (int r = 0; r < 32; ++r) {
    const int pp = 2 * r + hf;
    f32x4 hv = *(const f32x4*)(st + (size_t)pp * 128 + n4);
    const float xp = shfl_idx_f(x, pp) * dt;
    f32x4 hn;
    float yp = 0.f;
#pragma unroll
    for (int e = 0; e < 4; ++e) { hn[e] = dA * hv[e] + xp * Bv[e]; yp += hn[e] * Cv[e]; }
    *(f32x4*)(so + (size_t)pp * 128 + n4) = hn;
#pragma unroll
    for (int o = 16; o >= 1; o >>= 1) yp += shfl_xor_f(yp, o);
    if ((lane & 31) == r) ymine = yp;
  }
  const int pm = 2 * (lane & 31) + hf;
  const float xm = shfl_idx_f(x, pm);
  const float zs = bf2f(ZS[(size_t)tok * 1024 + h * 64 + pm]);
  const float yg = (ymine + xm * p.in[17][h]) * zs;
  float ss = wave_sum(yg * yg);
  Y[(size_t)tok * 1024 + h * 64 + pm] = f2bf(yg);
  if (lane == 0) { YPS[(size_t)tok * 32 + g * 16 + (h & 7) * 2] = ss; YPS[(size_t)tok * 32 + g * 16 + (h & 7) * 2 + 1] = 0.f; }
}

__device__ __forceinline__ void attn_sample_item(const Params& p, int item, const int wv) {
  const int lane = lane_fresh(), wid = wv, tid = wv * 64 + lane;
  const int h = item & 3, b = item >> 2, tok = TP + b;
  float* sc_l = (float*)g_shm;
  float* red_l = sc_l + 256;
  u16* Q = (u16*)((char*)p.out + OOFF_Q);
  const float* Kc = p.in[3] + ((size_t)b * 256 * 4 + h) * 128;
  const float* Vc = p.in[4] + ((size_t)b * 256 * 4 + h) * 128;
  const int vdch = tid & 31, vmg = tid >> 5;
  f32x4 vreg[16];
#pragma unroll
  for (int i = 0; i < 16; ++i) vreg[i] = *(const f32x4*)(Vc + (size_t)(vmg * 16 + i) * 512 + vdch * 4);
  __syncthreads();
  {
    const int dch = lane & 15, ksub = lane >> 4;
    u32x4 qw = *(const u32x4*)(Q + (size_t)tok * 512 + h * 128 + dch * 8);
    float q[8] = {bflo(qw.x), bfhi(qw.x), bflo(qw.y), bfhi(qw.y), bflo(qw.z), bfhi(qw.z), bflo(qw.w), bfhi(qw.w)};
#pragma unroll
    for (int it = 0; it < 8; ++it) {
      const int mm = wid * 32 + it * 4 + ksub;
      f32x4 k0 = *(const f32x4*)(Kc + (size_t)mm * 512 + dch * 8), k1 = *(const f32x4*)(Kc + (size_t)mm * 512 + dch * 8 + 4);
      float d = q[0] * k0[0] + q[1] * k0[1] + q[2] * k0[2] + q[3] * k0[3] + q[4] * k1[0] + q[5] * k1[1] + q[6] * k1[2] + q[7] * k1[3];
      d += shfl_xor_f(d, 1); d += shfl_xor_f(d, 2); d += shfl_xor_f(d, 4); d += shfl_xor_f(d, 8);
      if (dch == 0) sc_l[mm] = d * 0.08838834764831845f;
    }
  }
  __syncthreads();
  float pv[4];
  {
    float mx = -1e30f;
#pragma unroll
    for (int i = 0; i < 4; ++i) { pv[i] = sc_l[lane + 64 * i]; mx = fmaxf(mx, pv[i]); }
    mx = wave_max(mx);
    float sum = 0.f;
#pragma unroll
    for (int i = 0; i < 4; ++i) { pv[i] = __expf(pv[i] - mx); sum += pv[i]; }
    sum = wave_sum(sum);
    const float inv = 1.f / sum;
#pragma unroll
    for (int i = 0; i < 4; ++i) pv[i] *= inv;
  }
  __syncthreads();
  if (wid == 0) {
#pragma unroll
    for (int i = 0; i < 4; ++i) sc_l[lane + 64 * i] = pv[i];
  }
  __syncthreads();
  {
    f32x4 acc = {0.f, 0.f, 0.f, 0.f};
#pragma unroll
    for (int i = 0; i < 16; ++i) acc += vreg[i] * sc_l[vmg * 16 + i];
    *(f32x4*)(red_l + vmg * 128 + vdch * 4) = acc;
  }
  __syncthreads();
  if (tid < 128) {
    float o = 0.f;
#pragma unroll
    for (int mg = 0; mg < 16; ++mg) o += red_l[mg * 128 + tid];
    ((u16*)(p.ws + OFF_XA))[(size_t)tok * 512 + h * 128 + tid] = f2bf(o);
  }
}

__device__ __forceinline__ void phaseC(const Params& p, const int wv, const int r0, const int r1, const int r2, const int r3, const int r4, unsigned* bar) {
  const int wid = wv;
  const int nS = gridDim.x >> 1;
  if ((int)blockIdx.x < nS) {
    for (int it = blockIdx.x; it < 128 * r0; it += nS) ssd_prompt_item(p, it & 127, wv);
  } else {
    const int ob = blockIdx.x - nS, nO = gridDim.x - nS;
    const int gw = ob * 8 + wid, nw = nO * 8;
    for (int it = ob; it < 32; it += nO) memkv_tile(p, it, wv, bar);
    for (int it = gw; it < 2048 * r1; it += nw) ssd_sample_item(p, it & 2047, wv);
    if (nO >= 64) {
      if (ob < 32) attn_sample_item(p, ob, wv);
      else for (int it = 32 + (ob - 32); it < 512; it += nO - 32) attn_sample_item(p, it, wv);
    } else {
      for (int it = ob; it < 512; it += nO) attn_sample_item(p, it, wv);
    }
    for (int it = ob; it < 256 * r2; it += nO) attn_prompt_item(p, it & 255, wv, bar);
    for (int it = ob; it < 256 * r3; it += nO) gmlp_prompt_item(p, it & 255, wv);
    for (int it = gw; it < 128; it += nw) gmlp_sample_row(p, it, wv);
  }
}

__device__ __forceinline__ void phaseD(const Params& p, const int wv, const int rep) {
  const int wid = wv, wr = wid >> 2, wc = wid & 3;
  char* ws = p.ws;
  const u16* GM = (const u16*)((char*)p.out + OOFF_GM);
  const u16* Y = (const u16*)((char*)p.out + OOFF_XN);
  const u16* XA = (const u16*)(ws + OFF_XA);
  const u16* GATE = (const u16*)(ws + OFF_GATE);
  const float* YPS = (const float*)(ws + OFF_YPS);
  u16* MERGED = (u16*)(ws + OFF_MERGED);
  const u16* WGM = (const u16*)(ws + OFF_WGM);
  const u16* WSSD = (const u16*)(ws + OFF_WSSD);
  const u16* WXA = (const u16*)(ws + OFF_WXA);
  float* rs_l = (float*)(g_shm + 131072);
  for (int t_ = blockIdx.x; t_ < 256 * rep; t_ += gridDim.x) {
    const int t = t_ & 255;
    const int pm = t & 63, pn = t >> 6, brow = pm * 256, bcol = pn * 256;
    __syncthreads();
    {
      const int tid = wv * 64 + lane_fresh();
      const int r = tid >> 1, gg = tid & 1;
      const float* ps = YPS + (size_t)(brow + r) * 32 + gg * 16;
      f32x4 a = *(const f32x4*)ps + *(const f32x4*)(ps + 4) + *(const f32x4*)(ps + 8) + *(const f32x4*)(ps + 12);
      rs_l[r * 2 + gg] = rsqrtf((a[0] + a[1] + a[2] + a[3]) * (1.f / 512.f) + EPS);
    }
    auto opnd = [&](int br, const u16*& Ap, const u16*& Bp, int& ld) {
      if (br == 0) { Ap = GM + (size_t)brow * 512; Bp = WGM + (size_t)bcol * 512; ld = 512; }
      else if (br == 1) { Ap = Y + (size_t)brow * 1024; Bp = WSSD + (size_t)bcol * 1024; ld = 1024; }
      else if (br == 2) { Ap = Y + (size_t)brow * 1024 + 512; Bp = WSSD + (size_t)bcol * 1024 + 512; ld = 1024; }
      else { Ap = XA + (size_t)brow * 512; Bp = WXA + (size_t)bcol * 512; ld = 512; }
    };
    Acc acc; ACC_ZERO(acc);
    { const u16 *Ap, *Bp; int ld; opnd(0, Ap, Bp, ld); kloop_t<1, true>(Ap, ld, Bp, ld, 512, acc, wv); }
#pragma unroll 1
    for (int br = 0; br < 4; ++br) {
      const u16 *Ap, *Bp; int ld; opnd(br, Ap, Bp, ld);
      kloop_t<2>(Ap, ld, Bp, ld, 512, acc, wv);
      const int gnum = (br == 0) ? 0 : (br == 2) ? 1024 : 2048, gden = (br == 0) ? 1024 : 2048;
      const int lane_e = lane_fresh(), fr = lane_e & 15, fq = lane_e >> 4;
      const int r0 = brow + wr * 64 + fr, c0 = bcol + wc * 32 + fq * 4;
      u32x2 gq[2][4], dq[2][4];
#define D_LOAD(g, buf) do { const int row_ = r0 + ((g) >> 2) * 128 + ((g) & 3) * 16; \
        _Pragma("unroll") for (int q = 0; q < 4; ++q) { const int col_ = c0 + (q >> 1) * 128 + (q & 1) * 16; \
          gq[buf][q] = (u32x2){0x3f803f80u, 0x3f803f80u}; dq[buf][q] = (u32x2){0x3f803f80u, 0x3f803f80u}; \
          if (br != 1) gq[buf][q] = *(const u32x2*)(GATE + (size_t)row_ * 3072 + gnum + col_); \
          if (br == 0 || br == 2) dq[buf][q] = *(const u32x2*)(GATE + (size_t)row_ * 3072 + gden + col_); } } while (0)
      D_LOAD(0, 0);
      if (br < 3) { const u16 *An, *Bn; int ldn; opnd(br + 1, An, Bn, ldn); kloop_t<1, false>(An, ldn, Bn, ldn, 512, acc, wv); }
#pragma unroll
      for (int g = 0; g < 8; ++g) {
        if (g < 7) D_LOAD(g + 1, (g + 1) & 1);
        __builtin_amdgcn_sched_barrier(0);
        const int ai = g >> 2, m = g & 3, rrow = ai * 128 + wr * 64 + m * 16 + fr, row_ = brow + rrow;
        const float rs0 = rs_l[rrow * 2], rs1 = rs_l[rrow * 2 + 1];
        const float rsc = (br == 0) ? __builtin_amdgcn_rcpf(rs0) : (br == 1) ? rs0 * __builtin_amdgcn_rcpf(rs1) : (br == 2) ? rs1 : 1.f;
#pragma unroll
        for (int q = 0; q < 4; ++q) {
          const int col_ = c0 + (q >> 1) * 128 + (q & 1) * 16;
          const f32x4 gn = unpack4(gq[g & 1][q]), gd = unpack4(dq[g & 1][q]);
          f32x4 sc;
#pragma unroll
          for (int e = 0; e < 4; ++e) sc[e] = gn[e] * rsc * __builtin_amdgcn_rcpf(fmaxf(gd[e], 1e-30f));
          f32x4 o = acc[ai][q >> 1][m][q & 1] * sc;
          acc[ai][q >> 1][m][q & 1] = o;
        }
        if (br == 3) {
          u16* mrow = MERGED + (size_t)row_ * 1024 + bcol + wc * 32;
          store_pair16(mrow, pack4(acc[ai][0][m][0]), pack4(acc[ai][0][m][1]), fq);
          store_pair16(mrow + 128, pack4(acc[ai][1][m][0]), pack4(acc[ai][1][m][1]), fq);
        }
        __builtin_amdgcn_sched_barrier(0);
      }
#undef D_LOAD
    }
  }
  for (int gb = blockIdx.x; gb < 256; gb += gridDim.x) {
    const int task0 = gb * 2, mt = task0 >> 6, nt0 = task0 & 63, r0 = TP + mt * 16;
    skgemm<8>([&](int i) { const int br = i & 3; return br == 0 ? GM + (size_t)r0 * 512 : br == 1 ? Y + (size_t)r0 * 1024 : br == 2 ? Y + (size_t)r0 * 1024 + 512 : XA + (size_t)r0 * 512; },
              [&](int i) { const int br = i & 3, c0 = (nt0 + (i >> 2)) * 16; return br == 0 ? WGM + (size_t)c0 * 512 : br == 1 ? WSSD + (size_t)c0 * 1024 : br == 2 ? WSSD + (size_t)c0 * 1024 + 512 : WXA + (size_t)c0 * 512; },
              [&](int i) { const int br = i & 3; return (br == 1 || br == 2) ? 1024 : 512; }, 64, wv);
    if (wv < 2) {
      const int lane_e = lane_fresh(), fr = lane_e & 15, fq = lane_e >> 4;
      const int row = r0 + fr, col = (nt0 + wv) * 16 + fq * 4;
      const u16* gp_ = GATE + (size_t)row * 3072 + col;
      f32x4 g0 = unpack4(*(const u32x2*)gp_), g1 = unpack4(*(const u32x2*)(gp_ + 1024)), g2 = unpack4(*(const u32x2*)(gp_ + 2048));
      float rs[2];
#pragma unroll
      for (int gg = 0; gg < 2; ++gg) {
        const float* ps = YPS + (size_t)row * 32 + gg * 16;
        f32x4 a = *(const f32x4*)ps + *(const f32x4*)(ps + 4) + *(const f32x4*)(ps + 8) + *(const f32x4*)(ps + 12);
        rs[gg] = rsqrtf((a[0] + a[1] + a[2] + a[3]) * (1.f / 512.f) + EPS);
      }
      f32x4 a0 = skreduce(wv * 4 + 0), a1 = skreduce(wv * 4 + 1), a2 = skreduce(wv * 4 + 2), a3 = skreduce(wv * 4 + 3);
      f32x4 o = g0 * a0 + g1 * (a1 * rs[0] + a2 * rs[1]) + g2 * a3;
      *(u32x2*)(MERGED + (size_t)row * 1024 + col) = pack4(o);
    }
  }
}

__device__ __forceinline__ void phaseE(const Params& p, const int wv, const int rep) {
  const int wid = wv, wr = wid >> 2, wc = wid & 3;
  char* ws = p.ws;
  const u16* MERGED = (const u16*)(ws + OFF_MERGED);
  const u16* WOUT = (const u16*)(ws + OFF_WOUT);
  u16* H2B = (u16*)(ws + OFF_H2B);
  float* PS = (float*)(ws + OFF_PS);
  float* PSS = (float*)(ws + OFF_PSS);
  for (int t_ = blockIdx.x; t_ < 256 * rep; t_ += gridDim.x) {
    const int t = t_ & 255;
    const int pm = t & 63, pn = t >> 6, brow = pm * 256, bcol = pn * 256;
    Acc acc; ACC_ZERO(acc);
    kloop(MERGED + (size_t)brow * 1024, 1024, WOUT + (size_t)bcol * 1024, 1024, 1024, acc, wv);
    const int lane_e = lane_fresh(), fr = lane_e & 15, fq = lane_e >> 4; (void)fr; (void)fq;
#pragma unroll
    for (int ai = 0; ai < 2; ++ai)
#pragma unroll
      for (int m = 0; m < 4; ++m) {
        const int row = brow + ai * 128 + wr * 64 + m * 16 + fr;
        float ss = 0.f;
#pragma unroll
        for (int bj = 0; bj < 2; ++bj)
          {
            const int cb = bcol + bj * 128 + wc * 32;
            f32x4 v0 = acc[ai][bj][m][0] + *(const f32x4*)(p.in[0] + (size_t)row * 1024 + cb + fq * 4);
            f32x4 v1 = acc[ai][bj][m][1] + *(const f32x4*)(p.in[0] + (size_t)row * 1024 + cb + 16 + fq * 4);
            store_pair16(H2B + (size_t)row * 1024 + cb, pack4(v0), pack4(v1), fq);
            ss += v0[0] * v0[0] + v0[1] * v0[1] + v0[2] * v0[2] + v0[3] * v0[3] + v1[0] * v1[0] + v1[1] * v1[1] + v1[2] * v1[2] + v1[3] * v1[3];
          }
        ss += shfl_xor_f(ss, 16); ss += shfl_xor_f(ss, 32);
        if (fq == 0) PS[(size_t)row * 16 + pn * 4 + wc] = ss;
      }
  }
  for (int gb = blockIdx.x; gb < 256; gb += gridDim.x) {
    const int task0 = gb * 2, mt = task0 >> 6, nt0 = task0 & 63;
    const u16* Ab = MERGED + (size_t)(TP + mt * 16) * 1024;
    skgemm<2>([&](int) { return Ab; }, [&](int i) { return WOUT + (size_t)((nt0 + i) * 16) * 1024; }, [&](int) { return 1024; }, 128, wv);
    if (wv < 2) {
      const int lane_e = lane_fresh(), fr = lane_e & 15, fq = lane_e >> 4;
      const int ntl = nt0 + wv, row = TP + mt * 16 + fr, col = ntl * 16 + fq * 4;
      f32x4 v = skreduce(wv) + *(const f32x4*)(p.in[1] + (size_t)(row - TP) * 1024 + col);
      *(u32x2*)(H2B + (size_t)row * 1024 + col) = pack4(v);
      float ss = v[0] * v[0] + v[1] * v[1] + v[2] * v[2] + v[3] * v[3];
      ss += shfl_xor_f(ss, 16); ss += shfl_xor_f(ss, 32);
      if (fq == 0) PSS[(size_t)(row - TP) * 64 + ntl] = ss;
    }
  }
}

__device__ __forceinline__ void phaseF(const Params& p, const int wv, const int rep) {
  const int wid = wv, wr = wid >> 2, wc = wid & 3;
  char* ws = p.ws;
  const u16* H2B = (const u16*)(ws + OFF_H2B);
  const u16* WUP = (const u16*)(ws + OFF_WUP);
  u16* ACT = (u16*)(ws + OFF_ACT);
  const float* PS = (const float*)(ws + OFF_PS);
  const float* PSS = (const float*)(ws + OFF_PSS);
  {
    float* rs_l = (float*)(g_shm + 131072);
    auto fill_rs = [&](int t, int buf) {
      const int tid = wv * 64 + lane_fresh();
      if (tid < 256) {
        const float* ps = PS + (size_t)((t & 63) * 256 + tid) * 16;
        f32x4 a = *(const f32x4*)ps + *(const f32x4*)(ps + 4) + *(const f32x4*)(ps + 8) + *(const f32x4*)(ps + 12);
        rs_l[buf * 256 + tid] = rsqrtf((a[0] + a[1] + a[2] + a[3]) * (1.f / 1024.f) + EPS);
      }
    };
    int t_ = blockIdx.x, it = 0;
    const int tend = 1024 * rep;
    Acc acc;
    if (t_ < tend) {
      const int t = t_ & 1023;
      fill_rs(t, 0);
      kloop_t<1, true>(H2B + (size_t)((t & 63) * 256) * 1024, 1024, WUP + (size_t)((t >> 6) * 256) * 1024, 1024, 1024, acc, wv);
    }
    while (t_ < tend) {
      const int t = t_ & 1023;
      const int pm = t & 63, pn = t >> 6, brow = pm * 256, bcol = pn * 256;
      ACC_ZERO(acc);
      kloop_t<2>(H2B + (size_t)brow * 1024, 1024, WUP + (size_t)bcol * 1024, 1024, 1024, acc, wv);
      t_ += gridDim.x;
      if (t_ < tend) {
        const int tn = t_ & 1023;
        fill_rs(tn, (it + 1) & 1);
        kloop_t<1, false>(H2B + (size_t)((tn & 63) * 256) * 1024, 1024, WUP + (size_t)((tn >> 6) * 256) * 1024, 1024, 1024, acc, wv);
      }
      const float* rs_c = rs_l + (it & 1) * 256;
      ACC_FOREACH_PAIR({
        const float rstd = rs_c[rrow];
        f32x4 o0 = v0 * rstd, o1 = v1 * rstd;
        o0[0] = fmaxf(o0[0], 0.f); o0[1] = fmaxf(o0[1], 0.f); o0[2] = fmaxf(o0[2], 0.f); o0[3] = fmaxf(o0[3], 0.f);
        o1[0] = fmaxf(o1[0], 0.f); o1[1] = fmaxf(o1[1], 0.f); o1[2] = fmaxf(o1[2], 0.f); o1[3] = fmaxf(o1[3], 0.f);
        o0 = o0 * o0; o1 = o1 * o1;
        store_pair16(ACT + (size_t)(brow + rrow) * 4096 + bcol + cb32, pack4(o0), pack4(o1), fq);
      });
      ++it;
    }
  }
  for (int gb = blockIdx.x; gb < 256; gb += gridDim.x) {
    const int task0 = gb * 8, mt = task0 >> 8, nt0 = task0 & 255;
    const u16* Ab = H2B + (size_t)(TP + mt * 16) * 1024;
    skgemm<8>([&](int) { return Ab; }, [&](int i) { return WUP + (size_t)((nt0 + i) * 16) * 1024; }, [&](int) { return 1024; }, 128, wv);
    {
      const int lane_e = lane_fresh(), fr = lane_e & 15, fq = lane_e >> 4;
      const int ntl = nt0 + wv, row = TP + mt * 16 + fr, col = ntl * 16 + fq * 4;
      const float* ps = PSS + (size_t)(row - TP) * 64 + fq * 16;
      f32x4 a4 = *(const f32x4*)ps + *(const f32x4*)(ps + 4) + *(const f32x4*)(ps + 8) + *(const f32x4*)(ps + 12);
      float sq = a4[0] + a4[1] + a4[2] + a4[3];
      sq += shfl_xor_f(sq, 16); sq += shfl_xor_f(sq, 32);
      const float rstd = rsqrtf(sq * (1.f / 1024.f) + EPS);
      f32x4 v = skreduce(wv) * rstd;
#pragma unroll
      for (int e = 0; e < 4; ++e) { float r = fmaxf(v[e], 0.f); v[e] = r * r; }
      *(u32x2*)(ACT + (size_t)row * 4096 + col) = pack4(v);
    }
  }
}

__device__ __forceinline__ void phaseG(const Params& p, const int wv, const int rep, unsigned* bar, const bool fused) {
  const int wid = wv, wr = wid >> 2, wc = wid & 3;
  char* ws = p.ws;
  const u16* ACT = (const u16*)(ws + OFF_ACT);
  const u16* WDN = (const u16*)(ws + OFF_WDN);
  const u16* H2 = (const u16*)(ws + OFF_H2B);
  unsigned* CNT = bar + 4096;
  unsigned* CNTS = bar + 4096 + 1024;
  float* XS = (float*)(ws + OFF_PS);
  float* XSS = (float*)(ws + OFF_PSS);
  const float* wfin = p.in[29];
  for (int t_ = blockIdx.x; t_ < 256 * rep; t_ += gridDim.x) {
    const int t = t_ & 255;
    const int pm = t & 63, pn = t >> 6, brow = pm * 256, bcol = pn * 256;
    Acc acc; ACC_ZERO(acc);
    kloop(ACT + (size_t)brow * 4096, 4096, WDN + (size_t)bcol * 4096, 4096, 4096, acc, wv);
    if (!fused) {
      ACC_FOREACH({
        const size_t o = (size_t)(brow + rrow) * 1024 + bcol + rcol;
        *(f32x4*)(p.out + O_Y + o) = v + unpack4(*(const u32x2*)(H2 + o));
      });
    } else {
      float* red = (float*)g_shm;
      float* rstd_l = red + 1024;
      {
        const int lane_e = lane_fresh(), fr = lane_e & 15, fq = lane_e >> 4;
#pragma unroll
        for (int ai = 0; ai < 2; ++ai)
#pragma unroll
          for (int m = 0; m < 4; ++m) {
            const int rrow = ai * 128 + wr * 64 + m * 16 + fr;
            float ss = 0.f;
#pragma unroll
            for (int bj = 0; bj < 2; ++bj)
#pragma unroll
              for (int n = 0; n < 2; ++n) {
                const int rcol = bj * 128 + wc * 32 + n * 16 + fq * 4;
                f32x4 v = acc[ai][bj][m][n] + unpack4(*(const u32x2*)(H2 + (size_t)(brow + rrow) * 1024 + bcol + rcol));
                acc[ai][bj][m][n] = v;
                ss += v[0] * v[0] + v[1] * v[1] + v[2] * v[2] + v[3] * v[3];
              }
            ss += shfl_xor_f(ss, 16); ss += shfl_xor_f(ss, 32);
            if (fq == 0) red[rrow * 4 + wc] = ss;
          }
      }
      __syncthreads();
      {
        const int tid = wv * 64 + lane_fresh();
        if (tid < 256) {
          f32x4 r4 = *(const f32x4*)(red + tid * 4);
          __hip_atomic_store(XS + (size_t)(brow + tid) * 4 + pn, r4[0] + r4[1] + r4[2] + r4[3], __ATOMIC_RELAXED, __HIP_MEMORY_SCOPE_AGENT);
        }
        asm volatile("s_waitcnt vmcnt(0)" ::: "memory");
        __syncthreads();
        if (tid == 0) {
          (void)xb_add(&CNT[pm * 16], 1u);
          XB_SPIN(xb_ld(&CNT[pm * 16]) < 4u, bar);
        }
        __syncthreads();
        if (tid < 256) {
          float sq = 0.f;
#pragma unroll
          for (int q = 0; q < 4; ++q) sq += __hip_atomic_load(XS + (size_t)(brow + tid) * 4 + q, __ATOMIC_RELAXED, __HIP_MEMORY_SCOPE_AGENT);
          rstd_l[tid] = rsqrtf(sq * (1.f / 1024.f) + EPS);
        }
        __syncthreads();
      }
      ACC_FOREACH({
        const float rs = rstd_l[rrow];
        const f32x4 wv4 = *(const f32x4*)(wfin + bcol + rcol);
        *(f32x4*)(p.out + O_Y + (size_t)(brow + rrow) * 1024 + bcol + rcol) = v * rs * wv4;
      });
    }
  }
  for (int gb = blockIdx.x; gb < 256; gb += gridDim.x) {
    const int task0 = gb * 2, mt = task0 >> 6, nt0 = task0 & 63;
    const u16* Ab = ACT + (size_t)(TP + mt * 16) * 4096;
    skgemm<2>([&](int) { return Ab; }, [&](int i) { return WDN + (size_t)((nt0 + i) * 16) * 4096; }, [&](int) { return 4096; }, 512, wv);
    if (!fused) {
      if (wv < 2) {
        const int lane_e = lane_fresh(), fr = lane_e & 15, fq = lane_e >> 4;
        const int row = TP + mt * 16 + fr, col = (nt0 + wv) * 16 + fq * 4;
        const size_t o = (size_t)row * 1024 + col;
        *(f32x4*)(p.out + O_Y + o) = skreduce(wv) + unpack4(*(const u32x2*)(H2 + o));
      }
    } else {
      unsigned* last_l = (unsigned*)g_shm + 8192;
      if (wv < 2) {
        const int lane_e = lane_fresh(), fr = lane_e & 15, fq = lane_e >> 4;
        const int row = TP + mt * 16 + fr, col = (nt0 + wv) * 16 + fq * 4;
        const size_t o = (size_t)row * 1024 + col;
        f32x4 v = skreduce(wv) + unpack4(*(const u32x2*)(H2 + o));
        float* yo = p.out + O_Y + o;
#pragma unroll
        for (int e = 0; e < 4; ++e) __hip_atomic_store(yo + e, v[e], __ATOMIC_RELAXED, __HIP_MEMORY_SCOPE_AGENT);
        float ss = v[0] * v[0] + v[1] * v[1] + v[2] * v[2] + v[3] * v[3];
        ss += shfl_xor_f(ss, 16); ss += shfl_xor_f(ss, 32);
        if (fq == 0) __hip_atomic_store(XSS + (size_t)(row - TP) * 64 + nt0 + wv, ss, __ATOMIC_RELAXED, __HIP_MEMORY_SCOPE_AGENT);
      }
      asm volatile("s_waitcnt vmcnt(0)" ::: "memory");
      __syncthreads();
      const int tid = wv * 64 + lane_fresh();
      if (tid == 0) last_l[0] = (xb_add(&CNTS[mt * 16], 1u) == 31u) ? 1u : 0u;
      __syncthreads();
      if (last_l[0]) {
        __builtin_amdgcn_fence(__ATOMIC_ACQUIRE, "agent");
        const int r = tid >> 5, c32 = tid & 31;
        float* yrow = p.out + O_Y + (size_t)(TP + mt * 16 + r) * 1024;
        float sq = __hip_atomic_load(XSS + (size_t)(mt * 16 + r) * 64 + c32 * 2, __ATOMIC_RELAXED, __HIP_MEMORY_SCOPE_AGENT)
                 + __hip_atomic_load(XSS + (size_t)(mt * 16 + r) * 64 + c32 * 2 + 1, __ATOMIC_RELAXED, __HIP_MEMORY_SCOPE_AGENT);
        sq += shfl_xor_f(sq, 16); sq += shfl_xor_f(sq, 8); sq += shfl_xor_f(sq, 4); sq += shfl_xor_f(sq, 2); sq += shfl_xor_f(sq, 1);
        const float rs = rsqrtf(sq * (1.f / 1024.f) + EPS);
#pragma unroll
        for (int i = 0; i < 8; ++i) {
          const int col = i * 128 + c32 * 4;
          f32x4 v = *(const f32x4*)(yrow + col);
          *(f32x4*)(yrow + col) = v * rs * *(const f32x4*)(wfin + col);
        }
      }
    }
  }
}

__device__ __forceinline__ void phaseH(const Params& p, const int wv, const int rep) {
  const int wid = wv, lane = lane_fresh();
  const int gw = blockIdx.x * 8 + wid, nw = gridDim.x * 8;
  const float* w = p.in[29];
  for (int r_ = gw; r_ < T * rep; r_ += nw) {
    const int r = r_ >= T ? r_ - T : r_;
    float* x = p.out + O_Y + (size_t)r * 1024;
    f32x4 v[4]; float ss = 0.f;
#pragma unroll
    for (int i = 0; i < 4; ++i) { v[i] = *(const f32x4*)(x + (i * 64 + lane) * 4); ss += v[i][0] * v[i][0] + v[i][1] * v[i][1] + v[i][2] * v[i][2] + v[i][3] * v[i][3]; }
    ss = wave_sum(ss);
    const float rstd = rsqrtf(ss * (1.f / 1024.f) + EPS);
#pragma unroll
    for (int i = 0; i < 4; ++i) { f32x4 wv = *(const f32x4*)(w + (i * 64 + lane) * 4); *(f32x4*)(x + (i * 64 + lane) * 4) = v[i] * rstd * wv; }
  }
}

__global__ void __launch_bounds__(NTHREADS) fwd_megakernel(Params p) {
  cg::grid_group grid = cg::this_grid();
  const int wv = __builtin_amdgcn_readfirstlane(threadIdx.x >> 6);
#ifndef REP
#define REP 0
#endif
#define RB(bit) ({ int n_ = (REP & (1 << bit)) ? 2 : 1; asm volatile("" : "+s"(n_)); n_; })
  unsigned* bar = (unsigned*)(p.ws + OFF_BAR);
  if (wv == 0) { if (lane_fresh() == 0) { xb_words = make_uint4(0u, 0u, 0u, 0u); (void)xb_add(&bar[XB_XCNT(xb_xcc_id())], 1u); } }
  __syncthreads();
  phaseA(p, wv, RB(0));
  if (p.ws == nullptr) grid.sync();
  xcd_barrier(bar, wv);
  phaseB(p, wv, RB(1));
  xcd_barrier(bar, wv);
  phaseC(p, wv, RB(8), RB(9), RB(10), RB(11), RB(12), bar);
  xcd_barrier(bar, wv);
  phaseD(p, wv, RB(2));
  xcd_barrier(bar, wv);
  phaseE(p, wv, RB(3));
  xcd_barrier(bar, wv);
  phaseF(p, wv, RB(4));
  xcd_barrier(bar, wv);
  const bool fused = (gridDim.x == 256) && !(REP & 32);
  phaseG(p, wv, RB(5), bar, fused);
  if (!fused) {
    xcd_barrier(bar, wv);
    phaseH(p, wv, 1);
  }
  { int ns = (REP & 8192) ? 8 : 0; asm volatile("" : "+s"(ns)); for (int i = 0; i < ns; ++i) xcd_barrier(bar, wv); }
}

extern "C" void kernel_launch(void* const* d_in, const int* in_sizes, int n_in, void* d_out, int out_size, void* d_ws, size_t ws_size, hipStream_t stream) {
  static int grid_blocks = 0;
  if (!grid_blocks) {
    int dev = 0, cus = 0, per_cu = 0;
    (void)hipGetDevice(&dev);
    (void)hipDeviceGetAttribute(&cus, hipDeviceAttributeMultiprocessorCount, dev);
    (void)hipFuncSetAttribute((const void*)fwd_megakernel, hipFuncAttributeMaxDynamicSharedMemorySize, DYN_LDS);
    (void)hipOccupancyMaxActiveBlocksPerMultiprocessor(&per_cu, fwd_megakernel, NTHREADS, DYN_LDS);
    if (per_cu > 1) per_cu = 1;
    grid_blocks = cus * per_cu;
    if (grid_blocks > 256) grid_blocks = 256;
  }
  if (ws_size < WS_TOTAL || n_in < 30 || grid_blocks <= 0) { fprintf(stderr, "kernel_launch: bad config ws=%zu need=%zu grid=%d\n", ws_size, (size_t)WS_TOTAL, grid_blocks); return; }
  Params p{};
  for (int i = 0; i < 30; ++i) p.in[i] = (const float*)d_in[i];
  p.out = (float*)d_out;
  p.ws = (char*)d_ws;
  (void)hipMemsetAsync((char*)d_ws + OFF_BAR, 0, BAR_BYTES, stream);
  void* args[] = {&p};
  hipError_t e = hipLaunchCooperativeKernel((void*)fwd_megakernel, dim3(grid_blocks), dim3(NTHREADS), args, DYN_LDS, stream);
  if (e != hipSuccess) fprintf(stderr, "cooperative launch failed: %s (grid %d)\n", hipGetErrorString(e), grid_blocks);
}
```

```cpp
#include <hip/hip_runtime.h>
#include <hip/hip_cooperative_groups.h>
#include <cstdio>
namespace cg = cooperative_groups;

typedef unsigned short u16;
typedef short bf16x8 __attribute__((ext_vector_type(8)));
typedef float f32x4 __attribute__((ext_vector_type(4)));
typedef float f32x2 __attribute__((ext_vector_type(2)));
typedef unsigned u32x2 __attribute__((ext_vector_type(2)));
typedef unsigned u32x4 __attribute__((ext_vector_type(4)));

constexpr int TP = 16384, TS = 128, T = TP + TS;
constexpr float EPS = 1e-6f;
constexpr int NTHREADS = 512;
constexpr int DYN_LDS = 159744;

constexpr size_t OFF_WIN = 0;
constexpr size_t OFF_WKV = OFF_WIN + 14680064;
constexpr size_t OFF_WGM = OFF_WKV + 2097152;
constexpr size_t OFF_WSSD = OFF_WGM + 1048576;
constexpr size_t OFF_WXA = OFF_WSSD + 2097152;
constexpr size_t OFF_WOUT = OFF_WXA + 1048576;
constexpr size_t OFF_WUP = OFF_WOUT + 2097152;
constexpr size_t OFF_WDN = OFF_WUP + 8388608;
constexpr size_t OFF_WSB = OFF_WDN + 8388608;
constexpr size_t OFF_MN = OFF_WSB + 131072;
constexpr size_t OFF_KP = OFF_MN + 4194304;
constexpr size_t OFF_VT = OFF_KP + 2097152;
constexpr size_t OFF_DT = OFF_VT + 2097152;
constexpr size_t OFF_YPS = OFF_DT + 1056768;
constexpr size_t OFF_PS = OFF_YPS + 2113536;
constexpr size_t OFF_PSS = OFF_PS + 1048576;
constexpr size_t OFF_R1 = OFF_PSS + 32768;
constexpr size_t SZ_1024B = (size_t)T * 1024 * 2;
constexpr size_t OFF_UV = OFF_R1;
constexpr size_t OFF_ZS = OFF_R1 + SZ_1024B;
constexpr size_t OFF_XBC = OFF_R1 + 2 * SZ_1024B;
constexpr size_t OFF_MERGED = OFF_R1;
constexpr size_t OFF_ACT = OFF_R1;
constexpr size_t OFF_R2 = OFF_R1 + (size_t)T * 4096 * 2;
constexpr size_t OFF_GATE = OFF_R2;
constexpr size_t OFF_H2 = OFF_R2;
constexpr size_t OFF_H2B = OFF_R2 + (size_t)T * 1024 * 4;
constexpr size_t OFF_XA = OFF_R2 + (size_t)T * 3072 * 2;
constexpr size_t OFF_WDT = OFF_XA + (size_t)T * 512 * 2;
constexpr size_t OFF_BAR = OFF_WDT + 32768;
constexpr size_t BAR_BYTES = 32768;
constexpr size_t WS_TOTAL = OFF_BAR + BAR_BYTES;
constexpr size_t OOFF_XN = 0;
constexpr size_t OOFF_Q = SZ_1024B;
constexpr size_t OOFF_GM = SZ_1024B + (size_t)T * 512 * 2;
constexpr size_t O_Y = 0, O_MEMK = 16908288, O_MEMV = 17956864, O_CONVP = 19005440, O_SSMP = 19042304,
                 O_CONVS = 20090880, O_SSMS = 20680704, O_GMV = 37457920;

struct Params { const float* in[30]; float* out; char* ws; };

extern __shared__ __attribute__((aligned(16))) char g_shm[];

typedef __bf16 bf16x2_t __attribute__((ext_vector_type(2)));
__device__ __forceinline__ unsigned cvt_pk(float lo, float hi) { f32x2 v = {lo, hi}; bf16x2_t b = __builtin_convertvector(v, bf16x2_t); return __builtin_bit_cast(unsigned, b); }
__device__ __forceinline__ u32x2 pack4(f32x4 v) { u32x2 r; r.x = cvt_pk(v[0], v[1]); r.y = cvt_pk(v[2], v[3]); return r; }
__device__ __forceinline__ u16 f2bf(float f) { return (u16)(cvt_pk(f, 0.f) & 0xffffu); }
__device__ __forceinline__ float bf2f(u16 h) { return __uint_as_float(((unsigned)h) << 16); }
__device__ __forceinline__ float bflo(unsigned w) { return __uint_as_float(w << 16); }
__device__ __forceinline__ float bfhi(unsigned w) { return __uint_as_float(w & 0xffff0000u); }
__device__ __forceinline__ f32x4 unpack4(u32x2 w) { return (f32x4){bflo(w.x), bfhi(w.x), bflo(w.y), bfhi(w.y)}; }
__device__ __forceinline__ float silu_f(float x) { return x * __builtin_amdgcn_rcpf(1.f + __builtin_amdgcn_exp2f(-1.4426950409f * x)); }
__device__ __forceinline__ float sigm_f(float x) { return __builtin_amdgcn_rcpf(1.f + __builtin_amdgcn_exp2f(-1.4426950409f * x)); }
__device__ __forceinline__ float gelu_f(float v) {
  const float av = fabsf(v), t = __builtin_amdgcn_rcpf(av * 0.2316418882f + 1.0f);
  float q = t * 0.5307027145f + (-0.7265760135f); q = q * t + 0.7107068705f; q = q * t + (-0.142248368f); q = q * t + 0.127414796f; q = q * t;
  const float e = __builtin_amdgcn_exp2f((v * v) * (-0.72134752044f));
  const float m = v * (q * e), r = v - m;
  return v < 0.f ? m : r;
}
__device__ __forceinline__ float softplus_f(float x) { return fmaxf(x, 0.f) + log1pf(__expf(-fabsf(x))); }
__device__ __forceinline__ int lane_fresh() { int l; asm volatile("v_mbcnt_lo_u32_b32 %0, -1, 0\n\tv_mbcnt_hi_u32_b32 %0, -1, %0" : "=v"(l)); return l; }
__device__ __forceinline__ float shfl_xor_f(float v, int mask) { const int l = lane_fresh(); return __int_as_float(__builtin_amdgcn_ds_bpermute((l ^ mask) << 2, __float_as_int(v))); }
__device__ __forceinline__ float shfl_idx_f(float v, int src) { return __int_as_float(__builtin_amdgcn_ds_bpermute(src << 2, __float_as_int(v))); }
__device__ __forceinline__ float wave_sum(float v) {
#pragma unroll
  for (int o = 32; o >= 1; o >>= 1) v += shfl_xor_f(v, o);
  return v;
}
__device__ __forceinline__ float wave_max(float v) {
#pragma unroll
  for (int o = 32; o >= 1; o >>= 1) v = fmaxf(v, shfl_xor_f(v, o));
  return v;
}
#define MFMA16(a, b, c) __builtin_amdgcn_mfma_f32_16x16x32_bf16((a), (b), (c), 0, 0, 0)


#define XB_TMO      128
#define XB_XCNT(j)  (256  + 64 * (j))
#define XB_XSUB(j)  (1280 + 64 * (j))
#define XB_XGEN(j)  (2304 + 64 * (j))
#define XB_TOP      3328
#define XB_TOPGEN   3392
#define XB_SPIN_CAP (1u << 20)
#define LAS __attribute__((address_space(3)))
__device__ __forceinline__ unsigned xb_ld(unsigned* p) { return __hip_atomic_load(p, __ATOMIC_RELAXED, __HIP_MEMORY_SCOPE_AGENT); }
__device__ __forceinline__ unsigned xb_add(unsigned* p, unsigned v) { return __hip_atomic_fetch_add(p, v, __ATOMIC_RELAXED, __HIP_MEMORY_SCOPE_AGENT); }
__device__ __forceinline__ unsigned xb_xcc_id() { return (unsigned)__builtin_amdgcn_s_getreg((3 << 11) | 20) & 0xFu; }
#define XB_SPIN(cond, bar) do { unsigned _sp = 0; while (cond) { __builtin_amdgcn_s_sleep(1); \
    if ((++_sp & 255u) == 0u) { if (xb_ld(&(bar)[XB_TMO])) break; if (_sp > XB_SPIN_CAP) { atomicAdd(&(bar)[XB_TMO], 1u); break; } } } } while (0)
__shared__ uint4 xb_words;
__device__ __forceinline__ void xcd_barrier_complete(unsigned* bar, unsigned x, unsigned& nloc, unsigned& nx) {
  const unsigned G = gridDim.x;
  unsigned sum, cnt, mine, sp = 0u;
  for (;;) {
    sum = 0u; cnt = 0u; mine = 0u;
#pragma unroll
    for (unsigned j = 0; j < 16; ++j) { const unsigned c = xb_ld(&bar[XB_XCNT(j)]); sum += c; cnt += (c > 0u) ? 1u : 0u; mine = (j == x) ? c : mine; }
    if (sum == G) break;
    __builtin_amdgcn_s_sleep(1);
    if ((++sp & 255u) == 0u) { if (xb_ld(&bar[XB_TMO])) break; if (sp > XB_SPIN_CAP) { atomicAdd(&bar[XB_TMO], 1u); break; } }
  }
  nloc = mine > 0u ? mine : 1u; nx = cnt > 0u ? cnt : 1u;
}
__device__ __forceinline__ void xcd_barrier(unsigned* bar, const int wv) {
  asm volatile("s_waitcnt vmcnt(0)" ::: "memory");
  __syncthreads();
  if (wv == 0) {
    if (lane_fresh() == 0) {
      volatile LAS unsigned* st = (volatile LAS unsigned*)&xb_words;
      const unsigned x = xb_xcc_id();
      __builtin_amdgcn_s_waitcnt(0);
      unsigned nloc = st[0], nx = st[1];
      if (nloc == 0u) { xcd_barrier_complete(bar, x, nloc, nx); st[0] = nloc; st[1] = nx; }
      const unsigned old = xb_add(&bar[XB_XSUB(x)], 1u);
      const unsigned gen = old / nloc;
      if (old + 1u == (gen + 1u) * nloc) {
        __builtin_amdgcn_fence(__ATOMIC_RELEASE, "agent");
        asm volatile("s_waitcnt vmcnt(0)" ::: "memory");
        const unsigned og = xb_add(&bar[XB_TOP], 1u);
        const unsigned tg = og / nx;
        if (og + 1u == (tg + 1u) * nx) xb_add(&bar[XB_TOPGEN], 1u);
        else XB_SPIN(xb_ld(&bar[XB_TOPGEN]) == tg, bar);
        __builtin_amdgcn_fence(__ATOMIC_ACQUIRE, "agent");
        xb_add(&bar[XB_XGEN(x)], 1u);
        asm volatile("s_waitcnt vmcnt(0)" ::: "memory");
      } else {
        XB_SPIN(xb_ld(&bar[XB_XGEN(x)]) == gen, bar);
        __builtin_amdgcn_fence(__ATOMIC_ACQUIRE, "agent");
        asm volatile("s_waitcnt vmcnt(0)" ::: "memory");
      }
    }
  }
  __syncthreads();
}

constexpr int BM = 256, BK = 64, HALF = 128, HT = HALF * BK;
__device__ __forceinline__ int lds_byte(int r, int c) { int st = (r >> 4) * 2 + (c >> 5), rr = r & 15, cc = c & 31, ob = rr * 64 + cc * 2; return st * 1024 + (ob ^ (((ob >> 9) & 1) << 5)); }
__device__ __forceinline__ void stage_rc(int b, int& R, int& C) { int st = b / 1024, sb = b % 1024, swz = sb ^ (((sb >> 9) & 1) << 5); R = (st >> 1) * 16 + swz / 64; C = (st & 1) * 32 + (swz % 64) / 2; }

typedef f32x4 Acc[2][2][4][2];

template <int PART  , bool SYNC_FIRST = true>
__device__ __forceinline__ void kloop_t(const u16* __restrict__ A, int lda, const u16* __restrict__ Bt, int ldb, int K, Acc& acc, const int wv) {
  u16* shm = (u16*)g_shm;
#define SA(b, h) (shm + ((b) * 2 + (h)) * HT)
#define SB(b, h) (shm + (4 + (b) * 2 + (h)) * HT)
#define STAGE(P_, BASE, LD, br, kt) do { const u16* _gb = (BASE) + ((br) * (LD) + (kt) * BK); \
    unsigned _o0 = ((&(BASE) == &A) ? oA0 : oB0), _o1 = ((&(BASE) == &A) ? oA1 : oB1); asm volatile("" : "+v"(_o0), "+v"(_o1)); \
    __builtin_amdgcn_global_load_lds((const unsigned*)((const char*)_gb + _o0), (unsigned*)((char*)(P_) + ktid * 16), 16, 0, 0); \
    __builtin_amdgcn_global_load_lds((const unsigned*)((const char*)_gb + _o1), (unsigned*)((char*)(P_) + ktid * 16 + 8192), 16, 0, 0); } while (0)
#define LDA(dst, b, h) for (int m = 0; m < 4; ++m) for (int k = 0; k < 2; ++k) \
    dst[m][k] = *reinterpret_cast<const bf16x8*>((char*)SA(b, h) + lds_byte(wr * 64 + m * 16 + fr, k * 32 + fq * 8))
#define LDB(dst, b, h) for (int n = 0; n < 2; ++n) for (int k = 0; k < 2; ++k) \
    dst[n][k] = *reinterpret_cast<const bf16x8*>((char*)SB(b, h) + lds_byte(wc * 32 + n * 16 + fr, k * 32 + fq * 8))
#define MMA(ai, bj, At_, Bt_) do { __builtin_amdgcn_s_setprio(1); \
    for (int m = 0; m < 4; ++m) for (int n = 0; n < 2; ++n) for (int k = 0; k < 2; ++k) \
      acc[ai][bj][m][n] = MFMA16(Bt_[n][k], At_[m][k], acc[ai][bj][m][n]); \
    __builtin_amdgcn_s_setprio(0); } while (0)
#define WAIT_V(n) asm volatile("s_waitcnt vmcnt(" #n ")" ::: "memory")
#define WAIT_L(n) asm volatile("s_waitcnt lgkmcnt(" #n ")" ::: "memory")
#define BAR __builtin_amdgcn_s_barrier()
#define SCHED __builtin_amdgcn_sched_barrier(0)
  const int wid = wv, lane = lane_fresh(), ktid = wv * 64 + lane, wr = wid >> 2, wc = wid & 3, fr = lane & 15, fq = lane >> 4;
  bf16x8 At[4][2], B0[2][2], B1[2][2];
  const int nt = K / BK;
  unsigned oA0, oA1, oB0, oB1;
  { int r_, c_; stage_rc(ktid * 16, r_, c_); oA0 = (unsigned)(r_ * lda + c_) * 2u; oB0 = (unsigned)(r_ * ldb + c_) * 2u;
    stage_rc(ktid * 16 + 8192, r_, c_); oA1 = (unsigned)(r_ * lda + c_) * 2u; oB1 = (unsigned)(r_ * ldb + c_) * 2u; }
  if (PART != 2) {
    if (SYNC_FIRST) { WAIT_V(0); WAIT_L(0); __syncthreads(); }
    STAGE(SB(0, 0), Bt, ldb, 0, 0); STAGE(SA(0, 0), A, lda, 0, 0);
    STAGE(SB(0, 1), Bt, ldb, HALF, 0); STAGE(SA(0, 1), A, lda, HALF, 0);
  }
  if (PART == 1) return;
  if (wr == 1) BAR;
  WAIT_V(4); BAR;
  STAGE(SB(1, 0), Bt, ldb, 0, 1); STAGE(SA(1, 0), A, lda, 0, 1); STAGE(SB(1, 1), Bt, ldb, HALF, 1);
  WAIT_V(6); BAR;
#pragma unroll 1
  for (int t = 0; t < nt - 2; t += 2) {
    LDB(B0, 0, 0); SCHED; LDA(At, 0, 0); STAGE(SA(1, 1), A, lda, HALF, t + 1);
    WAIT_L(8); BAR; WAIT_L(0); MMA(0, 0, At, B0); BAR; SCHED;
    LDB(B1, 0, 1); STAGE(SB(0, 0), Bt, ldb, 0, t + 2);
    BAR; WAIT_L(0); MMA(0, 1, At, B1); BAR;
    LDA(At, 0, 1); STAGE(SA(0, 0), A, lda, 0, t + 2);
    BAR; WAIT_L(0); MMA(1, 0, At, B0); BAR; SCHED;
    STAGE(SB(0, 1), Bt, ldb, HALF, t + 2);
    WAIT_V(6); BAR; MMA(1, 1, At, B1); BAR;
    LDB(B0, 1, 0); SCHED; LDA(At, 1, 0); STAGE(SA(0, 1), A, lda, HALF, t + 2);
    WAIT_L(8); BAR; WAIT_L(0); MMA(0, 0, At, B0); BAR; SCHED;
    LDB(B1, 1, 1); STAGE(SB(1, 0), Bt, ldb, 0, t + 3);
    BAR; WAIT_L(0); MMA(0, 1, At, B1); BAR;
    LDA(At, 1, 1); STAGE(SA(1, 0), A, lda, 0, t + 3);
    BAR; WAIT_L(0); MMA(1, 0, At, B0); BAR; SCHED;
    STAGE(SB(1, 1), Bt, ldb, HALF, t + 3);
    WAIT_V(6); BAR; MMA(1, 1, At, B1); BAR;
  }
  { LDB(B0, 0, 0); LDA(At, 0, 0); STAGE(SA(1, 1), A, lda, HALF, nt - 1);
    BAR; WAIT_L(0); MMA(0, 0, At, B0); BAR;
    LDB(B1, 0, 1); BAR; WAIT_L(0); MMA(0, 1, At, B1); BAR;
    LDA(At, 0, 1); WAIT_V(4); BAR; WAIT_L(0); MMA(1, 0, At, B0); MMA(1, 1, At, B1); BAR; }
  { LDB(B0, 1, 0); LDA(At, 1, 0); WAIT_V(2); BAR; WAIT_L(0); MMA(0, 0, At, B0); BAR;
    LDB(B1, 1, 1); WAIT_V(0); BAR; WAIT_L(0); MMA(0, 1, At, B1); BAR;
    LDA(At, 1, 1); BAR; WAIT_L(0); MMA(1, 0, At, B0); MMA(1, 1, At, B1); BAR; }
  if (wr == 0) BAR;
  SCHED;
}

__device__ __forceinline__ void kloop(const u16* __restrict__ A, int lda, const u16* __restrict__ Bt, int ldb, int K, Acc& acc, const int wv) { kloop_t<0>(A, lda, Bt, ldb, K, acc, wv); }

#define ACC_ZERO(acc) do { _Pragma("unroll") for (int ai = 0; ai < 2; ++ai) _Pragma("unroll") for (int bj = 0; bj < 2; ++bj) \
  _Pragma("unroll") for (int m = 0; m < 4; ++m) _Pragma("unroll") for (int n = 0; n < 2; ++n) acc[ai][bj][m][n] = (f32x4){0.f, 0.f, 0.f, 0.f}; } while (0)
#define ACC_FOREACH(...) do { const int lane_e = lane_fresh(), fr = lane_e & 15, fq = lane_e >> 4; (void)fr; (void)fq; _Pragma("unroll") for (int ai = 0; ai < 2; ++ai) _Pragma("unroll") for (int m = 0; m < 4; ++m) { \
  const int rrow = ai * 128 + wr * 64 + m * 16 + fr; (void)rrow; \
  _Pragma("unroll") for (int bj = 0; bj < 2; ++bj) _Pragma("unroll") for (int n = 0; n < 2; ++n) { \
    const int rcol = bj * 128 + wc * 32 + n * 16 + fq * 4; (void)rcol; f32x4& v = acc[ai][bj][m][n]; __VA_ARGS__ } } } while (0)
#define ACC_FOREACH_SB(...) do { __builtin_amdgcn_sched_barrier(0); const int lane_e = lane_fresh(), fr = lane_e & 15, fq = lane_e >> 4; (void)fr; (void)fq; _Pragma("unroll") for (int ai = 0; ai < 2; ++ai) _Pragma("unroll") for (int m = 0; m < 4; ++m) { \
  const int rrow = ai * 128 + wr * 64 + m * 16 + fr; (void)rrow; \
  _Pragma("unroll") for (int bj = 0; bj < 2; ++bj) _Pragma("unroll") for (int n = 0; n < 2; ++n) { \
    const int rcol = bj * 128 + wc * 32 + n * 16 + fq * 4; (void)rcol; f32x4& v = acc[ai][bj][m][n]; __VA_ARGS__ } __builtin_amdgcn_sched_barrier(0); } } while (0)

__device__ __forceinline__ void store_pair16(u16* rowp32, u32x2 a, u32x2 b, int fq) {
  auto rx = __builtin_amdgcn_permlane16_swap(a.x, b.x, false, false);
  auto ry = __builtin_amdgcn_permlane16_swap(a.y, b.y, false, false);
  u32x4 w = {rx[0], ry[0], rx[1], ry[1]};
  *(u32x4*)(rowp32 + ((fq & 1) * 16 + (fq >> 1) * 8)) = w;
}
__device__ __forceinline__ void load_pair16(const u16* rowp32, int fq, u32x2& a, u32x2& b) {
  const u32x4 w = *(const u32x4*)(rowp32 + ((fq & 1) * 16 + (fq >> 1) * 8));
  auto rx = __builtin_amdgcn_permlane16_swap(w.x, w.z, false, false);
  auto ry = __builtin_amdgcn_permlane16_swap(w.y, w.w, false, false);
  a = (u32x2){rx[0], ry[0]}; b = (u32x2){rx[1], ry[1]};
}
__device__ __forceinline__ void unpair16(u32x4 w, u32x2& a, u32x2& b) {
  auto rx = __builtin_amdgcn_permlane16_swap(w.x, w.z, false, false);
  auto ry = __builtin_amdgcn_permlane16_swap(w.y, w.w, false, false);
  a = (u32x2){rx[0], ry[0]}; b = (u32x2){rx[1], ry[1]};
}
#define ACC_FOREACH_PAIR(...) do { const int lane_e = lane_fresh(), fr = lane_e & 15, fq = lane_e >> 4; (void)fr; (void)fq; \
  _Pragma("unroll") for (int ai = 0; ai < 2; ++ai) _Pragma("unroll") for (int m = 0; m < 4; ++m) { \
  const int rrow = ai * 128 + wr * 64 + m * 16 + fr; (void)rrow; \
  _Pragma("unroll") for (int bj = 0; bj < 2; ++bj) { const int cb32 = bj * 128 + wc * 32; (void)cb32; \
    f32x4& v0 = acc[ai][bj][m][0]; f32x4& v1 = acc[ai][bj][m][1]; __VA_ARGS__ } } } while (0)

__device__ __forceinline__ f32x4 wave_gemm16(const u16* __restrict__ A, int lda, const u16* __restrict__ Bt, int ldb, int K, f32x4 acc) {
  const int lane = lane_fresh(), fr = lane & 15, fq = lane >> 4;
  const u16* ap = A + (size_t)fr * lda + fq * 8;
  const u16* bp = Bt + (size_t)fr * ldb + fq * 8;
#pragma unroll 4
  for (int k = 0; k < K; k += 32) {
    bf16x8 a = *(const bf16x8*)(ap + k);
    bf16x8 b = *(const bf16x8*)(bp + k);
    acc = MFMA16(b, a, acc);
  }
  return acc;
}


template <int NT, class FA, class FB, class FL>
__device__ __forceinline__ void skgemm(FA aptr, FB bptr, FL ldf, const int KS, const int wv) {
  float* part = (float*)g_shm;
  const int lane = lane_fresh(), fr = lane & 15, fq = lane >> 4;
  __syncthreads();
#pragma unroll
  for (int i = 0; i < NT; ++i) {
    f32x4 acc = {0.f, 0.f, 0.f, 0.f};
    const int ld = ldf(i);
    const u16* ap = aptr(i) + (size_t)fr * ld + wv * KS + fq * 8;
    const u16* bp = bptr(i) + (size_t)fr * ld + wv * KS + fq * 8;
#pragma unroll 8
    for (int k = 0; k < KS; k += 32) acc = MFMA16(*(const bf16x8*)(bp + k), *(const bf16x8*)(ap + k), acc);
    *(f32x4*)(part + ((i * 8 + wv) * 64 + lane) * 4) = acc;
  }
  __syncthreads();
}
__device__ __forceinline__ f32x4 skreduce(int i) {
  const float* part = (const float*)g_shm;
  const int lane = lane_fresh();
  f32x4 s = {0.f, 0.f, 0.f, 0.f};
#pragma unroll
  for (int w = 0; w < 8; ++w) s += *(const f32x4*)(part + ((i * 8 + w) * 64 + lane) * 4);
  return s;
}

struct TJob { const float* src; const float* ks; u16* dst; int ldsrc, col0, k0, K, n0; };
__device__ __forceinline__ TJob tjob_decode(const Params& p, int i) {
  TJob j; char* ws = p.ws; j.ks = nullptr;
  if (i < 1792) { int kt = i & 15, ntl = i >> 4; j.src = p.in[8]; j.ldsrc = 7184; j.K = 1024; j.k0 = kt * 64; j.n0 = ntl * 64; j.col0 = j.n0 + (j.n0 >= 3584 ? 16 : 0); j.dst = (u16*)(ws + OFF_WIN); }
  else if ((i -= 1792) < 128) { int kt = i & 15, ntl = i >> 4; j.src = p.in[20]; j.ldsrc = 512; j.K = 1024; j.k0 = kt * 64; j.col0 = ntl * 64; j.n0 = (ntl >> 1) * 256 + (ntl & 1) * 64; j.dst = (u16*)(ws + OFF_WKV); }
  else if ((i -= 128) < 128) { int kt = i & 15, ntl = i >> 4; j.src = p.in[21]; j.ldsrc = 512; j.K = 1024; j.k0 = kt * 64; j.col0 = ntl * 64; j.n0 = (ntl >> 1) * 256 + 128 + (ntl & 1) * 64; j.dst = (u16*)(ws + OFF_WKV); }
  else if ((i -= 128) < 128) { int kt = i & 7, ntl = i >> 3; j.src = p.in[22]; j.ldsrc = 1024; j.K = 512; j.k0 = kt * 64; j.col0 = ntl * 64; j.n0 = j.col0; j.dst = (u16*)(ws + OFF_WGM); }
  else if ((i -= 128) < 256) { int kt = i & 15, ntl = i >> 4; j.src = p.in[23]; j.ldsrc = 1024; j.K = 1024; j.k0 = kt * 64; j.col0 = ntl * 64; j.n0 = j.col0; j.dst = (u16*)(ws + OFF_WSSD); j.ks = p.in[18]; }
  else if ((i -= 256) < 128) { int kt = i & 7, ntl = i >> 3; j.src = p.in[24]; j.ldsrc = 1024; j.K = 512; j.k0 = kt * 64; j.col0 = ntl * 64; j.n0 = j.col0; j.dst = (u16*)(ws + OFF_WXA); }
  else if ((i -= 128) < 256) { int kt = i & 15, ntl = i >> 4; j.src = p.in[25]; j.ldsrc = 1024; j.K = 1024; j.k0 = kt * 64; j.col0 = ntl * 64; j.n0 = j.col0; j.dst = (u16*)(ws + OFF_WOUT); }
  else if ((i -= 256) < 1024) { int kt = i & 15, ntl = i >> 4; j.src = p.in[27]; j.ldsrc = 4096; j.K = 1024; j.k0 = kt * 64; j.col0 = ntl * 64; j.n0 = j.col0; j.dst = (u16*)(ws + OFF_WUP); j.ks = p.in[26]; }
  else { i -= 1024; int kt = i & 63, ntl = i >> 6; j.src = p.in[28]; j.ldsrc = 1024; j.K = 4096; j.k0 = kt * 64; j.col0 = ntl * 64; j.n0 = j.col0; j.dst = (u16*)(ws + OFF_WDN); }
  return j;
}
__device__ __forceinline__ void ttile_load(const TJob& j, int tid, f32x4 (&v)[2]) {
#pragma unroll
  for (int i = 0; i < 2; ++i) {
    const int kk = (tid >> 4) + 32 * i, nn = (tid & 15) * 4;
    v[i] = *(const f32x4*)(j.src + (size_t)(j.k0 + kk) * j.ldsrc + j.col0 + nn);
    if (j.ks) v[i] = v[i] * j.ks[j.k0 + kk];
  }
}
__device__ __forceinline__ void ttile_store(const TJob& j, int tid, const f32x4 (&v)[2]) {
  float* tile = (float*)g_shm;
  __syncthreads();
#pragma unroll
  for (int i = 0; i < 2; ++i) {
    const int kk = (tid >> 4) + 32 * i, nn = (tid & 15) * 4;
    tile[kk * 65 + nn] = v[i][0]; tile[kk * 65 + nn + 1] = v[i][1]; tile[kk * 65 + nn + 2] = v[i][2]; tile[kk * 65 + nn + 3] = v[i][3];
  }
  __syncthreads();
  {
    const int nn = tid >> 3, k8 = (tid & 7) * 8;
    u32x4 w;
    w.x = cvt_pk(tile[(k8 + 0) * 65 + nn], tile[(k8 + 1) * 65 + nn]); w.y = cvt_pk(tile[(k8 + 2) * 65 + nn], tile[(k8 + 3) * 65 + nn]);
    w.z = cvt_pk(tile[(k8 + 4) * 65 + nn], tile[(k8 + 5) * 65 + nn]); w.w = cvt_pk(tile[(k8 + 6) * 65 + nn], tile[(k8 + 7) * 65 + nn]);
    *(u32x4*)(j.dst + (size_t)(j.n0 + nn) * j.K + j.k0 + k8) = w;
  }
}

__device__ __forceinline__ void phaseA(const Params& p, const int wv, const int rep) {
  const int lane = lane_fresh(), wid = wv, tid = wv * 64 + lane;
  char* ws = p.ws;
  {
    const int tend = 4864 * rep;
    int t_ = blockIdx.x;
    TJob job; f32x4 v[2];
    if (t_ < tend) { job = tjob_decode(p, t_ >= 4864 ? t_ - 4864 : t_); ttile_load(job, tid, v); }
    while (t_ < tend) {
      const int tn = t_ + gridDim.x;
      TJob jobn = job; f32x4 vn[2] = {v[0], v[1]};
      if (tn < tend) { jobn = tjob_decode(p, tn >= 4864 ? tn - 4864 : tn); ttile_load(jobn, tid, vn); }
      ttile_store(job, tid, v);
      job = jobn; v[0] = vn[0]; v[1] = vn[1]; t_ = tn;
    }
  }
  const int gw = blockIdx.x * 8 + wid, nw = gridDim.x * 8;
  u16* XN = (u16*)((char*)p.out + OOFF_XN);
  u16* MN = (u16*)(ws + OFF_MN);
  {
    const int rend = (T + 2048) * rep;
    auto rowsrc = [&](int r_) -> const float* {
      const int r = r_ >= T + 2048 ? r_ - (T + 2048) : r_;
      return r < TP ? p.in[0] + (size_t)r * 1024 : r < T ? p.in[1] + (size_t)(r - TP) * 1024 : p.in[2] + (size_t)(r - T) * 1024;
    };
    int r_ = gw;
    f32x4 v[4];
    if (r_ < rend) { const float* x = rowsrc(r_);
#pragma unroll
      for (int i = 0; i < 4; ++i) v[i] = *(const f32x4*)(x + (i * 64 + lane) * 4); }
    while (r_ < rend) {
      const int rn = r_ + nw;
      f32x4 vn[4] = {v[0], v[1], v[2], v[3]};
      if (rn < rend) { const float* x = rowsrc(rn);
#pragma unroll
        for (int i = 0; i < 4; ++i) vn[i] = *(const f32x4*)(x + (i * 64 + lane) * 4); }
      const int r = r_ >= T + 2048 ? r_ - (T + 2048) : r_;
      const float* w = r < T ? p.in[7] : p.in[19];
      u16* dst = r < T ? XN + (size_t)r * 1024 : MN + (size_t)(r - T) * 1024;
      float ss = 0.f;
#pragma unroll
      for (int i = 0; i < 4; ++i) ss += v[i][0] * v[i][0] + v[i][1] * v[i][1] + v[i][2] * v[i][2] + v[i][3] * v[i][3];
      ss = wave_sum(ss);
      const float rstd = rsqrtf(ss * (1.f / 1024.f) + EPS);
#pragma unroll
      for (int i = 0; i < 4; ++i) { f32x4 wv4 = *(const f32x4*)(w + (i * 64 + lane) * 4); *(u32x2*)(dst + (i * 64 + lane) * 4) = pack4(v[i] * rstd * wv4); }
#pragma unroll
      for (int i = 0; i < 4; ++i) v[i] = vn[i];
      r_ = rn;
    }
  }
  for (int i = blockIdx.x * NTHREADS + tid; i < 16384; i += gridDim.x * NTHREADS) {
    int k = i & 1023, hh = i >> 10;
    ((u16*)(ws + OFF_WDT))[i] = f2bf(p.in[8][(size_t)k * 7184 + 3584 + hh]);
  }
  u16* WSB = (u16*)(ws + OFF_WSB);
  for (int i = blockIdx.x * NTHREADS + tid; i < 65536; i += gridDim.x * NTHREADS) {
    int s = i & 127, tt = (i >> 7) & 127;
    WSB[i] = f2bf(s <= tt ? p.in[11][i] : 0.f);
  }
  for (int i = blockIdx.x * NTHREADS + tid; i < 128 * 3072; i += gridDim.x * NTHREADS) {
    int b = i / 3072, rem = i - b * 3072;
    p.out[O_CONVS + (size_t)b * 4608 + rem] = p.in[5][(size_t)b * 4608 + 1536 + rem];
  }
}

template <int SEC> __device__ __forceinline__ void epiB(const Params& p, int row, int col, f32x4 v) {
  char* ws = p.ws;
  if (SEC == 0) { f32x4 o = {gelu_f(v[0]), gelu_f(v[1]), gelu_f(v[2]), gelu_f(v[3])}; *(u32x2*)((u16*)(ws + OFF_UV) + (size_t)row * 1024 + col) = pack4(o); }
  else if (SEC == 1) { f32x4 o = {silu_f(v[0]), silu_f(v[1]), silu_f(v[2]), silu_f(v[3])}; *(u32x2*)((u16*)(ws + OFF_ZS) + (size_t)row * 1024 + (col - 1024)) = pack4(o); }
  else if (SEC == 2) {
    int c = col - 2048;
    *(u32x2*)((u16*)(ws + OFF_XBC) + (size_t)row * 1536 + c) = pack4(v);
    if (row >= TP) { *(f32x4*)(p.out + O_CONVS + (size_t)(row - TP) * 4608 + 3072 + c) = v; }
    else { int pos = row & 2047; if (pos >= 2045) *(f32x4*)(p.out + O_CONVP + (size_t)(row >> 11) * 4608 + (pos - 2045) * 1536 + c) = v; }
  }
  else if (SEC == 3) { *(u32x2*)((u16*)((char*)p.out + OOFF_Q) + (size_t)row * 512 + (col - 3584)) = pack4(v); }
  else if (SEC == 4) { f32x4 o = {sigm_f(v[0]), sigm_f(v[1]), sigm_f(v[2]), sigm_f(v[3])}; *(u32x2*)((u16*)(ws + OFF_GATE) + (size_t)row * 3072 + (col - 4096)) = pack4(o); }
  else {
    if (col < 512) {
      *(f32x4*)(p.out + O_MEMK + (size_t)row * 512 + col) = v;
      *(u32x2*)((u16*)(ws + OFF_KP) + (size_t)row * 512 + col) = pack4(v);
    } else {
      int c = col - 512;
      *(f32x4*)(p.out + O_MEMV + (size_t)row * 512 + c) = v;
      int b = row >> 8, mm = row & 255, hh = c >> 7, d = c & 127;
      int x = mm & 31, pos = (mm & ~31) + 8 * ((x >> 2) & 3) + 4 * (x >> 4) + (x & 3);
      u16* vt = (u16*)(ws + OFF_VT) + ((size_t)(b * 4 + hh) * 128 + d) * 256 + pos;
      vt[0] = f2bf(v[0]); vt[256] = f2bf(v[1]); vt[512] = f2bf(v[2]); vt[768] = f2bf(v[3]);
    }
  }
}
template <int SEC> __device__ __forceinline__ void epiB2(const Params& p, int row, int col32, f32x4 v0, f32x4 v1, int fq) {
  char* ws = p.ws;
  if (SEC == 0) { f32x4 o0 = {gelu_f(v0[0]), gelu_f(v0[1]), gelu_f(v0[2]), gelu_f(v0[3])}, o1 = {gelu_f(v1[0]), gelu_f(v1[1]), gelu_f(v1[2]), gelu_f(v1[3])};
    store_pair16((u16*)(ws + OFF_UV) + (size_t)row * 1024 + col32, pack4(o0), pack4(o1), fq); }
  else if (SEC == 1) { f32x4 o0 = {silu_f(v0[0]), silu_f(v0[1]), silu_f(v0[2]), silu_f(v0[3])}, o1 = {silu_f(v1[0]), silu_f(v1[1]), silu_f(v1[2]), silu_f(v1[3])};
    store_pair16((u16*)(ws + OFF_ZS) + (size_t)row * 1024 + (col32 - 1024), pack4(o0), pack4(o1), fq); }
  else if (SEC == 2) {
    const int c32 = col32 - 2048;
    store_pair16((u16*)(ws + OFF_XBC) + (size_t)row * 1536 + c32, pack4(v0), pack4(v1), fq);
    const int pos = row & 2047;
    if (pos >= 2045) {
      float* cp = p.out + O_CONVP + (size_t)(row >> 11) * 4608 + (pos - 2045) * 1536 + c32 + fq * 4;
      *(f32x4*)cp = v0; *(f32x4*)(cp + 16) = v1;
    }
  }
  else if (SEC == 3) { store_pair16((u16*)((char*)p.out + OOFF_Q) + (size_t)row * 512 + (col32 - 3584), pack4(v0), pack4(v1), fq); }
  else { f32x4 o0 = {sigm_f(v0[0]), sigm_f(v0[1]), sigm_f(v0[2]), sigm_f(v0[3])}, o1 = {sigm_f(v1[0]), sigm_f(v1[1]), sigm_f(v1[2]), sigm_f(v1[3])};
    store_pair16((u16*)(ws + OFF_GATE) + (size_t)row * 3072 + (col32 - 4096), pack4(o0), pack4(o1), fq); }
}
__device__ __forceinline__ int secB(int col) { return col < 1024 ? 0 : col < 2048 ? 1 : col < 3584 ? 2 : col < 4096 ? 3 : 4; }

__device__ __forceinline__ void phaseB(const Params& p, const int wv, const int rep) {
  const int wid = wv, wr = wid >> 2, wc = wid & 3;
  char* ws = p.ws;
  const u16* XN = (const u16*)((char*)p.out + OOFF_XN);
  {
    const u16* WIN = (const u16*)(ws + OFF_WIN);
    int t_ = blockIdx.x;
    const int tend = 1792 * rep;
    Acc acc;
    if (t_ < tend) {
      const int t = t_ >= 1792 ? t_ - 1792 : t_;
      kloop_t<1, true>(XN + (size_t)((t & 63) * 256) * 1024, 1024, WIN + (size_t)((t >> 6) * 256) * 1024, 1024, 1024, acc, wv);
    }
    while (t_ < tend) {
      const int t = t_ >= 1792 ? t_ - 1792 : t_;
      const int brow = (t & 63) * 256, bcol = (t >> 6) * 256, sec = secB(bcol);
      ACC_ZERO(acc);
      kloop_t<2>(XN + (size_t)brow * 1024, 1024, WIN + (size_t)bcol * 1024, 1024, 1024, acc, wv);
      t_ += gridDim.x;
      if (t_ < tend) {
        const int tn = t_ >= 1792 ? t_ - 1792 : t_;
        kloop_t<1, false>(XN + (size_t)((tn & 63) * 256) * 1024, 1024, WIN + (size_t)((tn >> 6) * 256) * 1024, 1024, 1024, acc, wv);
      }
      switch (sec) {
        case 0: ACC_FOREACH_PAIR({ epiB2<0>(p, brow + rrow, bcol + cb32, v0, v1, fq); }); break;
        case 1: ACC_FOREACH_PAIR({ epiB2<1>(p, brow + rrow, bcol + cb32, v0, v1, fq); }); break;
        case 2: ACC_FOREACH_PAIR({ epiB2<2>(p, brow + rrow, bcol + cb32, v0, v1, fq); }); break;
        case 3: ACC_FOREACH_PAIR({ epiB2<3>(p, brow + rrow, bcol + cb32, v0, v1, fq); }); break;
        default: ACC_FOREACH_PAIR({ epiB2<4>(p, brow + rrow, bcol + cb32, v0, v1, fq); }); break;
      }
    }
  }
  for (int gb = blockIdx.x; gb < 256; gb += gridDim.x) {
    const int task0 = gb * 14, mt = task0 / 448, nt0 = task0 - mt * 448;
    const u16* Ab = XN + (size_t)(TP + mt * 16) * 1024;
    const u16* Bb = (const u16*)(ws + OFF_WIN) + (size_t)(nt0 * 16) * 1024;
    skgemm<14>([&](int) { return Ab; }, [&](int i) { return Bb + (size_t)i * 16 * 1024; }, [&](int) { return 1024; }, 128, wv);
    for (int i = wv; i < 14; i += 8) {
      const int lane_e = lane_fresh(), fr = lane_e & 15, fq = lane_e >> 4;
      f32x4 a = skreduce(i);
      int row = TP + mt * 16 + fr, col = (nt0 + i) * 16 + fq * 4;
      switch (secB(col)) {
        case 0: epiB<0>(p, row, col, a); break;
        case 1: epiB<1>(p, row, col, a); break;
        case 2: epiB<2>(p, row, col, a); break;
        case 3: epiB<3>(p, row, col, a); break;
        default: epiB<4>(p, row, col, a); break;
      }
    }
  }
  for (int gb = blockIdx.x; gb < 256; gb += gridDim.x) {
    const u16* Bd = (const u16*)(ws + OFF_WDT);
    skgemm<5>([&](int i) { int tk = gb + 256 * i; tk = tk < T / 16 ? tk : 0; return XN + (size_t)(tk * 16) * 1024; }, [&](int) { return Bd; }, [&](int) { return 1024; }, 128, wv);
    for (int i = wv; i < 5; i += 8) {
      const int tk = gb + 256 * i;
      if (tk < T / 16) {
        const int lane_d = lane_fresh(), frd = lane_d & 15, fqd = lane_d >> 4;
        f32x4 a = skreduce(i);
        f32x4 bb = *(const f32x4*)(p.in[15] + fqd * 4);
        f32x4 o = {softplus_f(a[0] + bb[0]), softplus_f(a[1] + bb[1]), softplus_f(a[2] + bb[2]), softplus_f(a[3] + bb[3])};
        *(f32x4*)((float*)(ws + OFF_DT) + (size_t)(tk * 16 + frd) * 16 + fqd * 4) = o;
      }
    }
  }
}

__device__ __forceinline__ void ssd_prompt_item(const Params& p, int item, const int wv) {
  const int lane = lane_fresh(), wid = wv, tid = wv * 64 + lane, fr = lane & 15, fq = lane >> 4;
  const int h = item & 15, b = item >> 4, g = h >> 3;
  char* ws = p.ws;
  u16* C_l = (u16*)g_shm;
  u16* B_l = C_l + 128 * 136;
  u16* G_l = B_l;
  u16* BT_l = B_l + 128 * 136;
  u16* xT_l = BT_l + 128 * 136;
  u16* xw_l = xT_l + 64 * 136;
  u16* h_l = xw_l + 64 * 136;
  float* acum_l = (float*)(h_l + 64 * 136);
  float* dt_l = acum_l + 128;
  const u16* XBC = (const u16*)(ws + OFF_XBC);
  const u16* ZS = (const u16*)(ws + OFF_ZS);
  const float* DT = (const float*)(ws + OFF_DT);
  u16* Y = (u16*)((char*)p.out + OOFF_XN);
  float* YPS = (float*)(ws + OFF_YPS);
  const float Ah = -__expf(p.in[16][h]);
  const float Dh = p.in[17][h];
  const float* convw = p.in[13];
  const float* convb = p.in[14];
  const int cc = tid & 31, rg = tid >> 5;
  const int colbc = (cc < 16) ? (1024 + g * 128 + cc * 8) : (1280 + g * 128 + (cc - 16) * 8);
  const int xc = tid & 7, xr = tid >> 3;
  const int colx = h * 64 + xc * 8;
  const int j0 = rg * 8;
  f32x4 hacc[4];
#pragma unroll
  for (int pb = 0; pb < 4; ++pb) hacc[pb] = (f32x4){0.f, 0.f, 0.f, 0.f};
  u32x4 u[11], ux[5];
  float a0 = 0.f, a1 = 0.f;
#define SSD_PREFETCH(cn) do { const int t0n = b * 2048 + (cn) * 128; \
    _Pragma("unroll") for (int i_ = 0; i_ < 11; ++i_) { const int j_ = j0 - 3 + i_; const bool ok_ = ((cn) > 0) | (j_ >= 0); \
      u[i_] = *(const u32x4*)(XBC + (size_t)(t0n + (ok_ ? j_ : 0)) * 1536 + colbc); const unsigned m_ = ok_ ? 0xffffffffu : 0u; \
      u[i_].x &= m_; u[i_].y &= m_; u[i_].z &= m_; u[i_].w &= m_; } \
    _Pragma("unroll") for (int k_ = 0; k_ < 5; ++k_) { const int j_ = 2 * xr - 3 + k_; const bool ok_ = ((cn) > 0) | (j_ >= 0); \
      ux[k_] = *(const u32x4*)(XBC + (size_t)(t0n + (ok_ ? j_ : 0)) * 1536 + colx); const unsigned m_ = ok_ ? 0xffffffffu : 0u; \
      ux[k_].x &= m_; ux[k_].y &= m_; ux[k_].z &= m_; ux[k_].w &= m_; } \
    if (wid == 0) { a0 = DT[(size_t)(t0n + 2 * lane) * 16 + h]; a1 = DT[(size_t)(t0n + 2 * lane + 1) * 16 + h]; } } while (0)
  SSD_PREFETCH(0);
#pragma unroll 1
  for (int c = 0; c < 16; ++c) {
    const int t0 = b * 2048 + c * 128;
    __syncthreads();
#pragma unroll
    for (int pb = 0; pb < 4; ++pb) *(u32x2*)(h_l + (pb * 16 + fr) * 136 + wid * 16 + fq * 4) = pack4(hacc[pb]);
    if (wid == 0) {
      dt_l[2 * lane] = a0; dt_l[2 * lane + 1] = a1;
      float s = (a0 + a1) * Ah;
#pragma unroll
      for (int o = 1; o < 64; o <<= 1) { float v = shfl_idx_f(s, (lane - o) & 63); if (lane >= o) s += v; }
      acum_l[2 * lane + 1] = s; acum_l[2 * lane] = s - a1 * Ah;
    }
    {
      float w[4][8], bias[8];
#pragma unroll
      for (int k = 0; k < 4; ++k) { f32x4 w0 = *(const f32x4*)(convw + k * 1536 + colbc), w1 = *(const f32x4*)(convw + k * 1536 + colbc + 4);
        w[k][0] = w0[0]; w[k][1] = w0[1]; w[k][2] = w0[2]; w[k][3] = w0[3]; w[k][4] = w1[0]; w[k][5] = w1[1]; w[k][6] = w1[2]; w[k][7] = w1[3]; }
      { f32x4 b0 = *(const f32x4*)(convb + colbc), b1 = *(const f32x4*)(convb + colbc + 4);
        bias[0] = b0[0]; bias[1] = b0[1]; bias[2] = b0[2]; bias[3] = b0[3]; bias[4] = b1[0]; bias[5] = b1[1]; bias[6] = b1[2]; bias[7] = b1[3]; }
      unsigned outp[8][4];
#pragma unroll
      for (int jj = 0; jj < 8; ++jj) {
        float o[8];
#pragma unroll
        for (int e = 0; e < 8; ++e) o[e] = bias[e];
#pragma unroll
        for (int k = 0; k < 4; ++k) {
          u32x4 uu = u[jj + k];
          o[0] += w[k][0] * bflo(uu.x); o[1] += w[k][1] * bfhi(uu.x); o[2] += w[k][2] * bflo(uu.y); o[3] += w[k][3] * bfhi(uu.y);
          o[4] += w[k][4] * bflo(uu.z); o[5] += w[k][5] * bfhi(uu.z); o[6] += w[k][6] * bflo(uu.w); o[7] += w[k][7] * bfhi(uu.w);
        }
#pragma unroll
        for (int e = 0; e < 8; ++e) o[e] = silu_f(o[e]);
#pragma unroll
        for (int e2 = 0; e2 < 4; ++e2) outp[jj][e2] = cvt_pk(o[2 * e2], o[2 * e2 + 1]);
      }
      if (cc < 16) {
#pragma unroll
        for (int jj = 0; jj < 8; ++jj) *(u32x4*)(B_l + (j0 + jj) * 136 + cc * 8) = (u32x4){outp[jj][0], outp[jj][1], outp[jj][2], outp[jj][3]};
#pragma unroll
        for (int e2 = 0; e2 < 4; ++e2) {
          u32x4 lo, hi;
          lo.x = (outp[0][e2] & 0xffffu) | (outp[1][e2] << 16); lo.y = (outp[2][e2] & 0xffffu) | (outp[3][e2] << 16);
          lo.z = (outp[4][e2] & 0xffffu) | (outp[5][e2] << 16); lo.w = (outp[6][e2] & 0xffffu) | (outp[7][e2] << 16);
          hi.x = (outp[0][e2] >> 16) | (outp[1][e2] & 0xffff0000u); hi.y = (outp[2][e2] >> 16) | (outp[3][e2] & 0xffff0000u);
          hi.z = (outp[4][e2] >> 16) | (outp[5][e2] & 0xffff0000u); hi.w = (outp[6][e2] >> 16) | (outp[7][e2] & 0xffff0000u);
          *(u32x4*)(BT_l + (cc * 8 + 2 * e2) * 136 + j0) = lo;
          *(u32x4*)(BT_l + (cc * 8 + 2 * e2 + 1) * 136 + j0) = hi;
        }
      } else {
#pragma unroll
        for (int jj = 0; jj < 8; ++jj) *(u32x4*)(C_l + (j0 + jj) * 136 + (cc - 16) * 8) = (u32x4){outp[jj][0], outp[jj][1], outp[jj][2], outp[jj][3]};
      }
    }
    {
      f32x4 b0 = *(const f32x4*)(convb + colx), b1 = *(const f32x4*)(convb + colx + 4);
      f32x4 w0[4], w1[4];
#pragma unroll
      for (int k = 0; k < 4; ++k) { w0[k] = *(const f32x4*)(convw + k * 1536 + colx); w1[k] = *(const f32x4*)(convw + k * 1536 + colx + 4); }
      float xo[2][8];
#pragma unroll
      for (int r2 = 0; r2 < 2; ++r2) {
        float o[8] = {b0[0], b0[1], b0[2], b0[3], b1[0], b1[1], b1[2], b1[3]};
#pragma unroll
        for (int k = 0; k < 4; ++k) {
          u32x4 uu = ux[r2 + k];
          o[0] += w0[k][0] * bflo(uu.x); o[1] += w0[k][1] * bfhi(uu.x); o[2] += w0[k][2] * bflo(uu.y); o[3] += w0[k][3] * bfhi(uu.y);
          o[4] += w1[k][0] * bflo(uu.z); o[5] += w1[k][1] * bfhi(uu.z); o[6] += w1[k][2] * bflo(uu.w); o[7] += w1[k][3] * bfhi(uu.w);
        }
#pragma unroll
        for (int e = 0; e < 8; ++e) xo[r2][e] = silu_f(o[e]);
      }
#pragma unroll
      for (int e = 0; e < 8; ++e) *(unsigned*)(xT_l + (xc * 8 + e) * 136 + 2 * xr) = cvt_pk(xo[0][e], xo[1][e]);
    }
    __syncthreads();
    if (c < 15) SSD_PREFETCH(c + 1);
    u32x2 zsr[4];
#pragma unroll
    for (int pb = 0; pb < 4; ++pb) zsr[pb] = *(const u32x2*)(ZS + (size_t)(t0 + wid * 16 + fr) * 1024 + h * 64 + pb * 16 + fq * 4);
    bf16x8 cf[4];
#pragma unroll
    for (int ks = 0; ks < 4; ++ks) cf[ks] = *(const bf16x8*)(C_l + (wid * 16 + fr) * 136 + ks * 32 + fq * 8);
    f32x4 cb[8];
#pragma unroll
    for (int jb = 0; jb < 8; ++jb) {
      cb[jb] = (f32x4){0.f, 0.f, 0.f, 0.f};
      if (jb <= wid) {
#pragma unroll
        for (int ks = 0; ks < 4; ++ks) { bf16x8 bf = *(const bf16x8*)(B_l + (jb * 16 + fr) * 136 + ks * 32 + fq * 8); cb[jb] = MFMA16(bf, cf[ks], cb[jb]); }
      }
    }
    const float alast = acum_l[127];
#pragma unroll
    for (int r2 = 0; r2 < 2; ++r2) {
      int pp = (tid >> 4) + 32 * r2, jc = tid & 15;
      u32x4 xv = *(const u32x4*)(xT_l + pp * 136 + jc * 8);
      float wj[8];
#pragma unroll
      for (int e = 0; e < 8; ++e) wj[e] = dt_l[jc * 8 + e] * __expf(alast - acum_l[jc * 8 + e]);
      u32x4 ov;
      ov.x = cvt_pk(bflo(xv.x) * wj[0], bfhi(xv.x) * wj[1]); ov.y = cvt_pk(bflo(xv.y) * wj[2], bfhi(xv.y) * wj[3]);
      ov.z = cvt_pk(bflo(xv.z) * wj[4], bfhi(xv.z) * wj[5]); ov.w = cvt_pk(bflo(xv.w) * wj[6], bfhi(xv.w) * wj[7]);
      *(u32x4*)(xw_l + pp * 136 + jc * 8) = ov;
    }
    __syncthreads();
    {
      const int i = wid * 16 + fr;
      const float ai = acum_l[i];
#pragma unroll
      for (int jb = 0; jb < 8; ++jb) {
        f32x4 gv = {0.f, 0.f, 0.f, 0.f};
        if (jb <= wid) {
          f32x4 aj = *(const f32x4*)(acum_l + jb * 16 + fq * 4);
          f32x4 dj = *(const f32x4*)(dt_l + jb * 16 + fq * 4);
#pragma unroll
          for (int e = 0; e < 4; ++e) { int j = jb * 16 + fq * 4 + e; gv[e] = (j <= i) ? cb[jb][e] * __expf(ai - aj[e]) * dj[e] : 0.f; }
        }
        *(u32x2*)(G_l + i * 136 + jb * 16 + fq * 4) = pack4(gv);
      }
    }
    __syncthreads();
    {
      const int i = wid * 16 + fr, tok = t0 + i;
      const float ea = __expf(acum_l[i]);
      float ss = 0.f;
      u32x2 ypk[4];
      bf16x8 gf[4];
#pragma unroll
      for (int ks = 0; ks < 4; ++ks) gf[ks] = *(const bf16x8*)(G_l + (wid * 16 + fr) * 136 + ks * 32 + fq * 8);
#pragma unroll
      for (int pb = 0; pb < 4; ++pb) {
        f32x4 y = {0.f, 0.f, 0.f, 0.f};
#pragma unroll
        for (int ks = 0; ks < 4; ++ks) { bf16x8 hf = *(const bf16x8*)(h_l + (pb * 16 + fr) * 136 + ks * 32 + fq * 8); y = MFMA16(hf, cf[ks], y); }
        y = y * ea;
#pragma unroll
        for (int ks = 0; ks < 4; ++ks) {
          if (ks <= (wid >> 1)) {
            bf16x8 xf = *(const bf16x8*)(xT_l + (pb * 16 + fr) * 136 + ks * 32 + fq * 8);
            y = MFMA16(xf, gf[ks], y);
          }
        }
        const int pc = pb * 16 + fq * 4;
        f32x4 zs = unpack4(zsr[pb]);
#pragma unroll
        for (int e = 0; e < 4; ++e) { float xv = bf2f(xT_l[(pc + e) * 136 + i]); y[e] = (y[e] + xv * Dh) * zs[e]; ss += y[e] * y[e]; }
        ypk[pb] = pack4(y);
      }
      store_pair16(Y + (size_t)tok * 1024 + h * 64, ypk[0], ypk[1], fq);
      store_pair16(Y + (size_t)tok * 1024 + h * 64 + 32, ypk[2], ypk[3], fq);
      ss += shfl_xor_f(ss, 16); ss += shfl_xor_f(ss, 32);
      if (fq == 0) { YPS[(size_t)tok * 32 + g * 16 + (h & 7) * 2] = ss; YPS[(size_t)tok * 32 + g * 16 + (h & 7) * 2 + 1] = 0.f; }
    }
    {
      const float dl = __expf(alast);
      bf16x8 btf[4];
#pragma unroll
      for (int ks = 0; ks < 4; ++ks) btf[ks] = *(const bf16x8*)(BT_l + (wid * 16 + fr) * 136 + ks * 32 + fq * 8);
#pragma unroll
      for (int pb = 0; pb < 4; ++pb) {
        hacc[pb] = hacc[pb] * dl;
#pragma unroll
        for (int ks = 0; ks < 4; ++ks) {
          bf16x8 xwf = *(const bf16x8*)(xw_l + (pb * 16 + fr) * 136 + ks * 32 + fq * 8);
          hacc[pb] = MFMA16(btf[ks], xwf, hacc[pb]);
        }
      }
    }
  }
#undef SSD_PREFETCH
#pragma unroll
  for (int pb = 0; pb < 4; ++pb)
    *(f32x4*)(p.out + O_SSMP + ((size_t)(b * 16 + h) * 64 + pb * 16 + fr) * 128 + wid * 16 + fq * 4) = hacc[pb];
}

__device__ __forceinline__ void memkv_tile(const Params& p, int item, const int wv, unsigned* bar) {
  const int wid = wv, wr = wid >> 2, wc = wid & 3;
  const int h = item & 3, b = item >> 2;
  char* ws = p.ws;
  Acc acc; ACC_ZERO(acc);
  kloop((const u16*)(ws + OFF_MN) + (size_t)(b * 256) * 1024, 1024, (const u16*)(ws + OFF_WKV) + (size_t)(h * 256) * 1024, 1024, 1024, acc, wv);
  ACC_FOREACH({
    const int row = b * 256 + rrow;
    const int col = (rcol < 128) ? (h * 128 + rcol) : (512 + h * 128 + rcol - 128);
    epiB<5>(p, row, col, v);
  });
  asm volatile("s_waitcnt vmcnt(0)" ::: "memory");
  __syncthreads();
  if (wv == 0) { if (lane_fresh() == 0) { __builtin_amdgcn_fence(__ATOMIC_RELEASE, "agent"); asm volatile("s_waitcnt vmcnt(0)" ::: "memory"); (void)xb_add(&bar[6144 + item * 16], 1u); } }
}

__device__ __forceinline__ void attn_prompt_item(const Params& p, int item, const int wv, unsigned* bar) {
  const int lane = lane_fresh(), wid = wv, tid = wv * 64 + lane, fr = lane & 15, fq = lane >> 4;
  const int qt = item & 7, h = (item >> 3) & 3, b = item >> 5;
  char* ws = p.ws;
  u16* K_l = (u16*)g_shm;
  u16* VT_l = K_l + 256 * 136;
  const u16* KP = (const u16*)(ws + OFF_KP);
  const u16* VT = (const u16*)(ws + OFF_VT);
  u16* Q = (u16*)((char*)p.out + OOFF_Q);
  if (wv == 0) { if (lane == 0) { XB_SPIN(xb_ld(&bar[6144 + (b * 4 + h) * 16]) == 0u, bar); } }
  __syncthreads();
  __builtin_amdgcn_fence(__ATOMIC_ACQUIRE, "agent");
#pragma unroll
  for (int i = 0; i < 8; ++i) {
    int idx = i * 512 + tid, mm = idx >> 4, ch = idx & 15;
    *(u32x4*)(K_l + mm * 136 + ch * 8) = *(const u32x4*)(KP + (size_t)(b * 256 + mm) * 512 + h * 128 + ch * 8);
  }
#pragma unroll
  for (int i = 0; i < 8; ++i) {
    int idx = i * 512 + tid, d = idx >> 5, ch = idx & 31;
    *(u32x4*)(VT_l + d * 264 + ch * 8) = *(const u32x4*)(VT + ((size_t)(b * 4 + h) * 128 + d) * 256 + ch * 8);
  }
  const int q0 = b * 2048 + qt * 256 + wid * 32;
  bf16x8 qf[2][4];
#pragma unroll
  for (int qb = 0; qb < 2; ++qb)
#pragma unroll
    for (int ks = 0; ks < 4; ++ks) qf[qb][ks] = *(const bf16x8*)(Q + (size_t)(q0 + qb * 16 + fr) * 512 + h * 128 + ks * 32 + fq * 8);
  __syncthreads();
  f32x4 s[16][2];
#pragma unroll
  for (int mb = 0; mb < 16; ++mb) {
    s[mb][0] = (f32x4){0.f, 0.f, 0.f, 0.f}; s[mb][1] = (f32x4){0.f, 0.f, 0.f, 0.f};
#pragma unroll
    for (int ks = 0; ks < 4; ++ks) {
      bf16x8 kf = *(const bf16x8*)(K_l + (mb * 16 + fr) * 136 + ks * 32 + fq * 8);
      s[mb][0] = MFMA16(kf, qf[0][ks], s[mb][0]);
      s[mb][1] = MFMA16(kf, qf[1][ks], s[mb][1]);
    }
  }
  const float cexp = 0.08838834764831845f * 1.4426950408889634f;
  float inv[2];
  bf16x8 pf[2][8];
#pragma unroll
  for (int qb = 0; qb < 2; ++qb) {
    float mx = -1e30f;
#pragma unroll
    for (int mb = 0; mb < 16; ++mb) mx = fmaxf(mx, fmaxf(fmaxf(s[mb][qb][0], s[mb][qb][1]), fmaxf(s[mb][qb][2], s[mb][qb][3])));
    mx = fmaxf(mx, shfl_xor_f(mx, 16)); mx = fmaxf(mx, shfl_xor_f(mx, 32));
    float sum = 0.f;
#pragma unroll
    for (int mb = 0; mb < 16; ++mb)
#pragma unroll
      for (int e = 0; e < 4; ++e) { float pv = exp2f((s[mb][qb][e] - mx) * cexp); s[mb][qb][e] = pv; sum += pv; }
    sum += shfl_xor_f(sum, 16); sum += shfl_xor_f(sum, 32);
    inv[qb] = 1.f / sum;
#pragma unroll
    for (int st = 0; st < 8; ++st) {
      u32x2 lo = pack4(s[2 * st][qb]), hi = pack4(s[2 * st + 1][qb]);
      u32x4 w = {lo.x, lo.y, hi.x, hi.y};
      pf[qb][st] = __builtin_bit_cast(bf16x8, w);
    }
  }
  f32x4 o[8][2];
#pragma unroll
  for (int db = 0; db < 8; ++db) { o[db][0] = (f32x4){0.f, 0.f, 0.f, 0.f}; o[db][1] = (f32x4){0.f, 0.f, 0.f, 0.f}; }
#pragma unroll
  for (int st = 0; st < 8; ++st)
#pragma unroll
    for (int db = 0; db < 8; ++db) {
      bf16x8 vf = *(const bf16x8*)(VT_l + (db * 16 + fr) * 264 + st * 32 + fq * 8);
      o[db][0] = MFMA16(vf, pf[0][st], o[db][0]);
      o[db][1] = MFMA16(vf, pf[1][st], o[db][1]);
    }
#pragma unroll
  for (int qb = 0; qb < 2; ++qb)
#pragma unroll
    for (int dp = 0; dp < 4; ++dp)
      store_pair16((u16*)(ws + OFF_XA) + (size_t)(q0 + qb * 16 + fr) * 512 + h * 128 + dp * 32, pack4(o[2 * dp][qb] * inv[qb]), pack4(o[2 * dp + 1][qb] * inv[qb]), fq);
}

__device__ __forceinline__ void gmlp_prompt_item(const Params& p, int item, const int wv) {
  const int lane = lane_fresh(), wid = wv, tid = wv * 64 + lane, fr = lane & 15, fq = lane >> 4;
  const int gp = item & 1, c = (item >> 1) & 15, b = item >> 5;
  const int t0 = b * 2048 + c * 128;
  char* ws = p.ws;
  u16* VnT = (u16*)g_shm;
  const u16* UV = (const u16*)(ws + OFF_UV);
  const u16* WSB = (const u16*)(ws + OFF_WSB);
  u16* GM = (u16*)((char*)p.out + OOFF_GM);
  __syncthreads();
  {
    const int row = tid >> 2, qq = tid & 3;
    const u16* vrow = UV + (size_t)(t0 + row) * 1024 + 512;
    float sm = 0.f, sq = 0.f;
#pragma unroll
    for (int i = 0; i < 16; ++i) {
      u32x4 w = *(const u32x4*)(vrow + qq * 128 + i * 8);
      float f[8] = {bflo(w.x), bfhi(w.x), bflo(w.y), bfhi(w.y), bflo(w.z), bfhi(w.z), bflo(w.w), bfhi(w.w)};
#pragma unroll
      for (int e = 0; e < 8; ++e) { sm += f[e]; sq += f[e] * f[e]; }
    }
    sm += shfl_xor_f(sm, 1); sm += shfl_xor_f(sm, 2); sq += shfl_xor_f(sq, 1); sq += shfl_xor_f(sq, 2);
    const float mean = sm * (1.f / 512.f), var = fmaxf(sq * (1.f / 512.f) - mean * mean, 0.f), rstd = rsqrtf(var + EPS);
#pragma unroll
    for (int i = 0; i < 8; ++i) {
      const int cl = qq * 64 + i * 8, col = gp * 256 + cl;
      u32x4 w = *(const u32x4*)(vrow + col);
      float f[8] = {bflo(w.x), bfhi(w.x), bflo(w.y), bfhi(w.y), bflo(w.z), bfhi(w.z), bflo(w.w), bfhi(w.w)};
#pragma unroll
      for (int e = 0; e < 8; ++e) {
        float vn = (f[e] - mean) * rstd * p.in[9][col + e] + p.in[10][col + e];
        VnT[(cl + e) * 136 + row] = f2bf(vn);
      }
    }
  }
  __syncthreads();
  f32x4 acc[16];
#pragma unroll
  for (int db = 0; db < 16; ++db) acc[db] = (f32x4){0.f, 0.f, 0.f, 0.f};
#pragma unroll
  for (int ks = 0; ks < 4; ++ks) {
    if (ks <= (wid >> 1)) {
      bf16x8 w0 = *(const bf16x8*)(WSB + ((size_t)(gp * 2) * 128 + wid * 16 + fr) * 128 + ks * 32 + fq * 8);
      bf16x8 w1 = *(const bf16x8*)(WSB + ((size_t)(gp * 2 + 1) * 128 + wid * 16 + fr) * 128 + ks * 32 + fq * 8);
#pragma unroll
      for (int db = 0; db < 16; ++db) {
        bf16x8 vf = *(const bf16x8*)(VnT + (db * 16 + fr) * 136 + ks * 32 + fq * 8);
        acc[db] = MFMA16(vf, db < 8 ? w0 : w1, acc[db]);
      }
    }
  }
  const int tt = wid * 16 + fr, tok = t0 + tt;
#pragma unroll
  for (int dp = 0; dp < 8; ++dp) {
    const int gs = gp * 2 + (dp >> 2), cb = gs * 128 + (dp & 3) * 32;
    const float bsv = p.in[12][gs * 128 + tt];
    f32x4 u0 = unpack4(*(const u32x2*)(UV + (size_t)tok * 1024 + cb + fq * 4)), u1 = unpack4(*(const u32x2*)(UV + (size_t)tok * 1024 + cb + 16 + fq * 4));
    store_pair16(GM + (size_t)tok * 512 + cb, pack4(u0 * (acc[2 * dp] + bsv)), pack4(u1 * (acc[2 * dp + 1] + bsv)), fq);
  }
}

__device__ __forceinline__ void gmlp_sample_row(const Params& p, int bidx, const int wv) {
  const int lane = lane_fresh();
  char* ws = p.ws;
  const u16* UV = (const u16*)(ws + OFF_UV);
  u16* GM = (u16*)((char*)p.out + OOFF_GM);
  const int tok = TP + bidx;
  u32x4 w = *(const u32x4*)(UV + (size_t)tok * 1024 + 512 + lane * 8);
  float f[8] = {bflo(w.x), bfhi(w.x), bflo(w.y), bfhi(w.y), bflo(w.z), bfhi(w.z), bflo(w.w), bfhi(w.w)};
  float sm = 0.f, sq = 0.f;
#pragma unroll
  for (int e = 0; e < 8; ++e) { sm += f[e]; sq += f[e] * f[e]; }
  sm = wave_sum(sm); sq = wave_sum(sq);
  const float mean = sm * (1.f / 512.f), var = fmaxf(sq * (1.f / 512.f) - mean * mean, 0.f), rstd = rsqrtf(var + EPS);
  const int col = lane * 8, gs = col >> 7;
  const float w00 = p.in[11][gs * 16384], bs0 = p.in[12][gs * 128];
  u32x4 uw = *(const u32x4*)(UV + (size_t)tok * 1024 + col);
  float u[8] = {bflo(uw.x), bfhi(uw.x), bflo(uw.y), bfhi(uw.y), bflo(uw.z), bfhi(uw.z), bflo(uw.w), bfhi(uw.w)};
  float vn[8], o[8];
#pragma unroll
  for (int e = 0; e < 8; ++e) { vn[e] = (f[e] - mean) * rstd * p.in[9][col + e] + p.in[10][col + e]; o[e] = u[e] * (w00 * vn[e] + bs0); }
  *(f32x4*)(p.out + O_GMV + (size_t)bidx * 512 + col) = (f32x4){vn[0], vn[1], vn[2], vn[3]};
  *(f32x4*)(p.out + O_GMV + (size_t)bidx * 512 + col + 4) = (f32x4){vn[4], vn[5], vn[6], vn[7]};
  u32x4 ow = {cvt_pk(o[0], o[1]), cvt_pk(o[2], o[3]), cvt_pk(o[4], o[5]), cvt_pk(o[6], o[7])};
  *(u32x4*)(GM + (size_t)tok * 512 + col) = ow;
}

__device__ __forceinline__ void ssd_sample_item(const Params& p, int item, const int wv) {
  const int lane = lane_fresh();
  const int h = item & 15, b = item >> 4, g = h >> 3, tok = TP + b;
  char* ws = p.ws;
  const u16* XBC = (const u16*)(ws + OFF_XBC);
  const u16* ZS = (const u16*)(ws + OFF_ZS);
  const float* DT = (const float*)(ws + OFF_DT);
  u16* Y = (u16*)((char*)p.out + OOFF_XN);
  float* YPS = (float*)(ws + OFF_YPS);
  const float* sc = p.in[5] + (size_t)b * 4608;
  const float* convw = p.in[13];
  const float* convb = p.in[14];
  auto conv1 = [&](int col) -> float {
    float o = convb[col] + convw[col] * sc[col] + convw[1536 + col] * sc[1536 + col] + convw[3072 + col] * sc[3072 + col]
            + convw[4608 + col] * bf2f(XBC[(size_t)tok * 1536 + col]);
    return silu_f(o);
  };
  const float x = conv1(h * 64 + lane);
  const int n4 = (lane & 31) * 4, hf = lane >> 5;
  float Bv[4], Cv[4];
#pragma unroll
  for (int e = 0; e < 4; ++e) { Bv[e] = conv1(1024 + g * 128 + n4 + e); Cv[e] = conv1(1280 + g * 128 + n4 + e); }
  const float dt = DT[(size_t)tok * 16 + h];
  const float dA = __expf(-dt * __expf(p.in[16][h]));
  const float* st = p.in[6] + ((size_t)(b * 16 + h) * 64) * 128;
  float* so = p.out + O_SSMS + ((size_t)(b * 16 + h) * 64) * 128;
  float ymine = 0.f;
#pragma unroll 8
  for (int r = 0; r < 32; ++r) {
    const int pp = 2 * r + hf;
    f32x4 hv = *(const f32x4*)(st + (size_t)pp * 128 + n4);
    const float xp = shfl_idx_f(x, pp) * dt;
    f32x4 hn;
    float yp = 0.f;
#pragma unroll
    for (int e = 0; e < 4; ++e) { hn[e] = dA * hv[e] + xp * Bv[e]; yp += hn[e] * Cv[e]; }
    *(f32x4*)(so + (size_t)pp * 128 + n4) = hn;
#pragma unroll
    for (int o = 16; o >= 1; o >>= 1) yp += shfl_xor_f(yp, o);
    if ((lane & 31) == r) ymine = yp;
  }
  const int pm = 2 * (lane & 31) + hf;
  const float xm = shfl_idx_f(x, pm);
  const float zs = bf2f(ZS[(size_t)tok * 1024 + h * 64 + pm]);
  const float yg = (ymine + xm * p.in[17][h]) * zs;
  float ss = wave_sum(yg * yg);
  Y[(size_t)tok * 1024 + h * 64 + pm] = f2bf(yg);
  if (lane == 0) { YPS[(size_t)tok * 32 + g * 16 + (h & 7) * 2] = ss; YPS[(size_t)tok * 32 + g * 16 + (h & 7) * 2 + 1] = 0.f; }
}

__device__ __forceinline__ void attn_sample_item(const Params& p, int item, const int wv) {
  const int lane = lane_fresh(), wid = wv, tid = wv * 64 + lane;
  const int h = item & 3, b = item >> 2, tok = TP + b;
  float* sc_l = (float*)g_shm;
  float* red_l = sc_l + 256;
  u16* Q = (u16*)((char*)p.out + OOFF_Q);
  const float* Kc = p.in[3] + ((size_t)b * 256 * 4 + h) * 128;
  const float* Vc = p.in[4] + ((size_t)b * 256 * 4 + h) * 128;
  const int vdch = tid & 31, vmg = tid >> 5;
  f32x4 vreg[16];
#pragma unroll
  for (int i = 0; i < 16; ++i) vreg[i] = *(const f32x4*)(Vc + (size_t)(vmg * 16 + i) * 512 + vdch * 4);
  __syncthreads();
  {
    const int dch = lane & 15, ksub = lane >> 4;
    u32x4 qw = *(const u32x4*)(Q + (size_t)tok * 512 + h * 128 + dch * 8);
    float q[8] = {bflo(qw.x), bfhi(qw.x), bflo(qw.y), bfhi(qw.y), bflo(qw.z), bfhi(qw.z), bflo(qw.w), bfhi(qw.w)};
#pragma unroll
    for (int it = 0; it < 8; ++it) {
      const int mm = wid * 32 + it * 4 + ksub;
      f32x4 k0 = *(const f32x4*)(Kc + (size_t)mm * 512 + dch * 8), k1 = *(const f32x4*)(Kc + (size_t)mm * 512 + dch * 8 + 4);
      float d = q[0] * k0[0] + q[1] * k0[1] + q[2] * k0[2] + q[3] * k0[3] + q[4] * k1[0] + q[5] * k1[1] + q[6] * k1[2] + q[7] * k1[3];
      d += shfl_xor_f(d, 1); d += shfl_xor_f(d, 2); d += shfl_xor_f(d, 4); d += shfl_xor_f(d, 8);
      if (dch == 0) sc_l[mm] = d * 0.08838834764831845f;
    }
  }
  __syncthreads();
  float pv[4];
  {
    float mx = -1e30f;
#pragma unroll
    for (int i = 0; i < 4; ++i) { pv[i] = sc_l[lane + 64 * i]; mx = fmaxf(mx, pv[i]); }
    mx = wave_max(mx);
    float sum = 0.f;
#pragma unroll
    for (int i = 0; i < 4; ++i) { pv[i] = __expf(pv[i] - mx); sum += pv[i]; }
    sum = wave_sum(sum);
    const float inv = 1.f / sum;
#pragma unroll
    for (int i = 0; i < 4; ++i) pv[i] *= inv;
  }
  __syncthreads();
  if (wid == 0) {
#pragma unroll
    for (int i = 0; i < 4; ++i) sc_l[lane + 64 * i] = pv[i];
  }
  __syncthreads();
  {
    f32x4 acc = {0.f, 0.f, 0.f, 0.f};
#pragma unroll
    for (int i = 0; i < 16; ++i) acc += vreg[i] * sc_l[vmg * 16 + i];
    *(f32x4*)(red_l + vmg * 128 + vdch * 4) = acc;
  }
  __syncthreads();
  if (tid < 128) {
    float o = 0.f;
#pragma unroll
    for (int mg = 0; mg < 16; ++mg) o += red_l[mg * 128 + tid];
    ((u16*)(p.ws + OFF_XA))[(size_t)tok * 512 + h * 128 + tid] = f2bf(o);
  }
}

__device__ __forceinline__ void phaseC(const Params& p, const int wv, const int r0, const int r1, const int r2, const int r3, const int r4, unsigned* bar) {
  const int wid = wv;
  const int nS = gridDim.x >> 1;
  if ((int)blockIdx.x < nS) {
    for (int it = blockIdx.x; it < 128 * r0; it += nS) ssd_prompt_item(p, it & 127, wv);
  } else {
    const int ob = blockIdx.x - nS, nO = gridDim.x - nS;
    const int gw = ob * 8 + wid, nw = nO * 8;
    for (int it = ob; it < 32; it += nO) memkv_tile(p, it, wv, bar);
    for (int it = gw; it < 2048 * r1; it += nw) ssd_sample_item(p, it & 2047, wv);
    if (nO >= 64) {
      if (ob < 32) attn_sample_item(p, ob, wv);
      else for (int it = 32 + (ob - 32); it < 512; it += nO - 32) attn_sample_item(p, it, wv);
    } else {
      for (int it = ob; it < 512; it += nO) attn_sample_item(p, it, wv);
    }
    for (int it = ob; it < 256 * r2; it += nO) attn_prompt_item(p, it & 255, wv, bar);
    for (int it = ob; it < 256 * r3; it += nO) gmlp_prompt_item(p, it & 255, wv);
    for (int it = gw; it < 128; it += nw) gmlp_sample_row(p, it, wv);
  }
}

__device__ __forceinline__ void phaseD(const Params& p, const int wv, const int rep) {
  const int wid = wv, wr = wid >> 2, wc = wid & 3;
  char* ws = p.ws;
  const u16* GM = (const u16*)((char*)p.out + OOFF_GM);
  const u16* Y = (const u16*)((char*)p.out + OOFF_XN);
  const u16* XA = (const u16*)(ws + OFF_XA);
  const u16* GATE = (const u16*)(ws + OFF_GATE);
  const float* YPS = (const float*)(ws + OFF_YPS);
  u16* MERGED = (u16*)(ws + OFF_MERGED);
  const u16* WGM = (const u16*)(ws + OFF_WGM);
  const u16* WSSD = (const u16*)(ws + OFF_WSSD);
  const u16* WXA = (const u16*)(ws + OFF_WXA);
  float* rs_l = (float*)(g_shm + 131072);
  for (int t_ = blockIdx.x; t_ < 256 * rep; t_ += gridDim.x) {
    const int t = t_ & 255;
    const int pm = t & 63, pn = t >> 6, brow = pm * 256, bcol = pn * 256;
    __syncthreads();
    {
      const int tid = wv * 64 + lane_fresh();
      const int r = tid >> 1, gg = tid & 1;
      const float* ps = YPS + (size_t)(brow + r) * 32 + gg * 16;
      f32x4 a = *(const f32x4*)ps + *(const f32x4*)(ps + 4) + *(const f32x4*)(ps + 8) + *(const f32x4*)(ps + 12);
      rs_l[r * 2 + gg] = rsqrtf((a[0] + a[1] + a[2] + a[3]) * (1.f / 512.f) + EPS);
    }
    auto opnd = [&](int br, const u16*& Ap, const u16*& Bp, int& ld) {
      if (br == 0) { Ap = GM + (size_t)brow * 512; Bp = WGM + (size_t)bcol * 512; ld = 512; }
      else if (br == 1) { Ap = Y + (size_t)brow * 1024; Bp = WSSD + (size_t)bcol * 1024; ld = 1024; }
      else if (br == 2) { Ap = Y + (size_t)brow * 1024 + 512; Bp = WSSD + (size_t)bcol * 1024 + 512; ld = 1024; }
      else { Ap = XA + (size_t)brow * 512; Bp = WXA + (size_t)bcol * 512; ld = 512; }
    };
    Acc acc; ACC_ZERO(acc);
    { const u16 *Ap, *Bp; int ld; opnd(0, Ap, Bp, ld); kloop_t<1, true>(Ap, ld, Bp, ld, 512, acc, wv); }
#pragma unroll 1
    for (int br = 0; br < 4; ++br) {
      const u16 *Ap, *Bp; int ld; opnd(br, Ap, Bp, ld);
      kloop_t<2>(Ap, ld, Bp, ld, 512, acc, wv);
      const int gnum = (br == 0) ? 0 : (br == 2) ? 1024 : 2048, gden = (br == 0) ? 1024 : 2048;
      const int lane_e = lane_fresh(), fr = lane_e & 15, fq = lane_e >> 4;
      const int r0 = brow + wr * 64 + fr, c0 = bcol + wc * 32 + fq * 4;
      u32x4 gw[2][2], dw[2][2];
      const int poff = (fq & 1) * 16 + (fq >> 1) * 8;
#define D_LOAD(g, buf) do { const int row_ = r0 + ((g) >> 2) * 128 + ((g) & 3) * 16; \
        _Pragma("unroll") for (int bj_ = 0; bj_ < 2; ++bj_) { const u16* gp_ = GATE + (size_t)row_ * 3072 + bcol + wc * 32 + bj_ * 128 + poff; \
          gw[buf][bj_] = (u32x4){0x3f803f80u, 0x3f803f80u, 0x3f803f80u, 0x3f803f80u}; dw[buf][bj_] = (u32x4){0x3f803f80u, 0x3f803f80u, 0x3f803f80u, 0x3f803f80u}; \
          if (br != 1) gw[buf][bj_] = *(const u32x4*)(gp_ + gnum); \
          if (br == 0 || br == 2) dw[buf][bj_] = *(const u32x4*)(gp_ + gden); } } while (0)
      D_LOAD(0, 0);
      if (br < 3) { const u16 *An, *Bn; int ldn; opnd(br + 1, An, Bn, ldn); kloop_t<1, false>(An, ldn, Bn, ldn, 512, acc, wv); }
#pragma unroll
      for (int g = 0; g < 8; ++g) {
        if (g < 7) D_LOAD(g + 1, (g + 1) & 1);
        __builtin_amdgcn_sched_barrier(0);
        const int ai = g >> 2, m = g & 3, rrow = ai * 128 + wr * 64 + m * 16 + fr, row_ = brow + rrow;
        const float rs0 = rs_l[rrow * 2], rs1 = rs_l[rrow * 2 + 1];
        const float rsc = (br == 0) ? __builtin_amdgcn_rcpf(rs0) : (br == 1) ? rs0 * __builtin_amdgcn_rcpf(rs1) : (br == 2) ? rs1 : 1.f;
#pragma unroll
        for (int bj = 0; bj < 2; ++bj) {
          u32x2 gnp[2], gdp[2];
          unpair16(gw[g & 1][bj], gnp[0], gnp[1]); unpair16(dw[g & 1][bj], gdp[0], gdp[1]);
#pragma unroll
          for (int n = 0; n < 2; ++n) {
            const f32x4 gn = unpack4(gnp[n]), gd = unpack4(gdp[n]);
            f32x4 sc;
#pragma unroll
            for (int e = 0; e < 4; ++e) sc[e] = gn[e] * rsc * __builtin_amdgcn_rcpf(fmaxf(gd[e], 1e-30f));
            acc[ai][bj][m][n] = acc[ai][bj][m][n] * sc;
          }
        }
        if (br == 3) {
          u16* mrow = MERGED + (size_t)row_ * 1024 + bcol + wc * 32;
          store_pair16(mrow, pack4(acc[ai][0][m][0]), pack4(acc[ai][0][m][1]), fq);
          store_pair16(mrow + 128, pack4(acc[ai][1][m][0]), pack4(acc[ai][1][m][1]), fq);
        }
        __builtin_amdgcn_sched_barrier(0);
      }
#undef D_LOAD
    }
  }
  for (int gb = blockIdx.x; gb < 256; gb += gridDim.x) {
    const int task0 = gb * 2, mt = task0 >> 6, nt0 = task0 & 63, r0 = TP + mt * 16;
    skgemm<8>([&](int i) { const int br = i & 3; return br == 0 ? GM + (size_t)r0 * 512 : br == 1 ? Y + (size_t)r0 * 1024 : br == 2 ? Y + (size_t)r0 * 1024 + 512 : XA + (size_t)r0 * 512; },
              [&](int i) { const int br = i & 3, c0 = (nt0 + (i >> 2)) * 16; return br == 0 ? WGM + (size_t)c0 * 512 : br == 1 ? WSSD + (size_t)c0 * 1024 : br == 2 ? WSSD + (size_t)c0 * 1024 + 512 : WXA + (size_t)c0 * 512; },
              [&](int i) { const int br = i & 3; return (br == 1 || br == 2) ? 1024 : 512; }, 64, wv);
    if (wv < 2) {
      const int lane_e = lane_fresh(), fr = lane_e & 15, fq = lane_e >> 4;
      const int row = r0 + fr, col = (nt0 + wv) * 16 + fq * 4;
      const u16* gp_ = GATE + (size_t)row * 3072 + col;
      f32x4 g0 = unpack4(*(const u32x2*)gp_), g1 = unpack4(*(const u32x2*)(gp_ + 1024)), g2 = unpack4(*(const u32x2*)(gp_ + 2048));
      float rs[2];
#pragma unroll
      for (int gg = 0; gg < 2; ++gg) {
        const float* ps = YPS + (size_t)row * 32 + gg * 16;
        f32x4 a = *(const f32x4*)ps + *(const f32x4*)(ps + 4) + *(const f32x4*)(ps + 8) + *(const f32x4*)(ps + 12);
        rs[gg] = rsqrtf((a[0] + a[1] + a[2] + a[3]) * (1.f / 512.f) + EPS);
      }
      f32x4 a0 = skreduce(wv * 4 + 0), a1 = skreduce(wv * 4 + 1), a2 = skreduce(wv * 4 + 2), a3 = skreduce(wv * 4 + 3);
      f32x4 o = g0 * a0 + g1 * (a1 * rs[0] + a2 * rs[1]) + g2 * a3;
      *(u32x2*)(MERGED + (size_t)row * 1024 + col) = pack4(o);
    }
  }
}

__device__ __forceinline__ void phaseE(const Params& p, const int wv, const int rep) {
  const int wid = wv, wr = wid >> 2, wc = wid & 3;
  char* ws = p.ws;
  const u16* MERGED = (const u16*)(ws + OFF_MERGED);
  const u16* WOUT = (const u16*)(ws + OFF_WOUT);
  u16* H2B = (u16*)(ws + OFF_H2B);
  float* PS = (float*)(ws + OFF_PS);
  float* PSS = (float*)(ws + OFF_PSS);
  for (int t_ = blockIdx.x; t_ < 256 * rep; t_ += gridDim.x) {
    const int t = t_ & 255;
    const int pm = t & 63, pn = t >> 6, brow = pm * 256, bcol = pn * 256;
    Acc acc; ACC_ZERO(acc);
    kloop(MERGED + (size_t)brow * 1024, 1024, WOUT + (size_t)bcol * 1024, 1024, 1024, acc, wv);
    const int lane_e = lane_fresh(), fr = lane_e & 15, fq = lane_e >> 4; (void)fr; (void)fq;
#pragma unroll
    for (int ai = 0; ai < 2; ++ai)
#pragma unroll
      for (int m = 0; m < 4; ++m) {
        const int row = brow + ai * 128 + wr * 64 + m * 16 + fr;
        float ss = 0.f;
#pragma unroll
        for (int bj = 0; bj < 2; ++bj)
          {
            const int cb = bcol + bj * 128 + wc * 32;
            f32x4 v0 = acc[ai][bj][m][0] + *(const f32x4*)(p.in[0] + (size_t)row * 1024 + cb + fq * 4);
            f32x4 v1 = acc[ai][bj][m][1] + *(const f32x4*)(p.in[0] + (size_t)row * 1024 + cb + 16 + fq * 4);
            store_pair16(H2B + (size_t)row * 1024 + cb, pack4(v0), pack4(v1), fq);
            ss += v0[0] * v0[0] + v0[1] * v0[1] + v0[2] * v0[2] + v0[3] * v0[3] + v1[0] * v1[0] + v1[1] * v1[1] + v1[2] * v1[2] + v1[3] * v1[3];
          }
        ss += shfl_xor_f(ss, 16); ss += shfl_xor_f(ss, 32);
        if (fq == 0) PS[(size_t)row * 16 + pn * 4 + wc] = ss;
      }
  }
  for (int gb = blockIdx.x; gb < 256; gb += gridDim.x) {
    const int task0 = gb * 2, mt = task0 >> 6, nt0 = task0 & 63;
    const u16* Ab = MERGED + (size_t)(TP + mt * 16) * 1024;
    skgemm<2>([&](int) { return Ab; }, [&](int i) { return WOUT + (size_t)((nt0 + i) * 16) * 1024; }, [&](int) { return 1024; }, 128, wv);
    if (wv < 2) {
      const int lane_e = lane_fresh(), fr = lane_e & 15, fq = lane_e >> 4;
      const int ntl = nt0 + wv, row = TP + mt * 16 + fr, col = ntl * 16 + fq * 4;
      f32x4 v = skreduce(wv) + *(const f32x4*)(p.in[1] + (size_t)(row - TP) * 1024 + col);
      *(u32x2*)(H2B + (size_t)row * 1024 + col) = pack4(v);
      float ss = v[0] * v[0] + v[1] * v[1] + v[2] * v[2] + v[3] * v[3];
      ss += shfl_xor_f(ss, 16); ss += shfl_xor_f(ss, 32);
      if (fq == 0) PSS[(size_t)(row - TP) * 64 + ntl] = ss;
    }
  }
}

__device__ __forceinline__ void phaseF(const Params& p, const int wv, const int rep) {
  const int wid = wv, wr = wid >> 2, wc = wid & 3;
  char* ws = p.ws;
  const u16* H2B = (const u16*)(ws + OFF_H2B);
  const u16* WUP = (const u16*)(ws + OFF_WUP);
  u16* ACT = (u16*)(ws + OFF_ACT);
  const float* PS = (const float*)(ws + OFF_PS);
  const float* PSS = (const float*)(ws + OFF_PSS);
  {
    float* rs_l = (float*)(g_shm + 131072);
    auto fill_rs = [&](int t, int buf) {
      const int tid = wv * 64 + lane_fresh();
      if (tid < 256) {
        const float* ps = PS + (size_t)((t & 63) * 256 + tid) * 16;
        f32x4 a = *(const f32x4*)ps + *(const f32x4*)(ps + 4) + *(const f32x4*)(ps + 8) + *(const f32x4*)(ps + 12);
        rs_l[buf * 256 + tid] = rsqrtf((a[0] + a[1] + a[2] + a[3]) * (1.f / 1024.f) + EPS);
      }
    };
    int t_ = blockIdx.x, it = 0;
    const int tend = 1024 * rep;
    Acc acc;
    if (t_ < tend) {
      const int t = t_ & 1023;
      fill_rs(t, 0);
      kloop_t<1, true>(H2B + (size_t)((t & 63) * 256) * 1024, 1024, WUP + (size_t)((t >> 6) * 256) * 1024, 1024, 1024, acc, wv);
    }
    while (t_ < tend) {
      const int t = t_ & 1023;
      const int pm = t & 63, pn = t >> 6, brow = pm * 256, bcol = pn * 256;
      ACC_ZERO(acc);
      kloop_t<2>(H2B + (size_t)brow * 1024, 1024, WUP + (size_t)bcol * 1024, 1024, 1024, acc, wv);
      t_ += gridDim.x;
      if (t_ < tend) {
        const int tn = t_ & 1023;
        fill_rs(tn, (it + 1) & 1);
        kloop_t<1, false>(H2B + (size_t)((tn & 63) * 256) * 1024, 1024, WUP + (size_t)((tn >> 6) * 256) * 1024, 1024, 1024, acc, wv);
      }
      const float* rs_c = rs_l + (it & 1) * 256;
      ACC_FOREACH_PAIR({
        const float rstd = rs_c[rrow];
        f32x4 o0 = v0 * rstd, o1 = v1 * rstd;
        o0[0] = fmaxf(o0[0], 0.f); o0[1] = fmaxf(o0[1], 0.f); o0[2] = fmaxf(o0[2], 0.f); o0[3] = fmaxf(o0[3], 0.f);
        o1[0] = fmaxf(o1[0], 0.f); o1[1] = fmaxf(o1[1], 0.f); o1[2] = fmaxf(o1[2], 0.f); o1[3] = fmaxf(o1[3], 0.f);
        o0 = o0 * o0; o1 = o1 * o1;
        store_pair16(ACT + (size_t)(brow + rrow) * 4096 + bcol + cb32, pack4(o0), pack4(o1), fq);
      });
      ++it;
    }
  }
  for (int gb = blockIdx.x; gb < 256; gb += gridDim.x) {
    const int task0 = gb * 8, mt = task0 >> 8, nt0 = task0 & 255;
    const u16* Ab = H2B + (size_t)(TP + mt * 16) * 1024;
    skgemm<8>([&](int) { return Ab; }, [&](int i) { return WUP + (size_t)((nt0 + i) * 16) * 1024; }, [&](int) { return 1024; }, 128, wv);
    {
      const int lane_e = lane_fresh(), fr = lane_e & 15, fq = lane_e >> 4;
      const int ntl = nt0 + wv, row = TP + mt * 16 + fr, col = ntl * 16 + fq * 4;
      const float* ps = PSS + (size_t)(row - TP) * 64 + fq * 16;
      f32x4 a4 = *(const f32x4*)ps + *(const f32x4*)(ps + 4) + *(const f32x4*)(ps + 8) + *(const f32x4*)(ps + 12);
      float sq = a4[0] + a4[1] + a4[2] + a4[3];
      sq += shfl_xor_f(sq, 16); sq += shfl_xor_f(sq, 32);
      const float rstd = rsqrtf(sq * (1.f / 1024.f) + EPS);
      f32x4 v = skreduce(wv) * rstd;
#pragma unroll
      for (int e = 0; e < 4; ++e) { float r = fmaxf(v[e], 0.f); v[e] = r * r; }
      *(u32x2*)(ACT + (size_t)row * 4096 + col) = pack4(v);
    }
  }
}

__device__ __forceinline__ void phaseG(const Params& p, const int wv, const int rep, unsigned* bar, const bool fused) {
  const int wid = wv, wr = wid >> 2, wc = wid & 3;
  char* ws = p.ws;
  const u16* ACT = (const u16*)(ws + OFF_ACT);
  const u16* WDN = (const u16*)(ws + OFF_WDN);
  const u16* H2 = (const u16*)(ws + OFF_H2B);
  unsigned* CNT = bar + 4096;
  unsigned* CNTS = bar + 4096 + 1024;
  float* XS = (float*)(ws + OFF_PS);
  float* XSS = (float*)(ws + OFF_PSS);
  const float* wfin = p.in[29];
  for (int t_ = blockIdx.x; t_ < 256 * rep; t_ += gridDim.x) {
    const int t = t_ & 255;
    const int pm = t & 63, pn = t >> 6, brow = pm * 256, bcol = pn * 256;
    Acc acc; ACC_ZERO(acc);
    kloop(ACT + (size_t)brow * 4096, 4096, WDN + (size_t)bcol * 4096, 4096, 4096, acc, wv);
    if (!fused) {
      ACC_FOREACH({
        const size_t o = (size_t)(brow + rrow) * 1024 + bcol + rcol;
        *(f32x4*)(p.out + O_Y + o) = v + unpack4(*(const u32x2*)(H2 + o));
      });
    } else {
      float* red = (float*)g_shm;
      float* rstd_l = red + 1024;
      {
        const int lane_e = lane_fresh(), fr = lane_e & 15, fq = lane_e >> 4;
#pragma unroll
        for (int ai = 0; ai < 2; ++ai)
#pragma unroll
          for (int m = 0; m < 4; ++m) {
            const int rrow = ai * 128 + wr * 64 + m * 16 + fr;
            float ss = 0.f;
#pragma unroll
            for (int bj = 0; bj < 2; ++bj) {
              u32x2 hp[2];
              load_pair16(H2 + (size_t)(brow + rrow) * 1024 + bcol + bj * 128 + wc * 32, fq, hp[0], hp[1]);
#pragma unroll
              for (int n = 0; n < 2; ++n) {
                f32x4 v = acc[ai][bj][m][n] + unpack4(hp[n]);
                acc[ai][bj][m][n] = v;
                ss += v[0] * v[0] + v[1] * v[1] + v[2] * v[2] + v[3] * v[3];
              }
            }
            ss += shfl_xor_f(ss, 16); ss += shfl_xor_f(ss, 32);
            if (fq == 0) red[rrow * 4 + wc] = ss;
          }
      }
      __syncthreads();
      {
        const int tid = wv * 64 + lane_fresh();
        if (tid < 256) {
          f32x4 r4 = *(const f32x4*)(red + tid * 4);
          __hip_atomic_store(XS + (size_t)(brow + tid) * 4 + pn, r4[0] + r4[1] + r4[2] + r4[3], __ATOMIC_RELAXED, __HIP_MEMORY_SCOPE_AGENT);
        }
        asm volatile("s_waitcnt vmcnt(0)" ::: "memory");
        __syncthreads();
        if (tid == 0) {
          (void)xb_add(&CNT[pm * 16], 1u);
          XB_SPIN(xb_ld(&CNT[pm * 16]) < 4u, bar);
        }
        __syncthreads();
        if (tid < 256) {
          float sq = 0.f;
#pragma unroll
          for (int q = 0; q < 4; ++q) sq += __hip_atomic_load(XS + (size_t)(brow + tid) * 4 + q, __ATOMIC_RELAXED, __HIP_MEMORY_SCOPE_AGENT);
          rstd_l[tid] = rsqrtf(sq * (1.f / 1024.f) + EPS);
        }
        __syncthreads();
      }
      ACC_FOREACH({
        const float rs = rstd_l[rrow];
        const f32x4 wv4 = *(const f32x4*)(wfin + bcol + rcol);
        *(f32x4*)(p.out + O_Y + (size_t)(brow + rrow) * 1024 + bcol + rcol) = v * rs * wv4;
      });
    }
  }
  for (int gb = blockIdx.x; gb < 256; gb += gridDim.x) {
    const int task0 = gb * 2, mt = task0 >> 6, nt0 = task0 & 63;
    const u16* Ab = ACT + (size_t)(TP + mt * 16) * 4096;
    skgemm<2>([&](int) { return Ab; }, [&](int i) { return WDN + (size_t)((nt0 + i) * 16) * 4096; }, [&](int) { return 4096; }, 512, wv);
    if (!fused) {
      if (wv < 2) {
        const int lane_e = lane_fresh(), fr = lane_e & 15, fq = lane_e >> 4;
        const int row = TP + mt * 16 + fr, col = (nt0 + wv) * 16 + fq * 4;
        const size_t o = (size_t)row * 1024 + col;
        *(f32x4*)(p.out + O_Y + o) = skreduce(wv) + unpack4(*(const u32x2*)(H2 + o));
      }
    } else {
      unsigned* last_l = (unsigned*)g_shm + 8192;
      if (wv < 2) {
        const int lane_e = lane_fresh(), fr = lane_e & 15, fq = lane_e >> 4;
        const int row = TP + mt * 16 + fr, col = (nt0 + wv) * 16 + fq * 4;
        const size_t o = (size_t)row * 1024 + col;
        f32x4 v = skreduce(wv) + unpack4(*(const u32x2*)(H2 + o));
        float* yo = p.out + O_Y + o;
#pragma unroll
        for (int e = 0; e < 4; ++e) __hip_atomic_store(yo + e, v[e], __ATOMIC_RELAXED, __HIP_MEMORY_SCOPE_AGENT);
        float ss = v[0] * v[0] + v[1] * v[1] + v[2] * v[2] + v[3] * v[3];
        ss += shfl_xor_f(ss, 16); ss += shfl_xor_f(ss, 32);
        if (fq == 0) __hip_atomic_store(XSS + (size_t)(row - TP) * 64 + nt0 + wv, ss, __ATOMIC_RELAXED, __HIP_MEMORY_SCOPE_AGENT);
      }
      asm volatile("s_waitcnt vmcnt(0)" ::: "memory");
      __syncthreads();
      const int tid = wv * 64 + lane_fresh();
      if (tid == 0) last_l[0] = (xb_add(&CNTS[mt * 16], 1u) == 31u) ? 1u : 0u;
      __syncthreads();
      if (last_l[0]) {
        __builtin_amdgcn_fence(__ATOMIC_ACQUIRE, "agent");
        const int r = tid >> 5, c32 = tid & 31;
        float* yrow = p.out + O_Y + (size_t)(TP + mt * 16 + r) * 1024;
        float sq = __hip_atomic_load(XSS + (size_t)(mt * 16 + r) * 64 + c32 * 2, __ATOMIC_RELAXED, __HIP_MEMORY_SCOPE_AGENT)
                 + __hip_atomic_load(XSS + (size_t)(mt * 16 + r) * 64 + c32 * 2 + 1, __ATOMIC_RELAXED, __HIP_MEMORY_SCOPE_AGENT);
        sq += shfl_xor_f(sq, 16); sq += shfl_xor_f(sq, 8); sq += shfl_xor_f(sq, 4); sq += shfl_xor_f(sq, 2); sq += shfl_xor_f(sq, 1);
        const float rs = rsqrtf(sq * (1.f / 1024.f) + EPS);
#pragma unroll
        for (int i = 0; i < 8; ++i) {
          const int col = i * 128 + c32 * 4;
          f32x4 v = *(const f32x4*)(yrow + col);
          *(f32x4*)(yrow + col) = v * rs * *(const f32x4*)(wfin + col);
        }
      }
    }
  }
}

__device__ __forceinline__ void phaseH(const Params& p, const int wv, const int rep) {
  const int wid = wv, lane = lane_fresh();
  const int gw = blockIdx.x * 8 + wid, nw = gridDim.x * 8;
  const float* w = p.in[29];
  for (int r_ = gw; r_ < T * rep; r_ += nw) {
    const int r = r_ >= T ? r_ - T : r_;
    float* x = p.out + O_Y + (size_t)r * 1024;
    f32x4 v[4]; float ss = 0.f;
#pragma unroll
    for (int i = 0; i < 4; ++i) { v[i] = *(const f32x4*)(x + (i * 64 + lane) * 4); ss += v[i][0] * v[i][0] + v[i][1] * v[i][1] + v[i][2] * v[i][2] + v[i][3] * v[i][3]; }
    ss = wave_sum(ss);
    const float rstd = rsqrtf(ss * (1.f / 1024.f) + EPS);
#pragma unroll
    for (int i = 0; i < 4; ++i) { f32x4 wv = *(const f32x4*)(w + (i * 64 + lane) * 4); *(f32x4*)(x + (i * 64 + lane) * 4) = v[i] * rstd * wv; }
  }
}

__global__ void __launch_bounds__(NTHREADS) fwd_megakernel(Params p) {
  cg::grid_group grid = cg::this_grid();
  const int wv = __builtin_amdgcn_readfirstlane(threadIdx.x >> 6);
#ifndef REP
#define REP 0
#endif
#define RB(bit) ({ int n_ = (REP & (1 << bit)) ? 2 : 1; asm volatile("" : "+s"(n_)); n_; })
  unsigned* bar = (unsigned*)(p.ws + OFF_BAR);
  if (wv == 0) { if (lane_fresh() == 0) { xb_words = make_uint4(0u, 0u, 0u, 0u); (void)xb_add(&bar[XB_XCNT(xb_xcc_id())], 1u); } }
  __syncthreads();
  phaseA(p, wv, RB(0));
  if (p.ws == nullptr) grid.sync();
  xcd_barrier(bar, wv);
  phaseB(p, wv, RB(1));
  xcd_barrier(bar, wv);
  phaseC(p, wv, RB(8), RB(9), RB(10), RB(11), RB(12), bar);
  xcd_barrier(bar, wv);
  phaseD(p, wv, RB(2));
  xcd_barrier(bar, wv);
  phaseE(p, wv, RB(3));
  xcd_barrier(bar, wv);
  phaseF(p, wv, RB(4));
  xcd_barrier(bar, wv);
  const bool fused = (gridDim.x == 256) && !(REP & 32);
  phaseG(p, wv, RB(5), bar, fused);
  if (!fused) {
    xcd_barrier(bar, wv);
    phaseH(p, wv, 1);
  }
  { int ns = (REP & 8192) ? 8 : 0; asm volatile("" : "+s"(ns)); for (int i = 0; i < ns; ++i) xcd_barrier(bar, wv); }
}

extern "C" void kernel_launch(void* const* d_in, const int* in_sizes, int n_in, void* d_out, int out_size, void* d_ws, size_t ws_size, hipStream_t stream) {
  static int grid_blocks = 0;
  if (!grid_blocks) {
    int dev = 0, cus = 0, per_cu = 0;
    (void)hipGetDevice(&dev);
    (void)hipDeviceGetAttribute(&cus, hipDeviceAttributeMultiprocessorCount, dev);
    (void)hipFuncSetAttribute((const void*)fwd_megakernel, hipFuncAttributeMaxDynamicSharedMemorySize, DYN_LDS);
    (void)hipOccupancyMaxActiveBlocksPerMultiprocessor(&per_cu, fwd_megakernel, NTHREADS, DYN_LDS);
    if (per_cu > 1) per_cu = 1;
    grid_blocks = cus * per_cu;
    if (grid_blocks > 256) grid_blocks = 256;
  }
  if (ws_size < WS_TOTAL || n_in < 30 || grid_blocks <= 0) { fprintf(stderr, "kernel_launch: bad config ws=%zu need=%zu grid=%d\n", ws_size, (size_t)WS_TOTAL, grid_blocks); return; }
  Params p{};
  for (int i = 0; i < 30; ++i) p.in[i] = (const float*)d_in[i];
  p.out = (float*)d_out;
  p.ws = (char*)d_ws;
  (void)hipMemsetAsync((char*)d_ws + OFF_BAR, 0, BAR_BYTES, stream);
  void* args[] = {&p};
  hipError_t e = hipLaunchCooperativeKernel((void*)fwd_megakernel, dim3(grid_blocks), dim3(NTHREADS), args, DYN_LDS, stream);
  if (e != hipSuccess) fprintf(stderr, "cooperative launch failed: %s (grid %d)\n", hipGetErrorString(e), grid_blocks);
}
```
